# Optimizing an MI355X kernel written in HIP

```python
import jax, jax.numpy as jnp
from jax import lax
import numpy as np

D_MODEL = 1024
BATCH = 8
SEQ = 2048
DEPTH = 4
DEC_BATCH = 32
DEC_SEQ = 4
PAST_LEN = 8192
PAGE_SIZE = 128

HEAD_DIM = 64
RWKV_HEADS = 4
RWKV_DIM = RWKV_HEADS * HEAD_DIM
RWKV_W_RANK = 64
RWKV_A_RANK = 64
RWKV_G_RANK = 128
RWKV_PROJ = 3 * RWKV_DIM + RWKV_W_RANK + RWKV_A_RANK + RWKV_G_RANK
RWKV_GN_EPS = 64e-5
ATT_HEADS = 6
ATT_DIM = ATT_HEADS * HEAD_DIM
DILATED_BRANCHES = ((128, 1), (512, 4), (2048, 16))
MAX_WINDOW = 2048
SSM_HEADS = 6
SSM_DIM = SSM_HEADS * HEAD_DIM
SSM_GROUPS = 2
SSM_STATE = 128
SSM_CONV = 4
SSM_CHUNK = 128
SSM_CONV_DIM = SSM_DIM + 2 * SSM_GROUPS * SSM_STATE
PROJ_DIM = RWKV_PROJ + 3 * ATT_DIM + SSM_DIM + SSM_CONV_DIM + SSM_HEADS
D_MIX = RWKV_DIM + ATT_DIM + SSM_DIM
FFN_DIM = 2816
NORM_EPS = 1e-6
NEG_INF = -1e30

kernel_name = "hymba_rwkv7_dilated_ssd_decoder_step"


def rms_norm(x, w):
    xf = x.astype(jnp.float32)
    y = xf * lax.rsqrt(jnp.mean(xf * xf, axis=-1, keepdims=True) + NORM_EPS)
    return y.astype(x.dtype) * w


def swiglu(h, wg, wu, wd):
    return (jax.nn.silu(h @ wg) * (h @ wu)) @ wd


def alibi_slopes():
    return 2.0 ** (-8.0 * jnp.arange(1, ATT_HEADS + 1, dtype=jnp.float32) / ATT_HEADS)


def rwkv7_recurrence(r, w, k, v, kk, a, S0):
    def step(S, inp):
        r_t, w_t, k_t, v_t, kk_t, a_t = inp
        sa = jnp.einsum("bhij,bhj->bhi", S, -kk_t)
        S = (S * w_t[:, :, None, :] + sa[..., None] * (kk_t * a_t)[:, :, None, :]
             + v_t[..., None] * k_t[:, :, None, :])
        return S, jnp.einsum("bhij,bhj->bhi", S, r_t)
    xs = tuple(jnp.moveaxis(t, 1, 0) for t in (r, w, k, v, kk, a))
    S_final, ys = lax.scan(step, S0, xs)
    return jnp.moveaxis(ys, 0, 1), S_final


def rwkv7_mix(p, shift_prev, S0, lp):
    B_, T, _ = p.shape
    f32 = jnp.float32
    p_prev = jnp.concatenate([shift_prev[:, None, :].astype(p.dtype), p[:, :-1]], axis=1)
    ps = p + lp["rwkv_mu"] * (p_prev - p)
    o = np.cumsum([RWKV_DIM, RWKV_DIM, RWKV_DIM, RWKV_W_RANK, RWKV_A_RANK]).tolist()
    r, k, v, w_lr, a_lr, g_lr = jnp.split(ps, o, axis=-1)
    w_log = -jax.nn.softplus(-(lp["rwkv_w0"] + jnp.tanh(w_lr) @ lp["rwkv_w2"])) - 0.5
    decay = jnp.exp(-jnp.exp(w_log.astype(f32)))
    a = jax.nn.sigmoid(lp["rwkv_a0"] + a_lr @ lp["rwkv_a2"])
    g = jax.nn.sigmoid(g_lr) @ lp["rwkv_g2"]
    heads = lambda t: t.reshape(B_, T, RWKV_HEADS, HEAD_DIM).astype(f32)
    kk = heads(k * lp["rwkv_k_k"])
    kk = kk / jnp.maximum(jnp.sqrt(jnp.sum(kk * kk, axis=-1, keepdims=True)), 1e-12)
    k = k * (1.0 + (a - 1.0) * lp["rwkv_k_a"])
    rh, kh, vh, ah, wh = heads(r), heads(k), heads(v), heads(a), heads(decay)
    y, S_final = rwkv7_recurrence(rh, wh, kh, vh, kk, ah, S0.astype(f32))
    mu = jnp.mean(y, axis=-1, keepdims=True)
    var = jnp.mean(jnp.square(y - mu), axis=-1, keepdims=True)
    y = ((y - mu) * lax.rsqrt(var + RWKV_GN_EPS)).reshape(B_, T, RWKV_DIM)
    y = y * lp["rwkv_ln_w"] + lp["rwkv_ln_b"]
    bonus = jnp.sum(rh * kh * lp["rwkv_r_k"].astype(f32), axis=-1, keepdims=True) * vh
    out = (y + bonus.reshape(B_, T, RWKV_DIM)).astype(p.dtype) * g
    return out, p[:, -1], S_final.astype(S0.dtype)


def _branch_prompt(q, k, v, slopes, window, dil):
    B_, T, H, Dh = q.shape
    L = window // dil
    span = L * dil
    nb = -(-T // span)
    S_pad = nb * span
    P = S_pad - T

    def blocks(t):
        t = jnp.pad(t, ((0, 0), (P, 0), (0, 0), (0, 0)))
        return t.reshape(B_, nb, L, dil, H, Dh)

    def with_prev(t):
        prev = jnp.pad(t[:, :-1], ((0, 0), (1, 0), (0, 0), (0, 0), (0, 0), (0, 0)))
        return jnp.concatenate([prev, t], axis=2)

    qb = blocks(q)
    kb2, vb2 = with_prev(blocks(k)), with_prev(blocks(v))
    s = jnp.einsum("bnichd,bnjchd->bnchij", qb, kb2)
    qi = jnp.arange(L)[:, None]
    kj = jnp.arange(2 * L)[None, :]
    delta = L + qi - kj
    blk = jnp.arange(nb)[:, None, None, None]
    res = jnp.arange(dil)[None, :, None, None]
    key_pos = ((blk - 1) * L + kj[None, None]) * dil + res
    valid = (delta >= 0) & (delta <= L) & (key_pos >= P)
    bias = -slopes[:, None, None] * (dil * delta).astype(jnp.float32)
    s = jnp.where(valid[None, :, :, None], s + bias, NEG_INF)
    m = jnp.max(s, axis=-1)
    pr = jnp.exp(s - m[..., None])
    l = jnp.sum(pr, axis=-1)
    acc = jnp.einsum("bnchij,bnjchd->bnichd", pr, vb2).reshape(B_, S_pad, H, Dh)[:, P:]
    m = m.transpose(0, 1, 4, 2, 3).reshape(B_, S_pad, H)[:, P:]
    l = l.transpose(0, 1, 4, 2, 3).reshape(B_, S_pad, H)[:, P:]
    return acc, m, l


def _branch_sample(q, kc, vc, slopes, window, dil):
    B_, T, H, Dh = q.shape
    W = kc.shape[1] - T
    n = window // dil
    steps = jnp.arange(n + 1)
    idx = W + jnp.arange(T)[:, None] - dil * steps[None, :]
    valid = idx >= 0
    idx = jnp.maximum(idx, 0)
    kg, vg = kc[:, idx], vc[:, idx]
    s = jnp.einsum("bthd,btkhd->bhtk", q, kg) - slopes[:, None, None] * (dil * steps).astype(jnp.float32)
    s = jnp.where(valid[None, None], s, NEG_INF)
    m = jnp.max(s, axis=-1)
    pr = jnp.exp(s - m[..., None])
    l = jnp.sum(pr, axis=-1)
    acc = jnp.einsum("bhtk,btkhd->bthd", pr, vg)
    return acc, m.transpose(0, 2, 1), l.transpose(0, 2, 1)


def dilated_attention(q, k, v, k_buf, v_buf):
    f32 = jnp.float32
    slopes = alibi_slopes()
    qf = q.astype(f32) * (HEAD_DIM ** -0.5)
    kf, vf = k.astype(f32), v.astype(f32)
    if k_buf is None:
        res = [_branch_prompt(qf, kf, vf, slopes, w, d) for (w, d) in DILATED_BRANCHES]
    else:
        kc = jnp.concatenate([k_buf.astype(f32), kf], axis=1)
        vc = jnp.concatenate([v_buf.astype(f32), vf], axis=1)
        res = [_branch_sample(qf, kc, vc, slopes, w, d) for (w, d) in DILATED_BRANCHES]
    M = res[0][1]
    for br in res[1:]:
        M = jnp.maximum(M, br[1])
    num = jnp.zeros_like(qf)
    den = jnp.zeros_like(M)
    for acc, m, l in res:
        e = jnp.exp(m - M)
        num = num + e[..., None] * acc
        den = den + e * l
    return (num / den[..., None]).astype(q.dtype)


def ssd_chunked(x, dt, A, Bm, Cm, h0):
    B_, T, H, P = x.shape
    L = SSM_CHUNK if T % SSM_CHUNK == 0 else T
    nc = T // L
    rs = lambda t: t.reshape(B_, nc, L, *t.shape[2:])
    xc, dtc, Bc, Cc = rs(x), rs(dt), rs(Bm), rs(Cm)
    acum = jnp.cumsum(dtc * A, axis=2)
    seg = acum[:, :, :, None, :] - acum[:, :, None, :, :]
    causal = jnp.tril(jnp.ones((L, L), dtype=bool))[None, None, :, :, None]
    decay = jnp.exp(jnp.where(causal, seg, -jnp.inf))
    scores = jnp.einsum("bclhn,bcshn->bclsh", Cc, Bc) * decay * dtc[:, :, None, :, :]
    y_intra = jnp.einsum("bclsh,bcshp->bclhp", scores, xc)
    to_end = jnp.exp(acum[:, :, -1:, :] - acum) * dtc
    st = jnp.einsum("bclh,bclhn,bclhp->bchpn", to_end, Bc, xc)
    chunk_decay = jnp.exp(acum[:, :, -1, :])

    def step(h, inp):
        st_c, dec_c = inp
        return h * dec_c[:, :, None, None] + st_c, h

    h_final, h_starts = lax.scan(step, h0, (jnp.moveaxis(st, 1, 0), jnp.moveaxis(chunk_decay, 1, 0)))
    h_starts = jnp.moveaxis(h_starts, 0, 1)
    y_inter = jnp.einsum("bclhn,bchpn->bclhp", Cc, h_starts) * jnp.exp(acum)[..., None]
    return (y_intra + y_inter).reshape(B_, T, H, P), h_final


def mamba2_mix(p_z, p_xbc, p_dt, conv_prev, h0, lp):
    B_, T, _ = p_xbc.shape
    f32 = jnp.float32
    ext = jnp.concatenate([conv_prev.astype(p_xbc.dtype), p_xbc], axis=1)
    conv = lp["ssm_conv_b"]
    for i in range(SSM_CONV):
        conv = conv + ext[:, i:i + T] * lp["ssm_conv_w"][i]
    new_conv = ext[:, T:]
    xbc = jax.nn.silu(conv)
    xs, Bm, Cm = jnp.split(xbc, [SSM_DIM, SSM_DIM + SSM_GROUPS * SSM_STATE], axis=-1)
    x = xs.reshape(B_, T, SSM_HEADS, HEAD_DIM).astype(f32)
    rep = SSM_HEADS // SSM_GROUPS
    Bm = jnp.repeat(Bm.reshape(B_, T, SSM_GROUPS, SSM_STATE), rep, axis=2).astype(f32)
    Cm = jnp.repeat(Cm.reshape(B_, T, SSM_GROUPS, SSM_STATE), rep, axis=2).astype(f32)
    dt = jax.nn.softplus((p_dt + lp["ssm_dt_bias"]).astype(f32))
    A = -jnp.exp(lp["ssm_A_log"].astype(f32))
    y, h_final = ssd_chunked(x, dt, A, Bm, Cm, h0.astype(f32))
    y = y + lp["ssm_D"].astype(f32)[:, None] * x
    y = y.reshape(B_, T, SSM_DIM).astype(p_z.dtype) * jax.nn.silu(p_z)
    return rms_norm(y, lp["ssm_norm_w"]), new_conv, h_final.astype(h0.dtype)


def token_mixer(h, lp, st):
    k_buf, v_buf, shift_prev, conv_prev, S0, h0 = st
    B_, T, _ = h.shape
    p = h @ lp["w_in"]
    o1 = RWKV_PROJ
    o2 = o1 + 3 * ATT_DIM
    o3 = o2 + SSM_DIM
    o4 = o3 + SSM_CONV_DIM
    p_rwkv, p_att, p_z, p_xbc, p_dt = jnp.split(p, [o1, o2, o3, o4], axis=-1)
    y_a, new_shift, S_new = rwkv7_mix(p_rwkv, shift_prev, S0, lp)
    q, k, v = [t.reshape(B_, T, ATT_HEADS, HEAD_DIM) for t in jnp.split(p_att, 3, axis=-1)]
    y_b = dilated_attention(q, k, v, k_buf, v_buf).reshape(B_, T, ATT_DIM)
    y_b = rms_norm(y_b, lp["att_norm_w"])
    y_c, new_conv, h_new = mamba2_mix(p_z, p_xbc, p_dt, conv_prev, h0, lp)
    out = jnp.concatenate([y_a, y_b, y_c], axis=-1) @ lp["w_out"]
    return out, (k, v, new_shift, S_new, new_conv, h_new)


def run_trunk(x, layers, states, final_norm):
    new_states = []
    for l in range(DEPTH):
        lp = layers[l]
        x = x + 0.5 * swiglu(rms_norm(x, lp["ffn1_norm"]), lp["ffn1_w_gate"], lp["ffn1_w_up"], lp["ffn1_w_down"])
        mix, st_new = token_mixer(rms_norm(x, lp["mix_norm"]), lp, states[l])
        x = x + mix
        x = x + 0.5 * swiglu(rms_norm(x, lp["ffn2_norm"]), lp["ffn2_w_gate"], lp["ffn2_w_up"], lp["ffn2_w_down"])
        new_states.append(st_new)
    return rms_norm(x, final_norm), new_states


def setup_inputs(seed: int = 0) -> dict:
    key = jax.random.key(seed)
    it = iter(list(jax.random.split(key, 64)))
    f32 = jnp.float32

    def normal(shape, scale):
        return scale * jax.random.normal(next(it), shape, f32)

    def gain(shape):
        return 1.0 + normal(shape, 0.02)

    att_buf = min(MAX_WINDOW, PAST_LEN)
    dt0 = jnp.exp(jax.random.uniform(next(it), (DEPTH, SSM_HEADS), f32, np.log(1e-3), np.log(1e-1)))
    inp = {}
    inp["x_prompt"] = normal((BATCH, SEQ, D_MODEL), 1.0)
    inp["x_sample"] = normal((DEC_BATCH, DEC_SEQ, D_MODEL), 1.0)
    inp["cache_att_k"] = normal((DEPTH, DEC_BATCH, att_buf, ATT_HEADS, HEAD_DIM), 1.0)
    inp["cache_att_v"] = normal((DEPTH, DEC_BATCH, att_buf, ATT_HEADS, HEAD_DIM), 1.0)
    inp["state_rwkv_shift"] = normal((DEPTH, DEC_BATCH, RWKV_PROJ), 1.0)
    inp["state_rwkv"] = normal((DEPTH, DEC_BATCH, RWKV_HEADS, HEAD_DIM, HEAD_DIM), 0.3)
    inp["state_ssm_conv"] = normal((DEPTH, DEC_BATCH, SSM_CONV - 1, SSM_CONV_DIM), 1.0)
    inp["state_ssm"] = normal((DEPTH, DEC_BATCH, SSM_HEADS, HEAD_DIM, SSM_STATE), 0.3)
    inp["ffn1_norm"] = gain((DEPTH, D_MODEL))
    inp["ffn1_w_gate"] = normal((DEPTH, D_MODEL, FFN_DIM), D_MODEL ** -0.5)
    inp["ffn1_w_up"] = normal((DEPTH, D_MODEL, FFN_DIM), D_MODEL ** -0.5)
    inp["ffn1_w_down"] = normal((DEPTH, FFN_DIM, D_MODEL), FFN_DIM ** -0.5)
    inp["mix_norm"] = gain((DEPTH, D_MODEL))
    inp["w_in"] = normal((DEPTH, D_MODEL, PROJ_DIM), D_MODEL ** -0.5)
    inp["rwkv_mu"] = jax.random.uniform(next(it), (DEPTH, RWKV_PROJ), f32)
    inp["rwkv_w0"] = normal((DEPTH, RWKV_DIM), 0.5)
    inp["rwkv_w2"] = normal((DEPTH, RWKV_W_RANK, RWKV_DIM), RWKV_W_RANK ** -0.5)
    inp["rwkv_a0"] = normal((DEPTH, RWKV_DIM), 0.1)
    inp["rwkv_a2"] = normal((DEPTH, RWKV_A_RANK, RWKV_DIM), 0.5 * RWKV_A_RANK ** -0.5)
    inp["rwkv_g2"] = normal((DEPTH, RWKV_G_RANK, RWKV_DIM), RWKV_G_RANK ** -0.5)
    inp["rwkv_k_k"] = 0.85 + normal((DEPTH, RWKV_DIM), 0.02)
    inp["rwkv_k_a"] = gain((DEPTH, RWKV_DIM))
    inp["rwkv_r_k"] = normal((DEPTH, RWKV_HEADS, HEAD_DIM), 0.1)
    inp["rwkv_ln_w"] = gain((DEPTH, RWKV_DIM))
    inp["rwkv_ln_b"] = normal((DEPTH, RWKV_DIM), 0.01)
    inp["att_norm_w"] = gain((DEPTH, ATT_DIM))
    inp["ssm_conv_w"] = normal((DEPTH, SSM_CONV, SSM_CONV_DIM), 0.5)
    inp["ssm_conv_b"] = normal((DEPTH, SSM_CONV_DIM), 0.01)
    inp["ssm_dt_bias"] = dt0 + jnp.log(-jnp.expm1(-dt0))
    inp["ssm_A_log"] = jnp.log(jax.random.uniform(next(it), (DEPTH, SSM_HEADS), f32, 1.0, 16.0))
    inp["ssm_D"] = 1.0 + normal((DEPTH, SSM_HEADS), 0.1)
    inp["ssm_norm_w"] = gain((DEPTH, SSM_DIM))
    inp["w_out"] = normal((DEPTH, D_MIX, D_MODEL), D_MIX ** -0.5)
    inp["ffn2_norm"] = gain((DEPTH, D_MODEL))
    inp["ffn2_w_gate"] = normal((DEPTH, D_MODEL, FFN_DIM), D_MODEL ** -0.5)
    inp["ffn2_w_up"] = normal((DEPTH, D_MODEL, FFN_DIM), D_MODEL ** -0.5)
    inp["ffn2_w_down"] = normal((DEPTH, FFN_DIM, D_MODEL), FFN_DIM ** -0.5)
    inp["final_norm"] = gain((D_MODEL,))
    return inp


def reference(x_prompt, x_sample, cache_att_k, cache_att_v, state_rwkv_shift, state_rwkv,
              state_ssm_conv, state_ssm, ffn1_norm, ffn1_w_gate, ffn1_w_up, ffn1_w_down,
              mix_norm, w_in, rwkv_mu, rwkv_w0, rwkv_w2, rwkv_a0, rwkv_a2, rwkv_g2, rwkv_k_k,
              rwkv_k_a, rwkv_r_k, rwkv_ln_w, rwkv_ln_b, att_norm_w, ssm_conv_w, ssm_conv_b,
              ssm_dt_bias, ssm_A_log, ssm_D, ssm_norm_w, w_out, ffn2_norm, ffn2_w_gate,
              ffn2_w_up, ffn2_w_down, final_norm):
    layers = [dict(ffn1_norm=ffn1_norm[l], ffn1_w_gate=ffn1_w_gate[l], ffn1_w_up=ffn1_w_up[l],
                   ffn1_w_down=ffn1_w_down[l], mix_norm=mix_norm[l], w_in=w_in[l],
                   rwkv_mu=rwkv_mu[l], rwkv_w0=rwkv_w0[l], rwkv_w2=rwkv_w2[l], rwkv_a0=rwkv_a0[l],
                   rwkv_a2=rwkv_a2[l], rwkv_g2=rwkv_g2[l], rwkv_k_k=rwkv_k_k[l], rwkv_k_a=rwkv_k_a[l],
                   rwkv_r_k=rwkv_r_k[l], rwkv_ln_w=rwkv_ln_w[l], rwkv_ln_b=rwkv_ln_b[l],
                   att_norm_w=att_norm_w[l], ssm_conv_w=ssm_conv_w[l], ssm_conv_b=ssm_conv_b[l],
                   ssm_dt_bias=ssm_dt_bias[l], ssm_A_log=ssm_A_log[l], ssm_D=ssm_D[l],
                   ssm_norm_w=ssm_norm_w[l], w_out=w_out[l], ffn2_norm=ffn2_norm[l],
                   ffn2_w_gate=ffn2_w_gate[l], ffn2_w_up=ffn2_w_up[l], ffn2_w_down=ffn2_w_down[l])
              for l in range(DEPTH)]

    Bp, Tp = x_prompt.shape[0], x_prompt.shape[1]
    dtp = x_prompt.dtype
    zero_state = (None, None,
                  jnp.zeros((Bp, RWKV_PROJ), dtp),
                  jnp.zeros((Bp, SSM_CONV - 1, SSM_CONV_DIM), dtp),
                  jnp.zeros((Bp, RWKV_HEADS, HEAD_DIM, HEAD_DIM), dtp),
                  jnp.zeros((Bp, SSM_HEADS, HEAD_DIM, SSM_STATE), dtp))
    y_prompt, p_new = run_trunk(x_prompt, layers, [zero_state] * DEPTH, final_norm)

    s_states = [(cache_att_k[l], cache_att_v[l], state_rwkv_shift[l], state_ssm_conv[l],
                 state_rwkv[l], state_ssm[l]) for l in range(DEPTH)]
    y_sample, s_new = run_trunk(x_sample, layers, s_states, final_norm)

    keep = min(MAX_WINDOW, Tp)
    p_att_k = jnp.stack([s[0][:, -keep:] for s in p_new])
    p_att_v = jnp.stack([s[1][:, -keep:] for s in p_new])
    p_rwkv_shift = jnp.stack([s[2] for s in p_new])
    p_rwkv = jnp.stack([s[3] for s in p_new])
    p_ssm_conv = jnp.stack([s[4] for s in p_new])
    p_ssm = jnp.stack([s[5] for s in p_new])
    s_att_k = jnp.stack([s[0] for s in s_new])
    s_att_v = jnp.stack([s[1] for s in s_new])
    s_rwkv_shift = jnp.stack([s[2] for s in s_new])
    s_rwkv = jnp.stack([s[3] for s in s_new])
    s_ssm_conv = jnp.stack([s[4] for s in s_new])
    s_ssm = jnp.stack([s[5] for s in s_new])
    return (y_prompt, y_sample, p_att_k, p_att_v, p_rwkv_shift, p_rwkv, p_ssm_conv, p_ssm,
            s_att_k, s_att_v, s_rwkv_shift, s_rwkv, s_ssm_conv, s_ssm)
```

```cpp
#include <hip/hip_runtime.h>
#include <cstdio>
#include <cstdint>
namespace pg8 {
#define PG8_LAS __attribute__((address_space(3)))
typedef unsigned short bf16_t;
typedef short bf16x8 __attribute__((ext_vector_type(8)));
typedef float f32x4 __attribute__((ext_vector_type(4)));
typedef unsigned u32x4 __attribute__((ext_vector_type(4)));
constexpr int BM = 256, BK = 64, HALF = 128, HTB = HALF * BK * 2  , STAGE_BYTES = 8 * HTB, NXCD = 8, WGM = 8;

__host__ __device__ __forceinline__ int lds_byte(int r, int c) { const int st = (r >> 4) * 2 + (c >> 5), rr = r & 15, cc = c & 31, ob = rr * 64 + cc * 2; return st * 1024 + (ob ^ (((ob >> 9) & 1) << 5)); }
__host__ __device__ __forceinline__ void stage_rc(int b, int& R, int& C) { const int st = b / 1024, sb = b % 1024, swz = sb ^ (((sb >> 9) & 1) << 5); R = (st >> 1) * 16 + swz / 64; C = (st & 1) * 32 + (swz % 64) / 2; }
__host__ __device__ __forceinline__ int perm32(int rho) { const int n = rho >> 4, i = rho & 15; return 8 * (i >> 2) + 4 * n + (i & 3); }

struct Unit { int pm, pn; };
struct Gemm { const bf16_t* A; const bf16_t* Bt; int M, N, K; };

struct StaticOrder {
    int nM, nN, nwg, G, c;
    __host__ __device__ void init(int M, int N, int G_, int c_) { nM = M / BM; nN = N / BM; nwg = nM * nN; G = G_; c = c_; }
    __host__ __device__ bool next(int i, Unit& u) const {
        const long L = (long)i * G + c; if (L >= nwg) return false;
        int wgid = (int)L; { const int q = nwg / NXCD, r = nwg % NXCD, xcd = wgid % NXCD, off = wgid / NXCD; wgid = (xcd < r ? xcd * (q + 1) : r * (q + 1) + (xcd - r) * q) + off; }
        const int nig = WGM * nN, gid = wgid / nig, fm = gid * WGM, gsz = (nM - fm) < WGM ? (nM - fm) : WGM;
        u.pm = fm + ((wgid % nig) % gsz); u.pn = (wgid % nig) / gsz; return true;
    }
    __device__ __forceinline__ void a_ready(const Unit&) const {}
    __device__ __forceinline__ void done(const Unit&) const {}
};

__device__ __forceinline__ unsigned cvt_pk_bf16(float lo, float hi) { unsigned r; asm volatile("v_cvt_pk_bf16_f32 %0, %1, %2" : "=v"(r) : "v"(lo), "v"(hi)); return r; }
typedef float f32x2 __attribute__((ext_vector_type(2)));

typedef unsigned u32x2 __attribute__((ext_vector_type(2)));
__device__ __forceinline__ float xsum16(float v) { const auto r = __builtin_amdgcn_permlane16_swap(__float_as_uint(v), __float_as_uint(v), false, false); return __uint_as_float(r[0]) + __uint_as_float(r[1]); }
__device__ __forceinline__ float xsum32(float v) { const auto r = __builtin_amdgcn_permlane32_swap(__float_as_uint(v), __float_as_uint(v), false, false); return __uint_as_float(r[0]) + __uint_as_float(r[1]); }
__device__ __forceinline__ float xmax16(float v) { const auto r = __builtin_amdgcn_permlane16_swap(__float_as_uint(v), __float_as_uint(v), false, false); return fmaxf(__uint_as_float(r[0]), __uint_as_float(r[1])); }
__device__ __forceinline__ float xmax32(float v) { const auto r = __builtin_amdgcn_permlane32_swap(__float_as_uint(v), __float_as_uint(v), false, false); return fmaxf(__uint_as_float(r[0]), __uint_as_float(r[1])); }
constexpr int E_FF = 2816, E_NPP = 3584, E_D = 1024;
__device__ __forceinline__ float row_rstd(const float* ssq, int row) {
    const f32x4* sp = (const f32x4*)(ssq + (size_t)row * 16);
    const f32x4 s = (sp[0] + sp[1]) + (sp[2] + sp[3]);
    return __builtin_amdgcn_rsqf(((s[0] + s[1]) + (s[2] + s[3])) * (1.0f / 1024.0f) + 1e-6f);
}
__device__ __forceinline__ float silu_f(float g) { return g * __builtin_amdgcn_rcpf(1.0f + __builtin_amdgcn_exp2f(-1.4426950408889634f * g)); }
struct EpiGU {
    static constexpr bool PERM = true, AFTER_DRAIN = false;
    bf16_t* H; const float* ssq;
    __device__ __forceinline__ void operator()(const f32x4 (&acc)[2][2][4][2], const Unit& u, int wr, int wc, int fr, int fq) const {
        const int row0 = u.pm * BM + wr * 64 + fr, hc0 = u.pn * 128 + wc * 16 + 4 * fq;
#pragma unroll
        for (int ai = 0; ai < 2; ++ai)
#pragma unroll
            for (int m = 0; m < 4; ++m) { const int row = row0 + ai * HALF + m * 16; const float rs = row_rstd(ssq, row);
#pragma unroll
                for (int bj = 0; bj < 2; ++bj) { const f32x4 g = acc[ai][bj][m][0] * rs, up = acc[ai][bj][m][1] * rs;
                    u32x2 w; w.x = cvt_pk_bf16(silu_f(g[0]) * up[0], silu_f(g[1]) * up[1]); w.y = cvt_pk_bf16(silu_f(g[2]) * up[2], silu_f(g[3]) * up[3]);
                    *(u32x2*)(H + (size_t)row * E_FF + hc0 + bj * 64) = w; } asm volatile("" ::: "memory"); }
    }
};
struct EpiIn {
    static constexpr bool PERM = true, AFTER_DRAIN = false;
    bf16_t* P; const float* ssq;
    __device__ __forceinline__ void operator()(const f32x4 (&acc)[2][2][4][2], const Unit& u, int wr, int wc, int fr, int fq) const {
        const int row0 = u.pm * BM + wr * 64 + fr, col0 = u.pn * BM + wc * 32 + 8 * fq;
#pragma unroll
        for (int ai = 0; ai < 2; ++ai)
#pragma unroll
            for (int m = 0; m < 4; ++m) { const int row = row0 + ai * HALF + m * 16; const float rs = row_rstd(ssq, row);
#pragma unroll
                for (int bj = 0; bj < 2; ++bj) { const f32x4 v0 = acc[ai][bj][m][0] * rs, v1 = acc[ai][bj][m][1] * rs;
                    u32x4 w; w.x = cvt_pk_bf16(v0[0], v0[1]); w.y = cvt_pk_bf16(v0[2], v0[3]); w.z = cvt_pk_bf16(v1[0], v1[1]); w.w = cvt_pk_bf16(v1[2], v1[3]);
                    *(u32x4*)(P + (size_t)row * E_NPP + col0 + bj * HALF) = w; } asm volatile("" ::: "memory"); }
    }
};
struct EpiRes {
    static constexpr bool PERM = true, AFTER_DRAIN = false;
    float* X; bf16_t* XB; float* ssq; float scale;
    __device__ __forceinline__ void operator()(const f32x4 (&acc)[2][2][4][2], const Unit& u, int wr, int wc, int fr, int fq) const {
        const int row0 = u.pm * BM + wr * 64 + fr, col0 = u.pn * BM + wc * 32 + 8 * fq;
#pragma unroll
        for (int ai = 0; ai < 2; ++ai)
#pragma unroll
            for (int m = 0; m < 4; ++m) { const int row = row0 + ai * HALF + m * 16; float ss = 0.f;
#pragma unroll
                for (int bj = 0; bj < 2; ++bj) { float* xp = X + (size_t)row * E_D + col0 + bj * HALF;
                    const f32x4 x0 = *(const f32x4*)xp + acc[ai][bj][m][0] * scale, x1 = *(const f32x4*)(xp + 4) + acc[ai][bj][m][1] * scale;
                    *(f32x4*)xp = x0; *(f32x4*)(xp + 4) = x1;
                    ss += (x0[0] * x0[0] + x0[1] * x0[1]) + (x0[2] * x0[2] + x0[3] * x0[3]) + (x1[0] * x1[0] + x1[1] * x1[1]) + (x1[2] * x1[2] + x1[3] * x1[3]);
                    u32x4 w; w.x = cvt_pk_bf16(x0[0], x0[1]); w.y = cvt_pk_bf16(x0[2], x0[3]); w.z = cvt_pk_bf16(x1[0], x1[1]); w.w = cvt_pk_bf16(x1[2], x1[3]);
                    *(u32x4*)(XB + (size_t)row * E_D + col0 + bj * HALF) = w; }
                ss = xsum16(ss); ss = xsum32(ss);
                if (fq == 0) ssq[(size_t)row * 16 + u.pn * 4 + wc] = ss; asm volatile("" ::: "memory"); }
    }
};
template <class Epi, class Sched, bool ALIGN_EPI = false, bool SP2 = false>
__device__ __forceinline__ void gemm_phase(PG8_LAS unsigned char* lds, const Gemm g, const Sched& S, const Epi& E) {
    int tid = threadIdx.x; asm volatile("" : "+v"(tid)); const int wid = __builtin_amdgcn_readfirstlane(tid >> 6), lane = tid & 63, wr = wid >> 2, wc = wid & 3, fr = lane & 15, fq = lane >> 4;
    const int K = g.K, nt = K / BK;
    unsigned voffA[2], voffB[2];
#pragma unroll
    for (int i = 0; i < 2; ++i) { int R, C; stage_rc(tid * 16 + i * 8192, R, C); const int Rb = Epi::PERM ? ((R & ~31) + perm32(R & 31)) : R;
        voffA[i] = (unsigned)(R * K + C) * 2u; voffB[i] = (unsigned)(Rb * K + C) * 2u; }
    const size_t kstep = (size_t)(BK * 2);
    const size_t hstep = (size_t)HALF * K * 2;
    const size_t tstep = 2 * hstep;
    const unsigned ldsw = (unsigned)wid * 1024u;
    const int aoff = lds_byte(wr * 64 + fr, fq * 8), boff = lds_byte(wc * 32 + fr, fq * 8);
#define PG8_SA(b, h) (((b) * 2 + (h)) * HTB)
#define PG8_SB(b, h) ((4 + (b) * 2 + (h)) * HTB)
#define PG8_STAGE(bufoff, gbase, voff) do { _Pragma("unroll") for (int _i = 0; _i < 2; ++_i) \
        __builtin_amdgcn_global_load_lds((const unsigned*)((const char*)(gbase) + (voff)[_i]), (PG8_LAS unsigned*)(lds + (bufoff) + ldsw + _i * 8192), 16, 0, 0); } while (0)
#define PG8_LDA(dst, b, h) do { _Pragma("unroll") for (int m = 0; m < 4; ++m) _Pragma("unroll") for (int k = 0; k < 2; ++k) dst[m][k] = *(const PG8_LAS bf16x8*)(lds + PG8_SA(b, h) + aoff + m * 2048 + k * 1024); } while (0)
#define PG8_LDB(dst, b, h) do { _Pragma("unroll") for (int n = 0; n < 2; ++n) _Pragma("unroll") for (int k = 0; k < 2; ++k) dst[n][k] = *(const PG8_LAS bf16x8*)(lds + PG8_SB(b, h) + boff + n * 2048 + k * 1024); } while (0)
#define PG8_MMA(ai, bj, At, Bt) do { __builtin_amdgcn_s_setprio(1); _Pragma("unroll") for (int m = 0; m < 4; ++m) _Pragma("unroll") for (int n = 0; n < 2; ++n) _Pragma("unroll") for (int k = 0; k < 2; ++k) \
        acc[ai][bj][m][n] = __builtin_amdgcn_mfma_f32_16x16x32_bf16(Bt[n][k], At[m][k], acc[ai][bj][m][n], 0, 0, 0); __builtin_amdgcn_s_setprio(0); } while (0)
#define PG8_WAIT_V(n) asm volatile("s_waitcnt vmcnt(" #n ")" ::: "memory")
#define PG8_WAIT_L(n) asm volatile("s_waitcnt lgkmcnt(" #n ")" ::: "memory")
#define PG8_BAR __builtin_amdgcn_s_barrier()
#define PG8_SCHED __builtin_amdgcn_sched_barrier(0)
    Unit cur, nxt; int ui = 0;
    if (!S.next(0, cur)) return;
    f32x4 acc[2][2][4][2];
#pragma unroll
    for (int a = 0; a < 2; ++a)
#pragma unroll
        for (int b = 0; b < 2; ++b)
#pragma unroll
            for (int m = 0; m < 4; ++m)
#pragma unroll
                for (int n = 0; n < 2; ++n) acc[a][b][m][n] = (f32x4){0.f, 0.f, 0.f, 0.f};
    bf16x8 At[4][2], B0[2][2], B1[2][2];
    const char* cA = (const char*)g.A + (size_t)cur.pm * tstep; const char* cB = (const char*)g.Bt + (size_t)cur.pn * tstep;
    S.a_ready(cur);
    if constexpr (SP2) {
        PG8_STAGE(PG8_SB(0, 0), cB, voffB); PG8_STAGE(PG8_SB(0, 1), cB + hstep, voffB); PG8_STAGE(PG8_SA(0, 0), cA, voffA); PG8_STAGE(PG8_SA(0, 1), cA + hstep, voffA);
        if (wr == 1) PG8_BAR;
        PG8_WAIT_V(2); PG8_BAR;
        PG8_STAGE(PG8_SB(1, 0), cB + kstep, voffB); PG8_STAGE(PG8_SA(1, 0), cA + kstep, voffA); PG8_STAGE(PG8_SB(1, 1), cB + hstep + kstep, voffB);
        PG8_WAIT_V(6); PG8_BAR;
    } else {
        PG8_STAGE(PG8_SB(0, 0), cB, voffB); PG8_STAGE(PG8_SA(0, 0), cA, voffA); PG8_STAGE(PG8_SB(0, 1), cB + hstep, voffB); PG8_STAGE(PG8_SA(0, 1), cA + hstep, voffA);
        if (wr == 1) PG8_BAR;
        PG8_WAIT_V(4); PG8_BAR;
        PG8_STAGE(PG8_SB(1, 0), cB + kstep, voffB); PG8_STAGE(PG8_SA(1, 0), cA + kstep, voffA); PG8_STAGE(PG8_SB(1, 1), cB + hstep + kstep, voffB);
        PG8_WAIT_V(6); PG8_BAR;
    }
    for (;;) {
        const bool has_next = S.next(ui + 1, nxt);
        const char* nA = has_next ? (const char*)g.A + (size_t)nxt.pm * tstep : cA; const char* nB = has_next ? (const char*)g.Bt + (size_t)nxt.pn * tstep : cB;
        for (int t = 0; t < nt; t += 2) {
            const bool last = (t == nt - 2);
            const char* a1 = cA + (size_t)(t + 1) * kstep;
            const char* a2 = last ? nA : cA + (size_t)(t + 2) * kstep; const char* b2 = last ? nB : cB + (size_t)(t + 2) * kstep;
            const char* a3 = a2 + kstep; const char* b3 = b2 + kstep;
            if (last && has_next) S.a_ready(nxt);
            if constexpr (SP2) {
            PG8_LDB(B0, 0, 0); PG8_LDB(B1, 0, 1); PG8_SCHED; PG8_LDA(At, 0, 0); PG8_STAGE(PG8_SA(1, 1), a1 + hstep, voffA);
            PG8_WAIT_V(8); PG8_WAIT_L(0); PG8_BAR; PG8_MMA(0, 0, At, B0); PG8_MMA(0, 1, At, B1); PG8_BAR; PG8_SCHED;
            PG8_LDA(At, 0, 1); PG8_STAGE(PG8_SB(0, 0), b2, voffB); PG8_STAGE(PG8_SB(0, 1), b2 + hstep, voffB); PG8_STAGE(PG8_SA(0, 0), a2, voffA);
            PG8_WAIT_V(8); PG8_WAIT_L(0); PG8_BAR; PG8_MMA(1, 0, At, B0); PG8_MMA(1, 1, At, B1); PG8_BAR; PG8_SCHED;
            PG8_LDB(B0, 1, 0); PG8_LDB(B1, 1, 1); PG8_SCHED; PG8_LDA(At, 1, 0); PG8_STAGE(PG8_SA(0, 1), a2 + hstep, voffA);
            PG8_WAIT_V(8); PG8_WAIT_L(0); PG8_BAR; PG8_MMA(0, 0, At, B0); PG8_MMA(0, 1, At, B1); PG8_BAR; PG8_SCHED;
            PG8_LDA(At, 1, 1); PG8_STAGE(PG8_SB(1, 0), b3, voffB); PG8_STAGE(PG8_SB(1, 1), b3 + hstep, voffB); PG8_STAGE(PG8_SA(1, 0), a3, voffA);
            PG8_WAIT_V(8); PG8_WAIT_L(0); PG8_BAR; PG8_MMA(1, 0, At, B0); PG8_MMA(1, 1, At, B1); PG8_BAR; PG8_SCHED;
            } else {
            PG8_LDB(B0, 0, 0); PG8_SCHED; PG8_LDA(At, 0, 0); PG8_STAGE(PG8_SA(1, 1), a1 + hstep, voffA);
            PG8_WAIT_L(8); PG8_BAR; PG8_WAIT_L(0); PG8_MMA(0, 0, At, B0); PG8_BAR; PG8_SCHED;
            PG8_LDB(B1, 0, 1); PG8_STAGE(PG8_SB(0, 0), b2, voffB);
            PG8_BAR; PG8_WAIT_L(0); PG8_MMA(0, 1, At, B1); PG8_BAR;
            PG8_LDA(At, 0, 1); PG8_STAGE(PG8_SA(0, 0), a2, voffA);
            PG8_BAR; PG8_WAIT_L(0); PG8_MMA(1, 0, At, B0); PG8_BAR; PG8_SCHED;
            PG8_STAGE(PG8_SB(0, 1), b2 + hstep, voffB);
            PG8_WAIT_V(6); PG8_BAR; PG8_MMA(1, 1, At, B1); PG8_BAR;
            PG8_LDB(B0, 1, 0); PG8_SCHED; PG8_LDA(At, 1, 0); PG8_STAGE(PG8_SA(0, 1), a2 + hstep, voffA);
            PG8_WAIT_L(8); PG8_BAR; PG8_WAIT_L(0); PG8_MMA(0, 0, At, B0); PG8_BAR; PG8_SCHED;
            PG8_LDB(B1, 1, 1); PG8_STAGE(PG8_SB(1, 0), b3, voffB);
            PG8_BAR; PG8_WAIT_L(0); PG8_MMA(0, 1, At, B1); PG8_BAR;
            PG8_LDA(At, 1, 1); PG8_STAGE(PG8_SA(1, 0), a3, voffA);
            PG8_BAR; PG8_WAIT_L(0); PG8_MMA(1, 0, At, B0); PG8_BAR; PG8_SCHED;
            PG8_STAGE(PG8_SB(1, 1), b3 + hstep, voffB);
            PG8_WAIT_V(6); PG8_BAR; PG8_MMA(1, 1, At, B1); PG8_BAR;
            }
        }
        if constexpr (ALIGN_EPI) { if (wr == 0) PG8_BAR; }
        if constexpr (!Epi::AFTER_DRAIN) { E(acc, cur, wr, wc, fr, fq); S.done(cur); }
        if (!has_next) break;
#pragma unroll
        for (int a = 0; a < 2; ++a)
#pragma unroll
            for (int b = 0; b < 2; ++b)
#pragma unroll
                for (int m = 0; m < 4; ++m)
#pragma unroll
                    for (int n = 0; n < 2; ++n) acc[a][b][m][n] = (f32x4){0.f, 0.f, 0.f, 0.f};
        cur = nxt; cA = nA; cB = nB; ++ui;
        if constexpr (ALIGN_EPI) { if (wr == 1) PG8_BAR; }
    }
    PG8_WAIT_V(0);
    if constexpr (!ALIGN_EPI) { if (wr == 0) PG8_BAR; }
    PG8_BAR;
    if constexpr (Epi::AFTER_DRAIN) { E.fused(acc, cur, wr, wc, fr, fq, lds, wid, lane); S.done(cur); }
#undef PG8_SA
#undef PG8_SB
#undef PG8_STAGE
#undef PG8_LDA
#undef PG8_LDB
#undef PG8_MMA
#undef PG8_WAIT_V
#undef PG8_WAIT_L
#undef PG8_BAR
#undef PG8_SCHED
}
}
#define GAS __attribute__((address_space(1)))
#define LAS __attribute__((address_space(3)))
typedef unsigned short bf16;
typedef unsigned v4u __attribute__((ext_vector_type(4)));
typedef float f32x4 __attribute__((ext_vector_type(4)));
typedef short bf16x8 __attribute__((ext_vector_type(8)));
typedef GAS unsigned gu32;
typedef GAS unsigned long long gu64;
#define RLX_AGENT __ATOMIC_RELAXED, __HIP_MEMORY_SCOPE_AGENT
#define LDS_WAIT() asm volatile("s_waitcnt lgkmcnt(0)" ::: "memory")
#define VM_WAIT() asm volatile("s_waitcnt vmcnt(0)" ::: "memory")
__device__ __forceinline__ unsigned long long rt() { return __builtin_amdgcn_s_memrealtime(); }
__device__ __forceinline__ unsigned f2bf(float f) { unsigned u = __builtin_bit_cast(unsigned, f); return (u + 0x7fffu + ((u >> 16) & 1u)) >> 16; }
__device__ __forceinline__ unsigned pk2(float lo, float hi) { return f2bf(lo) | (f2bf(hi) << 16); }

#define XB_TMO      128
#define XB_XCNT(j)  (256  + 64 * (j))
#define XB_XSUB(j)  (1280 + 64 * (j))
#define XB_XGEN(j)  (2304 + 64 * (j))
#define XB_TOP      3328
#define XB_TOPGEN   3392
#define XCD_BAR_WORDS 3456
#define XB_SPIN_CAP (1u << 18)

__device__ __forceinline__ unsigned xb_ld(unsigned* p)              { return __hip_atomic_load(p, __ATOMIC_RELAXED, __HIP_MEMORY_SCOPE_AGENT); }
__device__ __forceinline__ unsigned xb_add(unsigned* p, unsigned v) { return __hip_atomic_fetch_add(p, v, __ATOMIC_RELAXED, __HIP_MEMORY_SCOPE_AGENT); }
__device__ __forceinline__ unsigned xb_xcc_id() { return (unsigned)__builtin_amdgcn_s_getreg((3 << 11) | 20) & 0xFu; }
#define XB_SPIN(cond, bar) do { unsigned _sp = 0; while (cond) { __builtin_amdgcn_s_sleep(1); \
    if ((++_sp & 255u) == 0u) { if (xb_ld(&(bar)[XB_TMO])) break; if (_sp > XB_SPIN_CAP) { atomicAdd(&(bar)[XB_TMO], 1u); break; } } } } while (0)

struct XcdBarrier {
    unsigned* bar; unsigned x;
    volatile LAS unsigned* st;
};

__device__ __forceinline__ XcdBarrier xcd_barrier_post(unsigned* bar, volatile LAS unsigned* st) {
    XcdBarrier b; b.bar = bar; b.x = xb_xcc_id(); b.st = st;
    if (threadIdx.x == 0) (void)xb_add(&bar[XB_XCNT(b.x)], 1u);
    return b;
}
__device__ __forceinline__ void xcd_barrier_complete(unsigned* bar, unsigned x, unsigned& nloc, unsigned& nx) {
    const unsigned G = gridDim.x * gridDim.y * gridDim.z;
    unsigned sum, cnt, mine, sp = 0u;
    for (;;) {
        sum = 0u; cnt = 0u; mine = 0u;
#pragma unroll
        for (unsigned j = 0; j < 16; ++j) { const unsigned c = xb_ld(&bar[XB_XCNT(j)]); sum += c; cnt += (c > 0u) ? 1u : 0u; mine = (j == x) ? c : mine; }
        if (sum == G) break;
        __builtin_amdgcn_s_sleep(1);
        if ((++sp & 255u) == 0u) { if (xb_ld(&bar[XB_TMO])) break; if (sp > XB_SPIN_CAP) { atomicAdd(&bar[XB_TMO], 1u); break; } }
    }
    nloc = mine > 0u ? mine : 1u; nx = cnt > 0u ? cnt : 1u;
}

__device__ __forceinline__ void xcd_barrier(const XcdBarrier& b) {
    asm volatile("s_waitcnt vmcnt(0)" ::: "memory");
    __syncthreads();
    int tid0_ = threadIdx.x; asm volatile("" : "+v"(tid0_));
    if (tid0_ == 0) {
        unsigned* bar = b.bar;
        __builtin_amdgcn_s_waitcnt(0);
        unsigned nloc = b.st[0], nx = b.st[1];
        if (nloc == 0u) { xcd_barrier_complete(bar, b.x, nloc, nx); b.st[0] = nloc; b.st[1] = nx; }
        const unsigned old = xb_add(&bar[XB_XSUB(b.x)], 1u);
        const unsigned gen = old / nloc;
        if (old + 1u == (gen + 1u) * nloc) {
            __builtin_amdgcn_fence(__ATOMIC_RELEASE, "agent");
            asm volatile("s_waitcnt vmcnt(0)" ::: "memory");
            const unsigned og = xb_add(&bar[XB_TOP], 1u);
            const unsigned tg = og / nx;
            if (og + 1u == (tg + 1u) * nx) xb_add(&bar[XB_TOPGEN], 1u);
            else XB_SPIN(xb_ld(&bar[XB_TOPGEN]) == tg, bar);
            __builtin_amdgcn_fence(__ATOMIC_ACQUIRE, "agent");
            xb_add(&bar[XB_XGEN(b.x)], 1u);
            asm volatile("s_waitcnt vmcnt(0)" ::: "memory");
        } else {
            XB_SPIN(xb_ld(&bar[XB_XGEN(b.x)]) == gen, bar);
            __builtin_amdgcn_fence(__ATOMIC_ACQUIRE, "agent");
            asm volatile("s_waitcnt vmcnt(0)" ::: "memory");
        }
    }
    __syncthreads();
}

constexpr int NWAVES = 8, NTHR = 512;
constexpr int D = 1024, FF = 2816, NPJ = 3462, NPP = 3584;
constexpr int TP = 16384, TS = 128, TOK = TP + TS, MP = 16640;
constexpr int DEPTH = 4;
constexpr int C_Q = 1024, C_K = 1408, C_V = 1792, C_Z = 2176, C_XBC = 2560, C_DT = 3456;
constexpr float NORM_EPS = 1e-6f, GN_EPS = 64e-5f, NEG_INF = -1e30f;
constexpr size_t O_YP = 0, O_YS = 16777216, O_PK = 16908288, O_PV = 42074112, O_PSH = 67239936, O_PR = 67272704, O_PC = 67796992, O_PS = 67883008,
                 O_SK = 69455872, O_SV = 69652480, O_SSH = 69849088, O_SR = 69980160, O_SC = 72077312, O_SS = 72421376, O_END = 78712832;
constexpr size_t MiB = 1u << 20;
constexpr size_t WS_CTL = 0, CTL_ZERO_BYTES = 1 * MiB;
constexpr size_t SZ_WGU = (size_t)2 * FF * D * 2, SZ_WD = (size_t)D * FF * 2, SZ_WIN = (size_t)NPP * D * 2, SZ_WOUT = (size_t)D * D * 2;
constexpr size_t WL_GU1 = 0, WL_D1 = WL_GU1 + SZ_WGU, WL_IN = WL_D1 + SZ_WD, WL_OUT = WL_IN + SZ_WIN, WL_GU2 = WL_OUT + SZ_WOUT, WL_D2 = WL_GU2 + SZ_WGU, WL_SIZE = WL_D2 + SZ_WD;
static_assert(WL_SIZE == 44040192, "per-layer bf16 weight bytes");
constexpr size_t WS_W = 2 * MiB;
constexpr size_t WS_X = 176 * MiB, WS_XB = 242 * MiB, WS_SSQ = 276 * MiB, WS_H = 280 * MiB, WS_P = 372 * MiB, WS_OPS = 488 * MiB, WS_G = 586 * MiB, WS_SC = 603 * MiB,
                 WS_YS = 604 * MiB, WS_XC = 622 * MiB, WS_DT = 651 * MiB, WS_YC = 652 * MiB, WS_AP = 678 * MiB, WS_AM = 752 * MiB, WS_AL = 754 * MiB, WS_YM = 756 * MiB, WS_END = 790 * MiB;
static_assert(WS_W + 4 * WL_SIZE <= WS_X && WS_X + (size_t)MP * D * 4 <= WS_XB && WS_XB + (size_t)MP * D * 2 <= WS_SSQ && WS_SSQ + (size_t)MP * 64 <= WS_H && WS_H + (size_t)MP * FF * 2 <= WS_P &&
              WS_P + (size_t)MP * NPP * 2 <= WS_OPS && WS_OPS + (size_t)TOK * 4 * 384 * 4 <= WS_G && WS_G + (size_t)TOK * 256 * 4 <= WS_SC && WS_SC + (size_t)TOK * 32 <= WS_YS &&
              WS_YS + (size_t)TOK * 256 * 4 <= WS_XC && WS_XC + (size_t)TOK * 896 * 2 <= WS_DT && WS_DT + (size_t)TOK * 32 <= WS_YC && WS_YC + (size_t)TOK * 384 * 4 <= WS_AP &&
              WS_AP + (size_t)3 * TOK * 384 * 4 <= WS_AM && WS_AM + (size_t)3 * TOK * 32 <= WS_AL && WS_AL + (size_t)3 * TOK * 32 <= WS_YM && WS_YM + (size_t)MP * D * 2 <= WS_END, "d_ws map");
constexpr int CW_BAR = 4096;
constexpr int CW_Q = 16384;
constexpr int RING_BYTES = 131072, LDSCTL_OFF = RING_BYTES, MISC_OFF = LDSCTL_OFF + 320, LDS_BYTES = 147456;

typedef unsigned v2u __attribute__((ext_vector_type(2)));

struct KArgs { const float* in[38]; float* out; unsigned char* ws; };
#define CAS __attribute__((address_space(4)))
struct KA {
    const CAS unsigned char* kp;
    __device__ __forceinline__ const float* in(int k) const { return *(const float* const CAS*)(kp + 8 * k); }
    __device__ __forceinline__ float* out() const { return *(float* const CAS*)(kp + 304); }
    __device__ __forceinline__ unsigned char* ws() const { return *(unsigned char* const CAS*)(kp + 312); }
};
__device__ __forceinline__ KA make_ka() { KA k; k.kp = (const CAS unsigned char*)__builtin_amdgcn_kernarg_segment_ptr(); asm volatile("" : "+s"(k.kp)); return k; }
__device__ __forceinline__ int fresh_tid() { int t = threadIdx.x; asm volatile("" : "+v"(t)); return t; }

__device__ __forceinline__ float bf2f(bf16 u) { return __uint_as_float((unsigned)u << 16); }
__device__ __forceinline__ float bflo(unsigned u) { return __uint_as_float(u << 16); }
__device__ __forceinline__ float bfhi(unsigned u) { return __uint_as_float(u & 0xffff0000u); }
__device__ __forceinline__ bf16 f2bf_s(float f) { unsigned u = __float_as_uint(f); return (bf16)((u + 0x7fffu + ((u >> 16) & 1u)) >> 16); }
template <int CTRL> __device__ __forceinline__ float dppf(float v) { return __builtin_bit_cast(float, __builtin_amdgcn_update_dpp(0, __builtin_bit_cast(int, v), CTRL, 0xF, 0xF, true)); }
__device__ __forceinline__ float red8(float v) { v += dppf<0xB1>(v); v += dppf<0x4E>(v); v += dppf<0x141>(v); return v; }
__device__ __forceinline__ float wave_sum(float v) { v += dppf<0xB1>(v); v += dppf<0x4E>(v); v += dppf<0x141>(v); v += dppf<0x140>(v); v = pg8::xsum16(v); return pg8::xsum32(v); }
__device__ __forceinline__ float wave_max(float v) { v = fmaxf(v, dppf<0xB1>(v)); v = fmaxf(v, dppf<0x4E>(v)); v = fmaxf(v, dppf<0x141>(v)); v = fmaxf(v, dppf<0x140>(v)); v = pg8::xmax16(v); return pg8::xmax32(v); }
__device__ __forceinline__ float sigmoidf_(float x) { return 1.0f / (1.0f + __expf(-x)); }
__device__ __forceinline__ float softplusf_(float x) { return fmaxf(x, 0.f) + log1pf(__expf(-fabsf(x))); }
template <int K> __device__ __forceinline__ f32x4 tile_mma(f32x4 acc, const LAS bf16* A, int lda, const LAS bf16* B, int ldb, int lane) {
    const LAS bf16* ap = A + (lane & 15) * lda + 8 * (lane >> 4); const LAS bf16* bp = B + (lane & 15) * ldb + 8 * (lane >> 4);
#pragma unroll
    for (int k = 0; k < K; k += 32) acc = __builtin_amdgcn_mfma_f32_16x16x32_bf16(*(const LAS bf16x8*)(ap + k), *(const LAS bf16x8*)(bp + k), acc, 0, 0, 0);
    return acc;
}

template <int MODE> __device__ __forceinline__ void tr_item(const float* W, int K, int N, const float* gain, bf16* WT, LAS float* scr, int kb, int nb, int lane) {
    const int k0 = 64 * kb, n0 = 32 * nb, nn = n0 + (lane & 31);
#pragma unroll 8
    for (int i = 0; i < 32; ++i) { const int kk = 2 * i + (lane >> 5); float v = (nn < N) ? W[(size_t)(k0 + kk) * N + nn] : 0.f; if (gain) v *= gain[k0 + kk]; scr[kk * 33 + (lane & 31)] = v; }
    asm volatile("s_waitcnt lgkmcnt(0)" ::: "memory");
    const int c = lane & 7;
#pragma unroll
    for (int j = 0; j < 4; ++j) { const int nl = (lane >> 3) + 8 * j, n = n0 + nl; const LAS float* s = scr + (8 * c) * 33 + nl;
        v4u o; o.x = pg8::cvt_pk_bf16(s[0 * 33], s[1 * 33]); o.y = pg8::cvt_pk_bf16(s[2 * 33], s[3 * 33]); o.z = pg8::cvt_pk_bf16(s[4 * 33], s[5 * 33]); o.w = pg8::cvt_pk_bf16(s[6 * 33], s[7 * 33]);
        const int drow = (MODE == 0) ? n : 8 * (n >> 2) + 4 * (MODE - 1) + (n & 3);
        *(v4u*)(WT + (size_t)drow * K + k0 + 8 * c) = o; }
    asm volatile("s_waitcnt lgkmcnt(0)" ::: "memory");
}
__device__ __forceinline__ void p0_prologue(const KA a, LAS unsigned char* lds, int tid) {
    const int lane = tid & 63, wave = __builtin_amdgcn_readfirstlane(tid >> 6), gw = blockIdx.x * NWAVES + wave; int NGW = gridDim.x * NWAVES; asm volatile("" : "+s"(NGW));
    LAS float* scr = (LAS float*)(lds + wave * 16384);
    constexpr int I_G = 16 * 88, I_D = 44 * 32, I_IN = 16 * 112, I_OUT = 16 * 32, I_LAYER = 6 * 1408 + I_IN + I_OUT;
    static_assert(I_G == 1408 && I_D == 1408, "items");
    for (int it = gw; it < DEPTH * I_LAYER; it += NGW) {
        const int l = it / I_LAYER; int r = it % I_LAYER;
        bf16* wl = (bf16*)(a.ws() + WS_W + (size_t)l * WL_SIZE);
        if (r < I_G) { tr_item<1>(a.in(9) + (size_t)l * D * FF, D, FF, a.in(8) + l * D, (bf16*)((unsigned char*)wl + WL_GU1), scr, r / 88, r % 88, lane); continue; } r -= I_G;
        if (r < I_G) { tr_item<2>(a.in(10) + (size_t)l * D * FF, D, FF, a.in(8) + l * D, (bf16*)((unsigned char*)wl + WL_GU1), scr, r / 88, r % 88, lane); continue; } r -= I_G;
        if (r < I_D) { tr_item<0>(a.in(11) + (size_t)l * D * FF, FF, D, nullptr, (bf16*)((unsigned char*)wl + WL_D1), scr, r / 32, r % 32, lane); continue; } r -= I_D;
        if (r < I_IN) { tr_item<0>(a.in(13) + (size_t)l * D * NPJ, D, NPJ, a.in(12) + l * D, (bf16*)((unsigned char*)wl + WL_IN), scr, r / 112, r % 112, lane); continue; } r -= I_IN;
        if (r < I_OUT) { tr_item<0>(a.in(32) + (size_t)l * D * D, D, D, nullptr, (bf16*)((unsigned char*)wl + WL_OUT), scr, r / 32, r % 32, lane); continue; } r -= I_OUT;
        if (r < I_G) { tr_item<1>(a.in(34) + (size_t)l * D * FF, D, FF, a.in(33) + l * D, (bf16*)((unsigned char*)wl + WL_GU2), scr, r / 88, r % 88, lane); continue; } r -= I_G;
        if (r < I_G) { tr_item<2>(a.in(35) + (size_t)l * D * FF, D, FF, a.in(33) + l * D, (bf16*)((unsigned char*)wl + WL_GU2), scr, r / 88, r % 88, lane); continue; } r -= I_G;
        tr_item<0>(a.in(36) + (size_t)l * D * FF, FF, D, nullptr, (bf16*)((unsigned char*)wl + WL_D2), scr, r / 32, r % 32, lane);
    }
    float* X = (float*)(a.ws() + WS_X); bf16* XB = (bf16*)(a.ws() + WS_XB); float* SSQ = (float*)(a.ws() + WS_SSQ); bf16* YM = (bf16*)(a.ws() + WS_YM);
    for (int m = gw; m < MP; m += NGW) {
        const float* src = (m < TP) ? a.in(0) + (size_t)m * D : a.in(1) + (size_t)(m - TP) * D;
        f32x4 v[4]; float s = 0.f;
#pragma unroll
        for (int j = 0; j < 4; ++j) { v[j] = (m < TOK) ? ((const f32x4*)src)[lane + 64 * j] : (f32x4){0.f, 0.f, 0.f, 0.f}; s += (v[j][0] * v[j][0] + v[j][1] * v[j][1]) + (v[j][2] * v[j][2] + v[j][3] * v[j][3]); }
        s = wave_sum(s);
#pragma unroll
        for (int j = 0; j < 4; ++j) { ((f32x4*)(X + (size_t)m * D))[lane + 64 * j] = v[j];
            v2u w; w.x = pg8::cvt_pk_bf16(v[j][0], v[j][1]); w.y = pg8::cvt_pk_bf16(v[j][2], v[j][3]); ((v2u*)(XB + (size_t)m * D))[lane + 64 * j] = w;
            if (m >= TOK) ((v2u*)(YM + (size_t)m * D))[lane + 64 * j] = (v2u){0u, 0u}; }
        if (lane < 16) SSQ[(size_t)m * 16 + lane] = (lane == 0) ? s : 0.f;
    }
}

__device__ __forceinline__ void rwkv_prep_tile(const KA a, int l, int tile, LAS unsigned char* lds, int tid) {
    LAS float* rkv = (LAS float*)lds;
    LAS float* wl = rkv + 16 * 768;
    LAS float* al = wl + 64 * 16;
    LAS float* gl = al + 64 * 16;
    const bf16* P = (const bf16*)(a.ws() + WS_P);
    const float* mu = a.in(14) + l * 1024;
    const int row0 = tile * 16;
    for (int idx = tid; idx < 16 * 1024; idx += NTHR) {
        const int t = idx >> 10, col = idx & 1023, row = row0 + t;
        const float p = bf2f(P[(size_t)row * NPP + col]);
        float pp;
        if (row < TP) pp = ((row & 2047) == 0) ? 0.f : bf2f(P[(size_t)(row - 1) * NPP + col]);
        else { const int r = row - TP; pp = ((r & 3) == 0) ? a.in(4)[(size_t)(l * 32 + (r >> 2)) * 1024 + col] : bf2f(P[(size_t)(row - 1) * NPP + col]); }
        const float ps = p + mu[col] * (pp - p);
        if (col < 768) rkv[t * 768 + col] = ps;
        else if (col < 832) wl[(col - 768) * 16 + t] = tanhf(ps);
        else if (col < 896) al[(col - 832) * 16 + t] = ps;
        else gl[(col - 896) * 16 + t] = sigmoidf_(ps);
    }
    __syncthreads();
    const int c = tid & 255, hf = tid >> 8, lane = tid & 63, h = c >> 6, j = c & 63;
    float wa[8], aa[8], ga[8];
#pragma unroll
    for (int i = 0; i < 8; ++i) { wa[i] = 0.f; aa[i] = 0.f; ga[i] = 0.f; }
    const float* w2 = a.in(16) + (size_t)l * 64 * 256 + c; const float* a2 = a.in(18) + (size_t)l * 64 * 256 + c; const float* g2 = a.in(19) + (size_t)l * 128 * 256 + c;
#pragma unroll 4
    for (int k = 0; k < 64; ++k) { const float wv = w2[k * 256], av = a2[k * 256];
        const f32x4 x0 = *(const LAS f32x4*)(wl + k * 16 + hf * 8), x1 = *(const LAS f32x4*)(wl + k * 16 + hf * 8 + 4), y0 = *(const LAS f32x4*)(al + k * 16 + hf * 8), y1 = *(const LAS f32x4*)(al + k * 16 + hf * 8 + 4);
#pragma unroll
        for (int i = 0; i < 4; ++i) { wa[i] += wv * x0[i]; wa[4 + i] += wv * x1[i]; aa[i] += av * y0[i]; aa[4 + i] += av * y1[i]; } }
#pragma unroll 4
    for (int k = 0; k < 128; ++k) { const float gv = g2[k * 256]; const f32x4 x0 = *(const LAS f32x4*)(gl + k * 16 + hf * 8), x1 = *(const LAS f32x4*)(gl + k * 16 + hf * 8 + 4);
#pragma unroll
        for (int i = 0; i < 4; ++i) { ga[i] += gv * x0[i]; ga[4 + i] += gv * x1[i]; } }
    const float w0 = a.in(15)[l * 256 + c], a0 = a.in(17)[l * 256 + c], k_k = a.in(20)[l * 256 + c], k_a = a.in(21)[l * 256 + c], r_k = a.in(22)[l * 256 + c];
    float* OPS = (float*)(a.ws() + WS_OPS); float* G = (float*)(a.ws() + WS_G); float* SC = (float*)(a.ws() + WS_SC);
#pragma unroll
    for (int i = 0; i < 8; ++i) {
        const int t = hf * 8 + i, row = row0 + t;
        const float wlog = -softplusf_(-(w0 + wa[i])) - 0.5f, w = __expf(-__expf(wlog)), av = sigmoidf_(a0 + aa[i]);
        const float r = rkv[t * 768 + c], k = rkv[t * 768 + 256 + c], v = rkv[t * 768 + 512 + c];
        const float kkr = k * k_k, n2 = wave_sum(kkr * kkr), kk = kkr / fmaxf(sqrtf(n2), 1e-12f);
        const float kt = k * (1.f + (av - 1.f) * k_a), bb = kk * av;
        const float br = wave_sum(bb * r), kr = wave_sum(kt * r), bon = wave_sum(r * kt * r_k);
        float* o = OPS + ((size_t)(row * 4 + h) * 6) * 64 + j;
        o[0] = -kk; o[64] = w * r - kk * br; o[128] = w; o[192] = bb; o[256] = kt; o[320] = v;
        G[(size_t)row * 256 + c] = ga[i];
        if (lane == 0) { SC[(size_t)(row * 4 + h) * 2] = kr; SC[(size_t)(row * 4 + h) * 2 + 1] = bon; }
    }
    __syncthreads();
}

__device__ __forceinline__ void prep_elementwise(const KA a, int l, int tid) {
    const int gtid = blockIdx.x * NTHR + tid; int GT = gridDim.x * NTHR; asm volatile("" : "+s"(GT));
    const bf16* P = (const bf16*)(a.ws() + WS_P); bf16* XC = (bf16*)(a.ws() + WS_XC); float* DT = (float*)(a.ws() + WS_DT); float* out = a.out();
    const float* cw = a.in(26) + (size_t)l * 4 * 896; const float* cb = a.in(27) + l * 896;
    for (int idx = gtid; idx < TOK * 896; idx += GT) {
        const int row = idx / 896, col = idx - row * 896;
        int t, b = 0; if (row < TP) t = row & 2047; else { const int r = row - TP; b = r >> 2; t = r & 3; }
        float acc = cb[col];
#pragma unroll
        for (int i = 0; i < 4; ++i) { const int tt = t - 3 + i; float xv;
            if (tt >= 0) xv = bf2f(P[(size_t)(row - 3 + i) * NPP + C_XBC + col]); else xv = (row < TP) ? 0.f : a.in(6)[((size_t)(l * 32 + b) * 3 + (3 + tt)) * 896 + col];
            acc += cw[i * 896 + col] * xv; }
        XC[(size_t)row * 896 + col] = f2bf_s(acc * sigmoidf_(acc));
    }
    for (int idx = gtid; idx < TOK * 6; idx += GT) { const int row = idx / 6, h = idx - row * 6;
        DT[(size_t)row * 8 + h] = softplusf_(bf2f(P[(size_t)row * NPP + C_DT + h]) + a.in(28)[l * 6 + h]); }
    for (int idx = gtid; idx < TOK * 96; idx += GT) { const int row = idx / 96, c8 = idx - row * 96, which = c8 / 48, cc = (c8 - which * 48) * 8;
        const v4u w = *(const v4u*)(P + (size_t)row * NPP + C_K + c8 * 8);
        float* dst = (row < TP) ? out + (which ? O_PV : O_PK) + ((size_t)l * TP + row) * 384 + cc : out + (which ? O_SV : O_SK) + ((size_t)l * TS + (row - TP)) * 384 + cc;
        *(f32x4*)dst = (f32x4){bflo(w.x), bfhi(w.x), bflo(w.y), bfhi(w.y)}; *(f32x4*)(dst + 4) = (f32x4){bflo(w.z), bfhi(w.z), bflo(w.w), bfhi(w.w)}; }
    for (int idx = gtid; idx < 40 * 1024; idx += GT) { const int s = idx >> 10, col = idx & 1023;
        const int row = (s < 8) ? s * 2048 + 2047 : TP + (s - 8) * 4 + 3;
        float* dst = (s < 8) ? out + O_PSH + (size_t)(l * 8 + s) * 1024 + col : out + O_SSH + (size_t)(l * 32 + s - 8) * 1024 + col;
        *dst = bf2f(P[(size_t)row * NPP + col]); }
    for (int idx = gtid; idx < 40 * 2688; idx += GT) { const int s = idx / 2688, rem = idx - s * 2688, i = rem / 896, col = rem - i * 896;
        const int row = (s < 8) ? s * 2048 + 2045 + i : TP + (s - 8) * 4 + 1 + i;
        float* dst = (s < 8) ? out + O_PC + ((size_t)(l * 8 + s) * 3 + i) * 896 + col : out + O_SC + ((size_t)(l * 32 + s - 8) * 3 + i) * 896 + col;
        *dst = bf2f(P[(size_t)row * NPP + C_XBC + col]); }
}

__device__ __forceinline__ void rwkv_scan_unit(const KA a, int l, int unit, LAS unsigned char* lds, int tid) {
    int b, h, row_base, T; const float* s0; float* sout;
    if (unit < 32) { b = unit >> 2; h = unit & 3; row_base = b * 2048; T = 2048; s0 = nullptr; sout = a.out() + O_PR + (size_t)((l * 8 + b) * 4 + h) * 4096; }
    else { const int u = unit - 32; b = u >> 2; h = u & 3; row_base = TP + b * 4; T = 4; s0 = a.in(5) + (size_t)((l * 32 + b) * 4 + h) * 4096; sout = a.out() + O_SR + (size_t)((l * 32 + b) * 4 + h) * 4096; }
    const int lane = tid & 63, wave = __builtin_amdgcn_readfirstlane(tid >> 6), rl = lane >> 3, seg = lane & 7, i = wave * 8 + rl;
    float S[8];
#pragma unroll
    for (int j = 0; j < 8; ++j) S[j] = s0 ? s0[i * 64 + seg * 8 + j] : 0.f;
    const float* OPS = (const float*)(a.ws() + WS_OPS); float* YS = (float*)(a.ws() + WS_YS);
    LAS float* buf = (LAS float*)lds;
    const int nch = (T + 31) >> 5;
    f32x4 stg[6];
#pragma unroll
    for (int q = 0; q < 6; ++q) { const int idx = tid + NTHR * q, t = idx / 96, e = idx - t * 96;
        stg[q] = (t < T) ? *(const f32x4*)(OPS + (size_t)((row_base + t) * 4 + h) * 384 + e * 4) : (f32x4){0.f, 0.f, 0.f, 0.f};
        *(LAS f32x4*)(buf + t * 384 + e * 4) = stg[q]; }
    __syncthreads();
    for (int c = 0; c < nch; ++c) {
        const LAS float* cur = buf + (c & 1) * (32 * 384);
        if (c + 1 < nch) {
#pragma unroll
            for (int q = 0; q < 6; ++q) { const int idx = tid + NTHR * q, t = idx / 96, e = idx - t * 96, tt = (c + 1) * 32 + t;
                stg[q] = (tt < T) ? *(const f32x4*)(OPS + (size_t)((row_base + tt) * 4 + h) * 384 + e * 4) : (f32x4){0.f, 0.f, 0.f, 0.f}; }
        }
        const int nst = (T - c * 32) < 32 ? (T - c * 32) : 32;
        for (int t = 0; t < nst; ++t) {
            const LAS float* o = cur + t * 384 + seg * 8;
            const f32x4 n0 = *(const LAS f32x4*)(o), n1 = *(const LAS f32x4*)(o + 4), r0 = *(const LAS f32x4*)(o + 64), r1 = *(const LAS f32x4*)(o + 68);
            const f32x4 w0 = *(const LAS f32x4*)(o + 128), w1 = *(const LAS f32x4*)(o + 132), b0 = *(const LAS f32x4*)(o + 192), b1 = *(const LAS f32x4*)(o + 196);
            const f32x4 k0 = *(const LAS f32x4*)(o + 256), k1 = *(const LAS f32x4*)(o + 260);
            const float v = cur[t * 384 + 320 + i];
            float sa = 0.f, y = 0.f;
#pragma unroll
            for (int j = 0; j < 4; ++j) { sa += S[j] * n0[j]; sa += S[4 + j] * n1[j]; y += S[j] * r0[j]; y += S[4 + j] * r1[j]; }
            sa = red8(sa); y = red8(y);
#pragma unroll
            for (int j = 0; j < 4; ++j) { S[j] = S[j] * w0[j] + (sa * b0[j] + v * k0[j]); S[4 + j] = S[4 + j] * w1[j] + (sa * b1[j] + v * k1[j]); }
            if (seg == 0) YS[(size_t)(row_base + c * 32 + t) * 256 + h * 64 + i] = y;
        }
        if (c + 1 < nch) {
            LAS float* nxt = buf + ((c + 1) & 1) * (32 * 384);
#pragma unroll
            for (int q = 0; q < 6; ++q) { const int idx = tid + NTHR * q, t = idx / 96, e = idx - t * 96; *(LAS f32x4*)(nxt + t * 384 + e * 4) = stg[q]; }
        }
        __syncthreads();
    }
#pragma unroll
    for (int j = 0; j < 8; ++j) sout[i * 64 + seg * 8 + j] = S[j];
}

constexpr int SD_PC = 136, SD_PX = 72;
__device__ __forceinline__ void ssd_unit(const KA a, int l, int unit, LAS unsigned char* lds, int tid) {
    int b, h, row_base, T; const float* h0; float* hout;
    if (unit < 48) { b = unit / 6; h = unit - b * 6; row_base = b * 2048; T = 2048; h0 = nullptr; hout = a.out() + O_PS + (size_t)((l * 8 + b) * 6 + h) * 8192; }
    else { const int u = unit - 48; b = u / 6; h = u - b * 6; row_base = TP + b * 4; T = 4; h0 = a.in(7) + (size_t)((l * 32 + b) * 6 + h) * 8192; hout = a.out() + O_SS + (size_t)((l * 32 + b) * 6 + h) * 8192; }
    const int g = h / 3, lane = tid & 63, wave = __builtin_amdgcn_readfirstlane(tid >> 6), fr = lane & 15, fq = lane >> 4;
    LAS bf16* Cs = (LAS bf16*)lds;
    LAS bf16* Bs = Cs + 64 * SD_PC;
    LAS bf16* hb = Bs + 64 * SD_PC;
    LAS bf16* BsT = hb + 64 * SD_PC;
    LAS bf16* xT = BsT + 128 * SD_PX;
    LAS bf16* Sc = xT + 64 * SD_PX;
    LAS float* acum = (LAS float*)(Sc + 64 * SD_PX);
    LAS float* dtv = acum + 64; LAS float* eac = dtv + 64; LAS float* toe = eac + 64;
    const bf16* XC = (const bf16*)(a.ws() + WS_XC); const float* DT = (const float*)(a.ws() + WS_DT); float* YC = (float*)(a.ws() + WS_YC);
    const float A = -__expf(a.in(29)[l * 6 + h]), Dh = a.in(30)[l * 6 + h];
    const int pt = wave >> 1, nt0 = (wave & 1) * 4;
    f32x4 hs[4];
#pragma unroll
    for (int q = 0; q < 4; ++q)
#pragma unroll
        for (int e = 0; e < 4; ++e) hs[q][e] = h0 ? h0[(size_t)(16 * pt + 4 * fq + e) * 128 + 16 * (nt0 + q) + fr] : 0.f;
    const int nch = (T + 63) >> 6;
    for (int c = 0; c < nch; ++c) {
        const int r0 = row_base + c * 64, nv = (T - c * 64) < 64 ? (T - c * 64) : 64;
        if (tid < 64) { const float dt = (tid < nv) ? DT[(size_t)(r0 + tid) * 8 + h] : 0.f; dtv[tid] = dt; toe[tid] = dt * A; }
        __syncthreads();
        if (wave == 0) {
            float s = 0.f, tot = 0.f;
#pragma unroll
            for (int q = 0; q < 16; ++q) { const f32x4 v = *(const LAS f32x4*)(toe + 4 * q);
#pragma unroll
                for (int e = 0; e < 4; ++e) { tot += v[e]; s += (4 * q + e <= lane) ? v[e] : 0.f; } }
            const float dt = dtv[lane];
            asm volatile("s_waitcnt lgkmcnt(0)" ::: "memory");
            acum[lane] = s; eac[lane] = __expf(s); toe[lane] = __expf(tot - s) * dt;
        }
#pragma unroll
        for (int q = 0; q < 4; ++q)
#pragma unroll
            for (int e = 0; e < 4; ++e) hb[(16 * pt + 4 * fq + e) * SD_PC + 16 * (nt0 + q) + fr] = f2bf_s(hs[q][e]);
#pragma unroll
        for (int q = 0; q < 2; ++q) { const int idx = tid + NTHR * q, r = idx >> 4, pc = idx & 15;
            v4u vc = (v4u){0u, 0u, 0u, 0u}, vb = vc;
            if (r < nv) { vc = *(const v4u*)(XC + (size_t)(r0 + r) * 896 + 640 + g * 128 + pc * 8); vb = *(const v4u*)(XC + (size_t)(r0 + r) * 896 + 384 + g * 128 + pc * 8); }
            *(LAS v4u*)(Cs + r * SD_PC + pc * 8) = vc; *(LAS v4u*)(Bs + r * SD_PC + pc * 8) = vb; }
        __syncthreads();
#pragma unroll
        for (int q = 0; q < 2; ++q) { const int idx = tid + NTHR * q, r = idx >> 4, pc = idx & 15; const float te = toe[r];
            const v4u vb = *(const LAS v4u*)(Bs + r * SD_PC + pc * 8); const unsigned wv[4] = {vb.x, vb.y, vb.z, vb.w};
#pragma unroll
            for (int e = 0; e < 4; ++e) { BsT[(pc * 8 + 2 * e) * SD_PX + r] = f2bf_s(bflo(wv[e]) * te); BsT[(pc * 8 + 2 * e + 1) * SD_PX + r] = f2bf_s(bfhi(wv[e]) * te); } }
        { const int r = tid >> 3, pc = tid & 7; v4u vx = (v4u){0u, 0u, 0u, 0u};
          if (r < nv) vx = *(const v4u*)(XC + (size_t)(r0 + r) * 896 + h * 64 + pc * 8);
          const unsigned wv[4] = {vx.x, vx.y, vx.z, vx.w};
#pragma unroll
          for (int e = 0; e < 4; ++e) { xT[(pc * 8 + 2 * e) * SD_PX + r] = (bf16)(wv[e] & 0xffffu); xT[(pc * 8 + 2 * e + 1) * SD_PX + r] = (bf16)(wv[e] >> 16); } }
        const int lt = wave >> 1;
#pragma unroll
        for (int q = 0; q < 2; ++q) { const int st = (wave & 1) * 2 + q;
            f32x4 gacc = tile_mma<128>((f32x4){0.f, 0.f, 0.f, 0.f}, Cs + lt * 16 * SD_PC, SD_PC, Bs + st * 16 * SD_PC, SD_PC, lane);
            const int s = 16 * st + fr; const float as = acum[s], ds = dtv[s];
#pragma unroll
            for (int e = 0; e < 4; ++e) { const int ll = 16 * lt + 4 * fq + e; const float v = (s <= ll) ? gacc[e] * __expf(acum[ll] - as) * ds : 0.f; Sc[ll * SD_PX + s] = f2bf_s(v); } }
        __syncthreads();
#pragma unroll
        for (int q = 0; q < 2; ++q) { const int ptl = (wave & 1) * 2 + q;
            const f32x4 yi = tile_mma<64>((f32x4){0.f, 0.f, 0.f, 0.f}, Sc + lt * 16 * SD_PX, SD_PX, xT + ptl * 16 * SD_PX, SD_PX, lane);
            const f32x4 yo = tile_mma<128>((f32x4){0.f, 0.f, 0.f, 0.f}, Cs + lt * 16 * SD_PC, SD_PC, hb + ptl * 16 * SD_PC, SD_PC, lane);
            const int p = 16 * ptl + fr;
#pragma unroll
            for (int e = 0; e < 4; ++e) { const int ll = 16 * lt + 4 * fq + e;
                if (ll < nv) YC[(size_t)(r0 + ll) * 384 + h * 64 + p] = yi[e] + eac[ll] * yo[e] + Dh * bf2f(xT[p * SD_PX + ll]); } }
        { const float cd = eac[63];
#pragma unroll
          for (int q = 0; q < 4; ++q) { hs[q] = hs[q] * cd; hs[q] = tile_mma<64>(hs[q], xT + pt * 16 * SD_PX, SD_PX, BsT + (nt0 + q) * 16 * SD_PX, SD_PX, lane); } }
        __syncthreads();
    }
#pragma unroll
    for (int q = 0; q < 4; ++q)
#pragma unroll
        for (int e = 0; e < 4; ++e) hout[(size_t)(16 * pt + 4 * fq + e) * 128 + 16 * (nt0 + q) + fr] = hs[q][e];
}

constexpr int AT_PV = 264;
__device__ __forceinline__ void attn_prompt_unit(const KA a, int l, int unit, LAS unsigned char* lds, int tid) {
    const int cn = unit & 15, br = (unit >> 4) % 3, bh = unit / 48, b = bh / 6, h = bh - b * 6;
    const int dil = (br == 0) ? 1 : (br == 1 ? 4 : 16), nblk = 16 / dil, cls = cn / nblk, n = cn - cls * nblk;
    const int lane = tid & 63, wave = __builtin_amdgcn_readfirstlane(tid >> 6), fr = lane & 15, fq = lane >> 4;
    const bf16* P = (const bf16*)(a.ws() + WS_P);
    LAS bf16* VT = (LAS bf16*)lds;
    const size_t rowb = (size_t)b * 2048;
    { const int kj = tid >> 1, hf = tid & 1; int ks = (n - 1) * 128 + kj; if (ks < 0) ks = 0;
      const bf16* src = P + (rowb + (size_t)ks * dil + cls) * NPP + C_V + h * 64 + hf * 32;
#pragma unroll
      for (int q = 0; q < 4; ++q) { const v4u w = *(const v4u*)(src + q * 8); const unsigned wv[4] = {w.x, w.y, w.z, w.w};
#pragma unroll
          for (int e = 0; e < 4; ++e) { VT[(hf * 32 + q * 8 + 2 * e) * AT_PV + kj] = (bf16)(wv[e] & 0xffffu); VT[(hf * 32 + q * 8 + 2 * e + 1) * AT_PV + kj] = (bf16)(wv[e] >> 16); } } }
    const int qi = 16 * wave + fr;
    const bf16* qp = P + (rowb + (size_t)(n * 128 + qi) * dil + cls) * NPP + C_Q + h * 64 + 8 * fq;
    const bf16x8 q0 = *(const bf16x8*)qp, q1 = *(const bf16x8*)(qp + 32);
    const float slope = exp2f(-8.0f * (float)(h + 1) / 6.0f) * (float)dil;
    f32x4 s[16];
    const int kt0 = (n == 0) ? 8 : 0;
#pragma unroll
    for (int kt = 0; kt < 16; ++kt) {
        if (kt >= kt0) {
            int ks = (n - 1) * 128 + 16 * kt + fr; if (ks < 0) ks = 0;
            const bf16* kp = P + (rowb + (size_t)ks * dil + cls) * NPP + C_K + h * 64 + 8 * fq;
            f32x4 acc = __builtin_amdgcn_mfma_f32_16x16x32_bf16(*(const bf16x8*)kp, q0, (f32x4){0.f, 0.f, 0.f, 0.f}, 0, 0, 0);
            acc = __builtin_amdgcn_mfma_f32_16x16x32_bf16(*(const bf16x8*)(kp + 32), q1, acc, 0, 0, 0);
#pragma unroll
            for (int e = 0; e < 4; ++e) { const int kj = 16 * kt + 4 * fq + e, delta = 128 + qi - kj;
                const bool ok = (delta >= 0) && (delta <= 128) && ((n - 1) * 128 + kj >= 0);
                acc[e] = ok ? acc[e] * 0.125f - slope * (float)delta : NEG_INF; }
            s[kt] = acc;
        } else s[kt] = (f32x4){NEG_INF, NEG_INF, NEG_INF, NEG_INF};
    }
    float m = NEG_INF;
#pragma unroll
    for (int kt = 0; kt < 16; ++kt) m = fmaxf(fmaxf(m, fmaxf(s[kt][0], s[kt][1])), fmaxf(s[kt][2], s[kt][3]));
    m = pg8::xmax16(m); m = pg8::xmax32(m);
    float lsum = 0.f;
#pragma unroll
    for (int kt = 0; kt < 16; ++kt)
#pragma unroll
        for (int e = 0; e < 4; ++e) { const float p = __expf(s[kt][e] - m); s[kt][e] = p; lsum += p; }
    lsum = pg8::xsum16(lsum); lsum = pg8::xsum32(lsum);
    __syncthreads();
    f32x4 o[4];
#pragma unroll
    for (int dt = 0; dt < 4; ++dt) o[dt] = (f32x4){0.f, 0.f, 0.f, 0.f};
#pragma unroll
    for (int jp = 0; jp < 8; ++jp) {
        union { bf16x8 v; unsigned u[4]; } pa;
        pa.u[0] = pg8::cvt_pk_bf16(s[2 * jp][0], s[2 * jp][1]); pa.u[1] = pg8::cvt_pk_bf16(s[2 * jp][2], s[2 * jp][3]);
        pa.u[2] = pg8::cvt_pk_bf16(s[2 * jp + 1][0], s[2 * jp + 1][1]); pa.u[3] = pg8::cvt_pk_bf16(s[2 * jp + 1][2], s[2 * jp + 1][3]);
#pragma unroll
        for (int dt = 0; dt < 4; ++dt) { const LAS bf16* vp = VT + (16 * dt + fr) * AT_PV + 32 * jp + 4 * fq;
            union { bf16x8 v; v2u u[2]; } vb; vb.u[0] = *(const LAS v2u*)vp; vb.u[1] = *(const LAS v2u*)(vp + 16);
            o[dt] = __builtin_amdgcn_mfma_f32_16x16x32_bf16(pa.v, vb.v, o[dt], 0, 0, 0); }
    }
    float* AP = (float*)(a.ws() + WS_AP) + (size_t)br * TOK * 384; float* AM = (float*)(a.ws() + WS_AM) + (size_t)br * TOK * 8; float* AL = (float*)(a.ws() + WS_AL) + (size_t)br * TOK * 8;
#pragma unroll
    for (int e = 0; e < 4; ++e) { const int qq = 16 * wave + 4 * fq + e; const size_t row = rowb + (size_t)(n * 128 + qq) * dil + cls;
#pragma unroll
        for (int dt = 0; dt < 4; ++dt) AP[row * 384 + h * 64 + 16 * dt + fr] = o[dt][e]; }
    if (fq == 0) { const size_t row = rowb + (size_t)(n * 128 + qi) * dil + cls; AM[row * 8 + h] = m; AL[row * 8 + h] = lsum; }
    __syncthreads();
}

__device__ __forceinline__ void attn_sample_task(const KA a, int l, int task0, LAS unsigned char* lds, int tid) {
    const int lane = tid & 63, wave = __builtin_amdgcn_readfirstlane(tid >> 6), task = task0 + wave;
    const int t = task & 3, bh = task >> 2, b = bh / 6, h = bh - b * 6;
    const bf16* P = (const bf16*)(a.ws() + WS_P);
    const float* ck = a.in(2) + ((size_t)(l * 32 + b) * 2048) * 384 + h * 64; const float* cv = a.in(3) + ((size_t)(l * 32 + b) * 2048) * 384 + h * 64;
    const int row = TP + b * 4 + t;
    LAS float* pl = (LAS float*)lds + wave * 512;
    float q[64];
    { const bf16* qp = P + (size_t)row * NPP + C_Q + h * 64;
#pragma unroll
      for (int i = 0; i < 8; ++i) { const v4u w = *(const v4u*)(qp + i * 8); q[8 * i] = bflo(w.x) * 0.125f; q[8 * i + 1] = bfhi(w.x) * 0.125f; q[8 * i + 2] = bflo(w.y) * 0.125f; q[8 * i + 3] = bfhi(w.y) * 0.125f;
          q[8 * i + 4] = bflo(w.z) * 0.125f; q[8 * i + 5] = bfhi(w.z) * 0.125f; q[8 * i + 6] = bflo(w.w) * 0.125f; q[8 * i + 7] = bfhi(w.w) * 0.125f; } }
    const float slope = exp2f(-8.0f * (float)(h + 1) / 6.0f);
    float sc[7]; float m = NEG_INF;
#pragma unroll
    for (int ps = 0; ps < 7; ++ps) {
        const int e = ps * 64 + lane; float v = NEG_INF;
        if (e < 387) { const int br = e / 129, st = e - br * 129, dil = (br == 0) ? 1 : (br == 1 ? 4 : 16), idx = 2048 + t - dil * st;
            float dot = 0.f;
            if (idx >= 2048) { const bf16* kp = P + (size_t)(TP + b * 4 + (idx - 2048)) * NPP + C_K + h * 64;
#pragma unroll
                for (int i = 0; i < 8; ++i) { const v4u w = *(const v4u*)(kp + i * 8); dot += q[8 * i] * bflo(w.x) + q[8 * i + 1] * bfhi(w.x) + q[8 * i + 2] * bflo(w.y) + q[8 * i + 3] * bfhi(w.y) + q[8 * i + 4] * bflo(w.z) + q[8 * i + 5] * bfhi(w.z) + q[8 * i + 6] * bflo(w.w) + q[8 * i + 7] * bfhi(w.w); } }
            else { const float* kp = ck + (size_t)idx * 384;
#pragma unroll
                for (int i = 0; i < 16; ++i) { const f32x4 w = *(const f32x4*)(kp + 4 * i); dot += q[4 * i] * w[0] + q[4 * i + 1] * w[1] + q[4 * i + 2] * w[2] + q[4 * i + 3] * w[3]; } }
            v = dot - slope * (float)(dil * st); }
        sc[ps] = v; m = fmaxf(m, v);
    }
    m = wave_max(m);
    float ls = 0.f;
#pragma unroll
    for (int ps = 0; ps < 7; ++ps) { const float p = __expf(sc[ps] - m); ls += p; pl[ps * 64 + lane] = p; }
    ls = wave_sum(ls);
    asm volatile("s_waitcnt lgkmcnt(0)" ::: "memory");
    float acc = 0.f;
#pragma unroll 3
    for (int e = 0; e < 387; ++e) { const int br = e / 129, st = e - br * 129, dil = (br == 0) ? 1 : (br == 1 ? 4 : 16), idx = 2048 + t - dil * st;
        const float vv = (idx >= 2048) ? bf2f(P[(size_t)(TP + b * 4 + (idx - 2048)) * NPP + C_V + h * 64 + lane]) : cv[(size_t)idx * 384 + lane];
        acc += pl[e] * vv; }
    float* AP = (float*)(a.ws() + WS_AP); float* AM = (float*)(a.ws() + WS_AM); float* AL = (float*)(a.ws() + WS_AL);
    AP[(size_t)row * 384 + h * 64 + lane] = acc; AP[((size_t)TOK + row) * 384 + h * 64 + lane] = 0.f; AP[((size_t)2 * TOK + row) * 384 + h * 64 + lane] = 0.f;
    if (lane == 0) { AM[(size_t)row * 8 + h] = m; AL[(size_t)row * 8 + h] = ls; AM[((size_t)TOK + row) * 8 + h] = NEG_INF; AL[((size_t)TOK + row) * 8 + h] = 0.f; AM[((size_t)2 * TOK + row) * 8 + h] = NEG_INF; AL[((size_t)2 * TOK + row) * 8 + h] = 0.f; }
}

__device__ __forceinline__ void post_rows(const KA a, int l, int tid) {
    const int lane = tid & 63, gw = blockIdx.x * NWAVES + __builtin_amdgcn_readfirstlane(tid >> 6); int NGW = gridDim.x * NWAVES; asm volatile("" : "+s"(NGW));
    const float* YS = (const float*)(a.ws() + WS_YS); const float* OPS = (const float*)(a.ws() + WS_OPS); const float* SC = (const float*)(a.ws() + WS_SC); const float* G = (const float*)(a.ws() + WS_G);
    const float* AP = (const float*)(a.ws() + WS_AP); const float* AM = (const float*)(a.ws() + WS_AM); const float* AL = (const float*)(a.ws() + WS_AL);
    const float* YC = (const float*)(a.ws() + WS_YC); const bf16* P = (const bf16*)(a.ws() + WS_P); bf16* YM = (bf16*)(a.ws() + WS_YM);
    for (int row = gw; row < TOK; row += NGW) {
        bf16* ym = YM + (size_t)row * D;
#pragma unroll
        for (int hh = 0; hh < 4; ++hh) { const int c = hh * 64 + lane;
            const float v = OPS[((size_t)(row * 4 + hh) * 6 + 5) * 64 + lane], kr = SC[(size_t)(row * 4 + hh) * 2], bon = SC[(size_t)(row * 4 + hh) * 2 + 1];
            const float y = YS[(size_t)row * 256 + c] + v * kr;
            const float mu = wave_sum(y) * (1.f / 64.f), d = y - mu, var = wave_sum(d * d) * (1.f / 64.f);
            const float yn = d * rsqrtf(var + GN_EPS) * a.in(23)[l * 256 + c] + a.in(24)[l * 256 + c];
            ym[c] = f2bf_s((yn + bon * v) * G[(size_t)row * 256 + c]); }
        float ob[6], ss = 0.f;
#pragma unroll
        for (int hd = 0; hd < 6; ++hd) {
            const float m0 = AM[(size_t)row * 8 + hd], m1 = AM[((size_t)TOK + row) * 8 + hd], m2 = AM[((size_t)2 * TOK + row) * 8 + hd];
            const float M = fmaxf(m0, fmaxf(m1, m2)), e0 = __expf(m0 - M), e1 = __expf(m1 - M), e2 = __expf(m2 - M);
            const float num = e0 * AP[(size_t)row * 384 + hd * 64 + lane] + e1 * AP[((size_t)TOK + row) * 384 + hd * 64 + lane] + e2 * AP[((size_t)2 * TOK + row) * 384 + hd * 64 + lane];
            const float den = e0 * AL[(size_t)row * 8 + hd] + e1 * AL[((size_t)TOK + row) * 8 + hd] + e2 * AL[((size_t)2 * TOK + row) * 8 + hd];
            ob[hd] = num / den; ss += ob[hd] * ob[hd]; }
        ss = wave_sum(ss); float rs = rsqrtf(ss * (1.f / 384.f) + NORM_EPS);
#pragma unroll
        for (int hd = 0; hd < 6; ++hd) ym[256 + hd * 64 + lane] = f2bf_s(ob[hd] * rs * a.in(25)[l * 384 + hd * 64 + lane]);
        ss = 0.f;
#pragma unroll
        for (int hd = 0; hd < 6; ++hd) { const float z = bf2f(P[(size_t)row * NPP + C_Z + hd * 64 + lane]); ob[hd] = YC[(size_t)row * 384 + hd * 64 + lane] * (z * sigmoidf_(z)); ss += ob[hd] * ob[hd]; }
        ss = wave_sum(ss); rs = rsqrtf(ss * (1.f / 384.f) + NORM_EPS);
#pragma unroll
        for (int hd = 0; hd < 6; ++hd) ym[640 + hd * 64 + lane] = f2bf_s(ob[hd] * rs * a.in(31)[l * 384 + hd * 64 + lane]);
    }
}
__device__ __forceinline__ void final_rows(const KA a, int tid) {
    const int lane = tid & 63, gw = blockIdx.x * NWAVES + __builtin_amdgcn_readfirstlane(tid >> 6); int NGW = gridDim.x * NWAVES; asm volatile("" : "+s"(NGW));
    const float* X = (const float*)(a.ws() + WS_X); const float* SSQ = (const float*)(a.ws() + WS_SSQ);
    for (int row = gw; row < TOK; row += NGW) {
        const float rs = pg8::row_rstd(SSQ, row);
        float* dst = (row < TP) ? a.out() + O_YP + (size_t)row * D : a.out() + O_YS + (size_t)(row - TP) * D;
#pragma unroll
        for (int j = 0; j < 4; ++j) { const f32x4 v = ((const f32x4*)(X + (size_t)row * D))[lane + 64 * j], w = ((const f32x4*)a.in(37))[lane + 64 * j]; ((f32x4*)dst)[lane + 64 * j] = v * rs * w; }
    }
}

constexpr int NU_MIX = 80 + 2304 + 96 + 128 + 192;
__global__ void __launch_bounds__(NTHR, 2) hymba_fwd(KArgs args) {
    extern __shared__ __attribute__((aligned(16))) unsigned char lds_raw[];
    LAS unsigned char* lds = (LAS unsigned char*)lds_raw;
    volatile LAS unsigned* MISC = (volatile LAS unsigned*)(lds + MISC_OFF);
    { const int tid = threadIdx.x; for (int u = tid; u < (LDS_BYTES - LDSCTL_OFF) / 4; u += NTHR) ((LAS unsigned*)(lds + LDSCTL_OFF))[u] = 0u; }
    __syncthreads();
    XcdBarrier bar = xcd_barrier_post((unsigned*)((gu32*)(args.ws + WS_CTL) + CW_BAR), MISC + 8);
#define GRID_BAR() do { XcdBarrier b_ = bar; asm volatile("" : "+s"(b_.bar), "+s"(b_.x)); xcd_barrier(b_); } while (0)
#define WSL(name) unsigned char* name = make_ka().ws()
#define GL(name) int name = gridDim.x; asm volatile("" : "+s"(name)); int bx_ = blockIdx.x; asm volatile("" : "+s"(bx_))

#ifndef NO_PRO
    p0_prologue(make_ka(), lds, fresh_tid());
#endif
    GRID_BAR();
    for (int l = 0; l < DEPTH; ++l) {
        { WSL(w); GL(G); pg8::Gemm g{(const bf16*)(w + WS_XB), (const bf16*)(w + WS_W + (size_t)l * WL_SIZE + WL_GU1), MP, 2 * FF, D}; pg8::StaticOrder S; S.init(MP, 2 * FF, G, bx_); pg8::EpiGU E{(bf16*)(w + WS_H), (const float*)(w + WS_SSQ)};
          pg8::gemm_phase<pg8::EpiGU, pg8::StaticOrder, true, true>(lds, g, S, E); }
        GRID_BAR();
        { WSL(w); GL(G); pg8::Gemm g{(const bf16*)(w + WS_H), (const bf16*)(w + WS_W + (size_t)l * WL_SIZE + WL_D1), MP, D, FF}; pg8::StaticOrder S; S.init(MP, D, G, bx_); pg8::EpiRes E{(float*)(w + WS_X), (bf16*)(w + WS_XB), (float*)(w + WS_SSQ), 0.5f};
          pg8::gemm_phase<pg8::EpiRes, pg8::StaticOrder, true, true>(lds, g, S, E); }
        GRID_BAR();
        { WSL(w); GL(G); pg8::Gemm g{(const bf16*)(w + WS_XB), (const bf16*)(w + WS_W + (size_t)l * WL_SIZE + WL_IN), MP, NPP, D}; pg8::StaticOrder S; S.init(MP, NPP, G, bx_); pg8::EpiIn E{(bf16*)(w + WS_P), (const float*)(w + WS_SSQ)};
          pg8::gemm_phase<pg8::EpiIn, pg8::StaticOrder, true, true>(lds, g, S, E); }
        GRID_BAR();
#ifndef NO_PREP
        { GL(G); for (int tile = bx_; tile < TOK / 16; tile += G) rwkv_prep_tile(make_ka(), l, tile, lds, fresh_tid()); }
#endif
#ifndef NO_PREPE
        prep_elementwise(make_ka(), l, fresh_tid());
#endif
        GRID_BAR();
        for (;;) {
            { WSL(w); if (fresh_tid() == 0) MISC[0] = __hip_atomic_fetch_add((unsigned*)((gu32*)(w + WS_CTL) + CW_Q + 64 * l), 1u, __ATOMIC_RELAXED, __HIP_MEMORY_SCOPE_AGENT); }
            __syncthreads();
            const int u = (int)MISC[0];
            __syncthreads();
            if (u >= NU_MIX) break;
#ifndef NO_SCAN
            if (u < 32) rwkv_scan_unit(make_ka(), l, u, lds, fresh_tid()); else
#endif
            if (0) {}
#ifndef NO_SSD
            else if (u < 80) ssd_unit(make_ka(), l, u - 32, lds, fresh_tid());
#endif
#ifndef NO_ATTP
            else if (u < 80 + 2304) attn_prompt_unit(make_ka(), l, u - 80, lds, fresh_tid());
#endif
#ifndef NO_ATTS
            else if (u < 80 + 2304 + 96) attn_sample_task(make_ka(), l, (u - 80 - 2304) * 8, lds, fresh_tid());
#endif
#ifndef NO_SCAN
            else if (u < 80 + 2304 + 96 + 128) rwkv_scan_unit(make_ka(), l, 32 + (u - 80 - 2304 - 96), lds, fresh_tid());
#endif
#ifndef NO_SSD
            else ssd_unit(make_ka(), l, 48 + (u - 80 - 2304 - 96 - 128), lds, fresh_tid());
#endif
        }
        GRID_BAR();
#ifndef NO_POST
        post_rows(make_ka(), l, fresh_tid());
#endif
        GRID_BAR();
        { WSL(w); GL(G); pg8::Gemm g{(const bf16*)(w + WS_YM), (const bf16*)(w + WS_W + (size_t)l * WL_SIZE + WL_OUT), MP, D, D}; pg8::StaticOrder S; S.init(MP, D, G, bx_); pg8::EpiRes E{(float*)(w + WS_X), (bf16*)(w + WS_XB), (float*)(w + WS_SSQ), 1.0f};
          pg8::gemm_phase<pg8::EpiRes, pg8::StaticOrder, true, true>(lds, g, S, E); }
        GRID_BAR();
        { WSL(w); GL(G); pg8::Gemm g{(const bf16*)(w + WS_XB), (const bf16*)(w + WS_W + (size_t)l * WL_SIZE + WL_GU2), MP, 2 * FF, D}; pg8::StaticOrder S; S.init(MP, 2 * FF, G, bx_); pg8::EpiGU E{(bf16*)(w + WS_H), (const float*)(w + WS_SSQ)};
          pg8::gemm_phase<pg8::EpiGU, pg8::StaticOrder, true, true>(lds, g, S, E); }
        GRID_BAR();
        { WSL(w); GL(G); pg8::Gemm g{(const bf16*)(w + WS_H), (const bf16*)(w + WS_W + (size_t)l * WL_SIZE + WL_D2), MP, D, FF}; pg8::StaticOrder S; S.init(MP, D, G, bx_); pg8::EpiRes E{(float*)(w + WS_X), (bf16*)(w + WS_XB), (float*)(w + WS_SSQ), 0.5f};
          pg8::gemm_phase<pg8::EpiRes, pg8::StaticOrder, true, true>(lds, g, S, E); }
        GRID_BAR();
    }
    final_rows(make_ka(), fresh_tid());
}

extern "C" void kernel_launch(void* const* d_in, const int* in_sizes, int n_in, void* d_out, int out_size, void* d_ws, size_t ws_size, hipStream_t stream) {
    static int grid = 0;
    if (grid == 0) {
        if (n_in != 38 || (size_t)out_size != O_END || ws_size < WS_END) { fprintf(stderr, "kernel_launch: unexpected shapes: n_in %d out %d ws %zu\n", n_in, out_size, ws_size); grid = -1; return; }
        int dev = 0, cus = 0, per_cu = 0;
        if (hipGetDevice(&dev) != hipSuccess || hipDeviceGetAttribute(&cus, hipDeviceAttributeMultiprocessorCount, dev) != hipSuccess) { grid = -1; return; }
        if (hipFuncSetAttribute((const void*)hymba_fwd, hipFuncAttributeMaxDynamicSharedMemorySize, LDS_BYTES) != hipSuccess) { fprintf(stderr, "kernel_launch: hipFuncSetAttribute failed\n"); grid = -1; return; }
        if (hipOccupancyMaxActiveBlocksPerMultiprocessor(&per_cu, (const void*)hymba_fwd, NTHR, LDS_BYTES) != hipSuccess || per_cu < 1) { fprintf(stderr, "kernel_launch: occupancy query says %d\n", per_cu); }
        (void)hipGetLastError();
        grid = cus;
    }
    if (grid < 0) return;
    if (hipMemsetAsync((char*)d_ws + WS_CTL, 0, CTL_ZERO_BYTES, stream) != hipSuccess) return;
    KArgs a{};
    for (int i = 0; i < 38; ++i) a.in[i] = (const float*)d_in[i];
    a.out = (float*)d_out; a.ws = (unsigned char*)d_ws;
    hipLaunchKernelGGL(hymba_fwd, dim3(grid), dim3(NTHR), LDS_BYTES, stream, a);
}
```

```cpp
#include <hip/hip_runtime.h>
#include <cstdio>
#include <cstdint>
namespace pg8 {
#define PG8_LAS __attribute__((address_space(3)))
typedef unsigned short bf16_t;
typedef short bf16x8 __attribute__((ext_vector_type(8)));
typedef float f32x4 __attribute__((ext_vector_type(4)));
typedef unsigned u32x4 __attribute__((ext_vector_type(4)));
constexpr int BM = 256, BK = 64, HALF = 128, HTB = HALF * BK * 2  , STAGE_BYTES = 8 * HTB, NXCD = 8, WGM = 4;

__host__ __device__ __forceinline__ int lds_byte(int r, int c) { const int st = (r >> 4) * 2 + (c >> 5), rr = r & 15, cc = c & 31, ob = rr * 64 + cc * 2; return st * 1024 + (ob ^ (((ob >> 9) & 1) << 5)); }
__host__ __device__ __forceinline__ void stage_rc(int b, int& R, int& C) { const int st = b / 1024, sb = b % 1024, swz = sb ^ (((sb >> 9) & 1) << 5); R = (st >> 1) * 16 + swz / 64; C = (st & 1) * 32 + (swz % 64) / 2; }
__host__ __device__ __forceinline__ int perm32(int rho) { const int n = rho >> 4, i = rho & 15; return 8 * (i >> 2) + 4 * n + (i & 3); }

struct Unit { int pm, pn; };
struct Gemm { const bf16_t* A; const bf16_t* Bt; int M, N, K; };

struct StaticOrder {
    int nM, nN, nwg, G, c, wgm;
    __host__ __device__ void init(int M, int N, int G_, int c_, int wgm_ = WGM) { nM = M / BM; nN = N / BM; nwg = nM * nN; G = G_; c = c_; wgm = wgm_; }
    __host__ __device__ bool next(int i, Unit& u) const {
        const long L = (long)i * G + c; if (L >= nwg) return false;
        int wgid = (int)L; { const int q = nwg / NXCD, r = nwg % NXCD, xcd = wgid % NXCD, off = wgid / NXCD; wgid = (xcd < r ? xcd * (q + 1) : r * (q + 1) + (xcd - r) * q) + off; }
        const int nig = wgm * nN, gid = wgid / nig, fm = gid * wgm, gsz = (nM - fm) < wgm ? (nM - fm) : wgm;
        u.pm = fm + ((wgid % nig) % gsz); u.pn = (wgid % nig) / gsz; return true;
    }
    __device__ __forceinline__ void a_ready(const Unit&) const {}
    __device__ __forceinline__ void done(const Unit&) const {}
};

typedef __bf16 bf2c_t __attribute__((ext_vector_type(2))); typedef float f2c_t __attribute__((ext_vector_type(2)));
__device__ __forceinline__ unsigned cvt_pk_bf16(float lo, float hi) { const f2c_t v = {lo, hi}; return __builtin_bit_cast(unsigned, __builtin_convertvector(v, bf2c_t)); }
typedef float f32x2 __attribute__((ext_vector_type(2)));

typedef unsigned u32x2 __attribute__((ext_vector_type(2)));
__device__ __forceinline__ float xsum16(float v) { const auto r = __builtin_amdgcn_permlane16_swap(__float_as_uint(v), __float_as_uint(v), false, false); return __uint_as_float(r[0]) + __uint_as_float(r[1]); }
__device__ __forceinline__ float xsum32(float v) { const auto r = __builtin_amdgcn_permlane32_swap(__float_as_uint(v), __float_as_uint(v), false, false); return __uint_as_float(r[0]) + __uint_as_float(r[1]); }
__device__ __forceinline__ float xmax16(float v) { const auto r = __builtin_amdgcn_permlane16_swap(__float_as_uint(v), __float_as_uint(v), false, false); return fmaxf(__uint_as_float(r[0]), __uint_as_float(r[1])); }
__device__ __forceinline__ float xmax32(float v) { const auto r = __builtin_amdgcn_permlane32_swap(__float_as_uint(v), __float_as_uint(v), false, false); return fmaxf(__uint_as_float(r[0]), __uint_as_float(r[1])); }
constexpr int E_FF = 2816, E_NPP = 3584, E_D = 1024;
constexpr int SSQS_OFF = 524288;
__device__ __forceinline__ float row_rstd(const float* ssq, int row) {
    float t;
    if (row < 16384) { const f32x4* sp = (const f32x4*)(ssq + (size_t)row * 16); const f32x4 s = (sp[0] + sp[1]) + (sp[2] + sp[3]); t = (s[0] + s[1]) + (s[2] + s[3]); }
    else { const f32x4* sp = (const f32x4*)(ssq + SSQS_OFF + (size_t)(row - 16384) * 64); f32x4 s = sp[0];
#pragma unroll
        for (int i = 1; i < 16; ++i) s += sp[i];
        t = (s[0] + s[1]) + (s[2] + s[3]); }
    return __builtin_amdgcn_rsqf(t * (1.0f / 1024.0f) + 1e-6f);
}
__device__ __forceinline__ float silu_f(float g) { return g * __builtin_amdgcn_rcpf(1.0f + __builtin_amdgcn_exp2f(-1.4426950408889634f * g)); }
__device__ __forceinline__ float row_rstd_coop(const float* ssq, int row, int fq) {
    float t;
    if (row < 16384) { const f32x4 s = ((const f32x4*)(ssq + (size_t)row * 16))[fq]; t = (s[0] + s[1]) + (s[2] + s[3]); }
    else { const f32x4* sp = (const f32x4*)(ssq + SSQS_OFF + (size_t)(row - 16384) * 64) + 4 * fq; const f32x4 s = (sp[0] + sp[1]) + (sp[2] + sp[3]); t = (s[0] + s[1]) + (s[2] + s[3]); }
    t = xsum16(t); t = xsum32(t);
    return __builtin_amdgcn_rsqf(t * (1.0f / 1024.0f) + 1e-6f);
}
struct EpiGU {
    static constexpr bool PERM = true, AFTER_DRAIN = false;
    bf16_t* H; const float* ssq;
    __device__ __forceinline__ void operator()(const f32x4 (&acc)[2][2][4][2], const Unit& u, int wr, int wc, int fr, int fq) const {
        const int row0 = u.pm * BM + wr * 64 + fr, hc0 = u.pn * 128 + wc * 16 + 4 * fq;
#pragma unroll
        for (int ai = 0; ai < 2; ++ai)
#pragma unroll
            for (int m = 0; m < 4; ++m) { const int row = row0 + ai * HALF + m * 16; const float rs = row_rstd_coop(ssq, row, fq);
#pragma unroll
                for (int bj = 0; bj < 2; ++bj) { const f32x4 g = acc[ai][bj][m][0] * rs, up = acc[ai][bj][m][1] * rs;
                    u32x2 w; w.x = cvt_pk_bf16(silu_f(g[0]) * up[0], silu_f(g[1]) * up[1]); w.y = cvt_pk_bf16(silu_f(g[2]) * up[2], silu_f(g[3]) * up[3]);
                    *(u32x2*)(H + (size_t)row * E_FF + hc0 + bj * 64) = w; } asm volatile("" ::: "memory"); }
    }
};
struct EpiIn {
    static constexpr bool PERM = true, AFTER_DRAIN = false;
    bf16_t* P; const float* ssq;
    __device__ __forceinline__ void operator()(const f32x4 (&acc)[2][2][4][2], const Unit& u, int wr, int wc, int fr, int fq) const {
        const int row0 = u.pm * BM + wr * 64 + fr, col0 = u.pn * BM + wc * 32 + 8 * fq;
#pragma unroll
        for (int ai = 0; ai < 2; ++ai)
#pragma unroll
            for (int m = 0; m < 4; ++m) { const int row = row0 + ai * HALF + m * 16; const float rs = row_rstd_coop(ssq, row, fq);
#pragma unroll
                for (int bj = 0; bj < 2; ++bj) { const f32x4 v0 = acc[ai][bj][m][0] * rs, v1 = acc[ai][bj][m][1] * rs;
                    u32x4 w; w.x = cvt_pk_bf16(v0[0], v0[1]); w.y = cvt_pk_bf16(v0[2], v0[3]); w.z = cvt_pk_bf16(v1[0], v1[1]); w.w = cvt_pk_bf16(v1[2], v1[3]);
                    *(u32x4*)(P + (size_t)row * E_NPP + col0 + bj * HALF) = w; } asm volatile("" ::: "memory"); }
    }
};
struct EpiRes {
    static constexpr bool PERM = true, AFTER_DRAIN = false;
    float* Xf; bf16_t* XB; float* ssq; float scale;
    __device__ __forceinline__ void operator()(const f32x4 (&acc)[2][2][4][2], const Unit& u, int wr, int wc, int fr, int fq) const {
        const int row0 = u.pm * BM + wr * 64 + fr, col0 = u.pn * BM + wc * 32 + 8 * fq;
#pragma unroll
        for (int ai = 0; ai < 2; ++ai)
#pragma unroll
            for (int m = 0; m < 4; ++m) { const int row = row0 + ai * HALF + m * 16; float ss = 0.f;
#pragma unroll
                for (int bj = 0; bj < 2; ++bj) { bf16_t* xp = XB + (size_t)row * E_D + col0 + bj * HALF; const u32x4 o = *(const u32x4*)xp;
                    f32x4 x0, x1;
                    x0[0] = __uint_as_float(o.x << 16); x0[1] = __uint_as_float(o.x & 0xffff0000u); x0[2] = __uint_as_float(o.y << 16); x0[3] = __uint_as_float(o.y & 0xffff0000u);
                    x1[0] = __uint_as_float(o.z << 16); x1[1] = __uint_as_float(o.z & 0xffff0000u); x1[2] = __uint_as_float(o.w << 16); x1[3] = __uint_as_float(o.w & 0xffff0000u);
                    x0 += acc[ai][bj][m][0] * scale; x1 += acc[ai][bj][m][1] * scale;
                    if (Xf) { float* fp = Xf + (size_t)row * E_D + col0 + bj * HALF; *(f32x4*)fp = x0; *(f32x4*)(fp + 4) = x1; }
                    ss += (x0[0] * x0[0] + x0[1] * x0[1]) + (x0[2] * x0[2] + x0[3] * x0[3]) + (x1[0] * x1[0] + x1[1] * x1[1]) + (x1[2] * x1[2] + x1[3] * x1[3]);
                    u32x4 w; w.x = cvt_pk_bf16(x0[0], x0[1]); w.y = cvt_pk_bf16(x0[2], x0[3]); w.z = cvt_pk_bf16(x1[0], x1[1]); w.w = cvt_pk_bf16(x1[2], x1[3]);
                    *(u32x4*)xp = w; }
                ss = xsum16(ss); ss = xsum32(ss);
                if (fq == 0) ssq[(size_t)row * 16 + u.pn * 4 + wc] = ss; if (m & 1) asm volatile("" ::: "memory"); }
    }
};
template <class Epi, class Sched, bool ALIGN_EPI = false, bool SP2 = false>
__device__ __forceinline__ void gemm_phase(PG8_LAS unsigned char* lds, const Gemm g, const Sched& S, const Epi& E) {
    int tid = threadIdx.x; asm volatile("" : "+v"(tid)); const int wid = __builtin_amdgcn_readfirstlane(tid >> 6), lane = tid & 63, wr = wid >> 2, wc = wid & 3, fr = lane & 15, fq = lane >> 4;
    const int K = g.K, nt = K / BK;
    unsigned voffA[2], voffB[2];
#pragma unroll
    for (int i = 0; i < 2; ++i) { int R, C; stage_rc(tid * 16 + i * 8192, R, C); const int Rb = Epi::PERM ? ((R & ~31) + perm32(R & 31)) : R;
        voffA[i] = (unsigned)(R * K + C) * 2u; voffB[i] = (unsigned)(Rb * K + C) * 2u; }
    const size_t kstep = (size_t)(BK * 2);
    const size_t hstep = (size_t)HALF * K * 2;
    const size_t tstep = 2 * hstep;
    const unsigned ldsw = (unsigned)wid * 1024u;
    const int aoff = lds_byte(wr * 64 + fr, fq * 8), boff = lds_byte(wc * 32 + fr, fq * 8);
#define PG8_SA(b, h) (((b) * 2 + (h)) * HTB)
#define PG8_SB(b, h) ((4 + (b) * 2 + (h)) * HTB)
#define PG8_STAGE(bufoff, gbase, voff) do { _Pragma("unroll") for (int _i = 0; _i < 2; ++_i) \
        __builtin_amdgcn_global_load_lds((const unsigned*)((const char*)(gbase) + (voff)[_i]), (PG8_LAS unsigned*)(lds + (bufoff) + ldsw + _i * 8192), 16, 0, 0); } while (0)
#define PG8_LDA(dst, b, h) do { _Pragma("unroll") for (int m = 0; m < 4; ++m) _Pragma("unroll") for (int k = 0; k < 2; ++k) dst[m][k] = *(const PG8_LAS bf16x8*)(lds + PG8_SA(b, h) + aoff + m * 2048 + k * 1024); } while (0)
#define PG8_LDB(dst, b, h) do { _Pragma("unroll") for (int n = 0; n < 2; ++n) _Pragma("unroll") for (int k = 0; k < 2; ++k) dst[n][k] = *(const PG8_LAS bf16x8*)(lds + PG8_SB(b, h) + boff + n * 2048 + k * 1024); } while (0)
#define PG8_MMA(ai, bj, At, Bt) do { __builtin_amdgcn_s_setprio(1); _Pragma("unroll") for (int m = 0; m < 4; ++m) _Pragma("unroll") for (int n = 0; n < 2; ++n) _Pragma("unroll") for (int k = 0; k < 2; ++k) \
        acc[ai][bj][m][n] = __builtin_amdgcn_mfma_f32_16x16x32_bf16(Bt[n][k], At[m][k], acc[ai][bj][m][n], 0, 0, 0); __builtin_amdgcn_s_setprio(0); } while (0)
#define PG8_WAIT_V(n) asm volatile("s_waitcnt vmcnt(" #n ")" ::: "memory")
#define PG8_WAIT_L(n) asm volatile("s_waitcnt lgkmcnt(" #n ")" ::: "memory")
#define PG8_BAR __builtin_amdgcn_s_barrier()
#define PG8_SCHED __builtin_amdgcn_sched_barrier(0)
    Unit cur, nxt; int ui = 0;
    if (!S.next(0, cur)) return;
    f32x4 acc[2][2][4][2];
#pragma unroll
    for (int a = 0; a < 2; ++a)
#pragma unroll
        for (int b = 0; b < 2; ++b)
#pragma unroll
            for (int m = 0; m < 4; ++m)
#pragma unroll
                for (int n = 0; n < 2; ++n) acc[a][b][m][n] = (f32x4){0.f, 0.f, 0.f, 0.f};
    bf16x8 At[4][2], B0[2][2], B1[2][2];
    const char* cA = (const char*)g.A + (size_t)cur.pm * tstep; const char* cB = (const char*)g.Bt + (size_t)cur.pn * tstep;
    S.a_ready(cur);
    if constexpr (SP2) {
        PG8_STAGE(PG8_SB(0, 0), cB, voffB); PG8_STAGE(PG8_SB(0, 1), cB + hstep, voffB); PG8_STAGE(PG8_SA(0, 0), cA, voffA); PG8_STAGE(PG8_SA(0, 1), cA + hstep, voffA);
        if (wr == 1) PG8_BAR;
        PG8_WAIT_V(2); PG8_BAR;
        PG8_STAGE(PG8_SB(1, 0), cB + kstep, voffB); PG8_STAGE(PG8_SA(1, 0), cA + kstep, voffA); PG8_STAGE(PG8_SB(1, 1), cB + hstep + kstep, voffB);
        PG8_WAIT_V(6); PG8_BAR;
    } else {
        PG8_STAGE(PG8_SB(0, 0), cB, voffB); PG8_STAGE(PG8_SA(0, 0), cA, voffA); PG8_STAGE(PG8_SB(0, 1), cB + hstep, voffB); PG8_STAGE(PG8_SA(0, 1), cA + hstep, voffA);
        if (wr == 1) PG8_BAR;
        PG8_WAIT_V(4); PG8_BAR;
        PG8_STAGE(PG8_SB(1, 0), cB + kstep, voffB); PG8_STAGE(PG8_SA(1, 0), cA + kstep, voffA); PG8_STAGE(PG8_SB(1, 1), cB + hstep + kstep, voffB);
        PG8_WAIT_V(6); PG8_BAR;
    }
    for (;;) {
        const bool has_next = S.next(ui + 1, nxt);
        const char* nA = has_next ? (const char*)g.A + (size_t)nxt.pm * tstep : cA; const char* nB = has_next ? (const char*)g.Bt + (size_t)nxt.pn * tstep : cB;
        for (int t = 0; t < nt; t += 2) {
            const bool last = (t == nt - 2);
            const char* a1 = cA + (size_t)(t + 1) * kstep;
            const char* a2 = last ? nA : cA + (size_t)(t + 2) * kstep; const char* b2 = last ? nB : cB + (size_t)(t + 2) * kstep;
            const char* a3 = a2 + kstep; const char* b3 = b2 + kstep;
            if (last && has_next) S.a_ready(nxt);
            if constexpr (SP2) {
            PG8_LDB(B0, 0, 0); PG8_LDB(B1, 0, 1); PG8_SCHED; PG8_LDA(At, 0, 0); PG8_STAGE(PG8_SA(1, 1), a1 + hstep, voffA);
            PG8_WAIT_V(8); PG8_WAIT_L(0); PG8_BAR; PG8_MMA(0, 0, At, B0); PG8_MMA(0, 1, At, B1); PG8_BAR; PG8_SCHED;
            PG8_LDA(At, 0, 1); PG8_STAGE(PG8_SB(0, 0), b2, voffB); PG8_STAGE(PG8_SB(0, 1), b2 + hstep, voffB); PG8_STAGE(PG8_SA(0, 0), a2, voffA);
            PG8_WAIT_V(8); PG8_WAIT_L(0); PG8_BAR; PG8_MMA(1, 0, At, B0); PG8_MMA(1, 1, At, B1); PG8_BAR; PG8_SCHED;
            PG8_LDB(B0, 1, 0); PG8_LDB(B1, 1, 1); PG8_SCHED; PG8_LDA(At, 1, 0); PG8_STAGE(PG8_SA(0, 1), a2 + hstep, voffA);
            PG8_WAIT_V(8); PG8_WAIT_L(0); PG8_BAR; PG8_MMA(0, 0, At, B0); PG8_MMA(0, 1, At, B1); PG8_BAR; PG8_SCHED;
            PG8_LDA(At, 1, 1); PG8_STAGE(PG8_SB(1, 0), b3, voffB); PG8_STAGE(PG8_SB(1, 1), b3 + hstep, voffB); PG8_STAGE(PG8_SA(1, 0), a3, voffA);
            PG8_WAIT_V(8); PG8_WAIT_L(0); PG8_BAR; PG8_MMA(1, 0, At, B0); PG8_MMA(1, 1, At, B1); PG8_BAR; PG8_SCHED;
            } else {
            PG8_LDB(B0, 0, 0); PG8_SCHED; PG8_LDA(At, 0, 0); PG8_STAGE(PG8_SA(1, 1), a1 + hstep, voffA);
            PG8_WAIT_L(8); PG8_BAR; PG8_WAIT_L(0); PG8_MMA(0, 0, At, B0); PG8_BAR; PG8_SCHED;
            PG8_LDB(B1, 0, 1); PG8_STAGE(PG8_SB(0, 0), b2, voffB);
            PG8_BAR; PG8_WAIT_L(0); PG8_MMA(0, 1, At, B1); PG8_BAR;
            PG8_LDA(At, 0, 1); PG8_STAGE(PG8_SA(0, 0), a2, voffA);
            PG8_BAR; PG8_WAIT_L(0); PG8_MMA(1, 0, At, B0); PG8_BAR; PG8_SCHED;
            PG8_STAGE(PG8_SB(0, 1), b2 + hstep, voffB);
            PG8_WAIT_V(6); PG8_BAR; PG8_MMA(1, 1, At, B1); PG8_BAR;
            PG8_LDB(B0, 1, 0); PG8_SCHED; PG8_LDA(At, 1, 0); PG8_STAGE(PG8_SA(0, 1), a2 + hstep, voffA);
            PG8_WAIT_L(8); PG8_BAR; PG8_WAIT_L(0); PG8_MMA(0, 0, At, B0); PG8_BAR; PG8_SCHED;
            PG8_LDB(B1, 1, 1); PG8_STAGE(PG8_SB(1, 0), b3, voffB);
            PG8_BAR; PG8_WAIT_L(0); PG8_MMA(0, 1, At, B1); PG8_BAR;
            PG8_LDA(At, 1, 1); PG8_STAGE(PG8_SA(1, 0), a3, voffA);
            PG8_BAR; PG8_WAIT_L(0); PG8_MMA(1, 0, At, B0); PG8_BAR; PG8_SCHED;
            PG8_STAGE(PG8_SB(1, 1), b3 + hstep, voffB);
            PG8_WAIT_V(6); PG8_BAR; PG8_MMA(1, 1, At, B1); PG8_BAR;
            }
        }
        if constexpr (ALIGN_EPI) { if (wr == 0) PG8_BAR; }
        if constexpr (!Epi::AFTER_DRAIN) { E(acc, cur, wr, wc, fr, fq); S.done(cur); }
        if (!has_next) break;
#pragma unroll
        for (int a = 0; a < 2; ++a)
#pragma unroll
            for (int b = 0; b < 2; ++b)
#pragma unroll
                for (int m = 0; m < 4; ++m)
#pragma unroll
                    for (int n = 0; n < 2; ++n) acc[a][b][m][n] = (f32x4){0.f, 0.f, 0.f, 0.f};
        cur = nxt; cA = nA; cB = nB; ++ui;
        if constexpr (ALIGN_EPI) { if (wr == 1) PG8_BAR; }
    }
    PG8_WAIT_V(0);
    if constexpr (!ALIGN_EPI) { if (wr == 0) PG8_BAR; }
    PG8_BAR;
    if constexpr (Epi::AFTER_DRAIN) { E.fused(acc, cur, wr, wc, fr, fq, lds, wid, lane); S.done(cur); }
#undef PG8_SA
#undef PG8_SB
#undef PG8_STAGE
#undef PG8_LDA
#undef PG8_LDB
#undef PG8_MMA
#undef PG8_WAIT_V
#undef PG8_WAIT_L
#undef PG8_BAR
#undef PG8_SCHED
}
}
#define GAS __attribute__((address_space(1)))
#define LAS __attribute__((address_space(3)))
typedef unsigned short bf16;
typedef unsigned v4u __attribute__((ext_vector_type(4)));
typedef float f32x4 __attribute__((ext_vector_type(4)));
typedef short bf16x8 __attribute__((ext_vector_type(8)));
typedef GAS unsigned gu32;
typedef GAS unsigned long long gu64;
#define RLX_AGENT __ATOMIC_RELAXED, __HIP_MEMORY_SCOPE_AGENT
#define LDS_WAIT() asm volatile("s_waitcnt lgkmcnt(0)" ::: "memory")
#define VM_WAIT() asm volatile("s_waitcnt vmcnt(0)" ::: "memory")
__device__ __forceinline__ unsigned long long rt() { return __builtin_amdgcn_s_memrealtime(); }
__device__ __forceinline__ unsigned f2bf(float f) { unsigned u = __builtin_bit_cast(unsigned, f); return (u + 0x7fffu + ((u >> 16) & 1u)) >> 16; }
__device__ __forceinline__ unsigned pk2(float lo, float hi) { return f2bf(lo) | (f2bf(hi) << 16); }

#define XB_TMO      128
#define XB_XCNT(j)  (256  + 64 * (j))
#define XB_XSUB(j)  (1280 + 64 * (j))
#define XB_XGEN(j)  (2304 + 64 * (j))
#define XB_TOP      3328
#define XB_TOPGEN   3392
#define XCD_BAR_WORDS 3456
#define XB_SPIN_CAP (1u << 18)

__device__ __forceinline__ unsigned xb_ld(unsigned* p)              { return __hip_atomic_load(p, __ATOMIC_RELAXED, __HIP_MEMORY_SCOPE_AGENT); }
__device__ __forceinline__ unsigned xb_add(unsigned* p, unsigned v) { return __hip_atomic_fetch_add(p, v, __ATOMIC_RELAXED, __HIP_MEMORY_SCOPE_AGENT); }
__device__ __forceinline__ unsigned xb_xcc_id() { return (unsigned)__builtin_amdgcn_s_getreg((3 << 11) | 20) & 0xFu; }
#define XB_SPIN(cond, bar) do { unsigned _sp = 0; while (cond) { __builtin_amdgcn_s_sleep(1); \
    if ((++_sp & 255u) == 0u) { if (xb_ld(&(bar)[XB_TMO])) break; if (_sp > XB_SPIN_CAP) { atomicAdd(&(bar)[XB_TMO], 1u); break; } } } } while (0)

struct XcdBarrier {
    unsigned* bar; unsigned x;
    volatile LAS unsigned* st;
};

__device__ __forceinline__ XcdBarrier xcd_barrier_post(unsigned* bar, volatile LAS unsigned* st) {
    XcdBarrier b; b.bar = bar; b.x = xb_xcc_id(); b.st = st;
    if (threadIdx.x == 0) (void)xb_add(&bar[XB_XCNT(b.x)], 1u);
    return b;
}
__device__ __forceinline__ void xcd_barrier_complete(unsigned* bar, unsigned x, unsigned& nloc, unsigned& nx) {
    const unsigned G = gridDim.x * gridDim.y * gridDim.z;
    unsigned sum, cnt, mine, sp = 0u;
    for (;;) {
        sum = 0u; cnt = 0u; mine = 0u;
#pragma unroll
        for (unsigned j = 0; j < 16; ++j) { const unsigned c = xb_ld(&bar[XB_XCNT(j)]); sum += c; cnt += (c > 0u) ? 1u : 0u; mine = (j == x) ? c : mine; }
        if (sum == G) break;
        __builtin_amdgcn_s_sleep(1);
        if ((++sp & 255u) == 0u) { if (xb_ld(&bar[XB_TMO])) break; if (sp > XB_SPIN_CAP) { atomicAdd(&bar[XB_TMO], 1u); break; } }
    }
    nloc = mine > 0u ? mine : 1u; nx = cnt > 0u ? cnt : 1u;
}

__device__ __forceinline__ void xcd_barrier(const XcdBarrier& b) {
    asm volatile("s_waitcnt vmcnt(0)" ::: "memory");
    __syncthreads();
    int tid0_ = threadIdx.x; asm volatile("" : "+v"(tid0_));
    if (tid0_ == 0) {
        unsigned* bar = b.bar;
        __builtin_amdgcn_s_waitcnt(0);
        unsigned nloc = b.st[0], nx = b.st[1];
        if (nloc == 0u) { xcd_barrier_complete(bar, b.x, nloc, nx); b.st[0] = nloc; b.st[1] = nx; }
        const unsigned old = xb_add(&bar[XB_XSUB(b.x)], 1u);
        const unsigned gen = old / nloc;
        if (old + 1u == (gen + 1u) * nloc) {
            __builtin_amdgcn_fence(__ATOMIC_RELEASE, "agent");
            asm volatile("s_waitcnt vmcnt(0)" ::: "memory");
            const unsigned og = xb_add(&bar[XB_TOP], 1u);
            const unsigned tg = og / nx;
            if (og + 1u == (tg + 1u) * nx) xb_add(&bar[XB_TOPGEN], 1u);
            else XB_SPIN(xb_ld(&bar[XB_TOPGEN]) == tg, bar);
            __builtin_amdgcn_fence(__ATOMIC_ACQUIRE, "agent");
            xb_add(&bar[XB_XGEN(b.x)], 1u);
            asm volatile("s_waitcnt vmcnt(0)" ::: "memory");
        } else {
            XB_SPIN(xb_ld(&bar[XB_XGEN(b.x)]) == gen, bar);
            __builtin_amdgcn_fence(__ATOMIC_ACQUIRE, "agent");
            asm volatile("s_waitcnt vmcnt(0)" ::: "memory");
        }
    }
    __syncthreads();
}

constexpr int NWAVES = 8, NTHR = 512;
#ifndef WGM_GU
#define WGM_GU 4
#endif
#ifndef WGM_IN
#define WGM_IN 4
#endif
#ifndef WGM_R
#define WGM_R 8
#endif
constexpr int D = 1024, FF = 2816, NPJ = 3462, NPP = 3584;
constexpr int TP = 16384, TS = 128, TOK = TP + TS, MP = 16640;
constexpr int DEPTH = 4;
constexpr int C_Q = 1024, C_K = 1408, C_V = 1792, C_Z = 2176, C_XBC = 2560, C_DT = 3456;
constexpr float NORM_EPS = 1e-6f, GN_EPS = 64e-5f, NEG_INF = -1e30f;
constexpr size_t O_YP = 0, O_YS = 16777216, O_PK = 16908288, O_PV = 42074112, O_PSH = 67239936, O_PR = 67272704, O_PC = 67796992, O_PS = 67883008,
                 O_SK = 69455872, O_SV = 69652480, O_SSH = 69849088, O_SR = 69980160, O_SC = 72077312, O_SS = 72421376, O_END = 78712832;
constexpr size_t MiB = 1u << 20;
constexpr size_t WS_CTL = 0, CTL_ZERO_BYTES = 1 * MiB;
constexpr size_t SZ_WGU = (size_t)2 * FF * D * 2, SZ_WD = (size_t)D * FF * 2, SZ_WIN = (size_t)NPP * D * 2, SZ_WOUT = (size_t)D * D * 2;
constexpr size_t WL_GU1 = 0, WL_D1 = WL_GU1 + SZ_WGU, WL_IN = WL_D1 + SZ_WD, WL_OUT = WL_IN + SZ_WIN, WL_GU2 = WL_OUT + SZ_WOUT, WL_D2 = WL_GU2 + SZ_WGU, WL_SIZE = WL_D2 + SZ_WD;
static_assert(WL_SIZE == 44040192, "per-layer bf16 weight bytes");
constexpr size_t WS_REC = 488 * MiB; constexpr int REC_BYTES = 13312, REC_N = 10240, REC_T = 11776, REC_G = 12288;
constexpr size_t WS_LW = 1 * MiB, LW_SIZE = 131072;
constexpr size_t WS_W = 2 * MiB;
constexpr size_t WS_X = 176 * MiB, WS_XB = 242 * MiB, WS_SSQ = 276 * MiB, WS_H = 280 * MiB, WS_P = 372 * MiB, WS_OPS = 488 * MiB, WS_G = 586 * MiB, WS_SC = 603 * MiB,
                 WS_YS = 604 * MiB, WS_XC = 622 * MiB, WS_DT = 651 * MiB, WS_YC = 652 * MiB, WS_AP = 678 * MiB, WS_AM = 752 * MiB, WS_AL = 754 * MiB, WS_YM = 756 * MiB, WS_END = 790 * MiB;
static_assert(WS_W + 4 * WL_SIZE <= WS_X && WS_X + (size_t)MP * D * 4 <= WS_XB && WS_XB + (size_t)MP * D * 2 <= WS_SSQ && WS_SSQ + (size_t)MP * 64 <= WS_H && WS_H + (size_t)MP * FF * 2 <= WS_P &&
              WS_P + (size_t)MP * NPP * 2 <= WS_OPS && WS_OPS + (size_t)TOK * 4 * 384 * 4 <= WS_G && WS_G + (size_t)TOK * 256 * 4 <= WS_SC && WS_SC + (size_t)TOK * 32 <= WS_YS &&
              WS_YS + (size_t)TOK * 256 * 4 <= WS_XC && WS_XC + (size_t)TOK * 896 * 2 <= WS_DT && WS_DT + (size_t)TOK * 32 <= WS_YC && WS_YC + (size_t)TOK * 384 * 4 <= WS_AP &&
              WS_AP + (size_t)3 * TOK * 384 * 4 <= WS_AM && WS_AM + (size_t)3 * TOK * 32 <= WS_AL && WS_AL + (size_t)3 * TOK * 32 <= WS_YM && WS_YM + (size_t)MP * D * 2 <= WS_END, "d_ws map");
constexpr int CW_BAR = 4096;
constexpr int CW_Q = 16384;
constexpr int RING_BYTES = 131072, LDSCTL_OFF = RING_BYTES, MISC_OFF = LDSCTL_OFF + 320, LDS_BYTES = 147456;

typedef unsigned v2u __attribute__((ext_vector_type(2)));

#ifndef PHASE_FN
#define PHASE_FN __attribute__((noinline)) static
#endif
struct KArgs { const float* in[38]; float* out; unsigned char* ws; };
#define CAS __attribute__((address_space(4)))
struct KA {
    const CAS unsigned char* kp;
    __device__ __forceinline__ const float* in(int k) const { return *(const float* const CAS*)(kp + 8 * k); }
    __device__ __forceinline__ float* out() const { return *(float* const CAS*)(kp + 304); }
    __device__ __forceinline__ unsigned char* ws() const { return *(unsigned char* const CAS*)(kp + 312); }
};
__device__ __forceinline__ KA make_ka() { KA k; k.kp = (const CAS unsigned char*)__builtin_amdgcn_kernarg_segment_ptr(); asm volatile("" : "+s"(k.kp)); return k; }
__device__ __forceinline__ int fresh_tid() { int t = threadIdx.x; asm volatile("" : "+v"(t)); return t; }

__device__ __forceinline__ float bf2f(bf16 u) { return __uint_as_float((unsigned)u << 16); }
__device__ __forceinline__ float bflo(unsigned u) { return __uint_as_float(u << 16); }
__device__ __forceinline__ float bfhi(unsigned u) { return __uint_as_float(u & 0xffff0000u); }
__device__ __forceinline__ bf16 f2bf_s(float f) { unsigned u = __float_as_uint(f); return (bf16)((u + 0x7fffu + ((u >> 16) & 1u)) >> 16); }
template <int CTRL> __device__ __forceinline__ float dppf(float v) { return __builtin_bit_cast(float, __builtin_amdgcn_update_dpp(0, __builtin_bit_cast(int, v), CTRL, 0xF, 0xF, true)); }
template <int N> __device__ __forceinline__ float dpp_shr(float v, float fill) { return __builtin_bit_cast(float, __builtin_amdgcn_update_dpp(__builtin_bit_cast(int, fill), __builtin_bit_cast(int, v), 0x110 + N, 0xF, 0xF, false)); }
__device__ __forceinline__ float red8(float v) { v += dppf<0xB1>(v); v += dppf<0x4E>(v); v += dppf<0x141>(v); return v; }
__device__ __forceinline__ float wave_sum(float v) { v += dppf<0xB1>(v); v += dppf<0x4E>(v); v += dppf<0x141>(v); v += dppf<0x140>(v); v = pg8::xsum16(v); return pg8::xsum32(v); }
__device__ __forceinline__ float wave_max(float v) { v = fmaxf(v, dppf<0xB1>(v)); v = fmaxf(v, dppf<0x4E>(v)); v = fmaxf(v, dppf<0x141>(v)); v = fmaxf(v, dppf<0x140>(v)); v = pg8::xmax16(v); return pg8::xmax32(v); }
__device__ __forceinline__ float sigmoidf_(float x) { return __builtin_amdgcn_rcpf(1.0f + __builtin_amdgcn_exp2f(-1.4426950408889634f * x)); }
__device__ __forceinline__ float tanhf_(float x) { return 2.0f * sigmoidf_(2.0f * x) - 1.0f; }
__device__ __forceinline__ float softplusf_(float x) { return fmaxf(x, 0.f) + 0.6931471805599453f * __builtin_amdgcn_logf(1.0f + __builtin_amdgcn_exp2f(-1.4426950408889634f * fabsf(x))); }
template <int K> __device__ __forceinline__ f32x4 tile_mma(f32x4 acc, const LAS bf16* A, int lda, const LAS bf16* B, int ldb, int lane) {
    const LAS bf16* ap = A + (lane & 15) * lda + 8 * (lane >> 4); const LAS bf16* bp = B + (lane & 15) * ldb + 8 * (lane >> 4);
#pragma unroll
    for (int k = 0; k < K; k += 32) acc = __builtin_amdgcn_mfma_f32_16x16x32_bf16(*(const LAS bf16x8*)(ap + k), *(const LAS bf16x8*)(bp + k), acc, 0, 0, 0);
    return acc;
}

template <int MODE, int VW> __device__ __forceinline__ void tr_item(const float* W, int K, int N, const float* gain, bf16* WT, LAS float* scr, int kb, int nb, int lane) {
    const int k0 = 64 * kb, n0 = 32 * nb;
    constexpr int LPR = 32 / VW, RPI = 64 / LPR, NI = 64 / RPI;
    const int rr = lane / LPR, cc = (lane % LPR) * VW;
    float v[NI][VW];
#pragma unroll
    for (int i = 0; i < NI; ++i) { const int kk = RPI * i + rr; const float* p = W + (size_t)(k0 + kk) * N + n0 + cc;
        if (n0 + 32 <= N) { if (VW == 4) { const f32x4 t = *(const f32x4*)p; v[i][0] = t[0]; v[i][1] = t[1]; v[i][VW - 2] = t[2]; v[i][VW - 1] = t[3]; } else { const pg8::f32x2 t = *(const pg8::f32x2*)p; v[i][0] = t[0]; v[i][1] = t[1]; } }
        else {
#pragma unroll
            for (int e = 0; e < VW; ++e) v[i][e] = (n0 + cc + e < N) ? p[e] : 0.f; } }
#pragma unroll
    for (int i = 0; i < NI; ++i) { const int kk = RPI * i + rr; const float g = gain ? gain[k0 + kk] : 1.0f;
#pragma unroll
        for (int e = 0; e < VW; ++e) scr[kk * 33 + cc + e] = v[i][e] * g; }
    asm volatile("s_waitcnt lgkmcnt(0)" ::: "memory");
    const int c = lane & 7;
#pragma unroll
    for (int j = 0; j < 4; ++j) { const int nl = (lane >> 3) + 8 * j, n = n0 + nl; const LAS float* sp = scr + (8 * c) * 33 + nl;
        v4u o; o.x = pg8::cvt_pk_bf16(sp[0 * 33], sp[1 * 33]); o.y = pg8::cvt_pk_bf16(sp[2 * 33], sp[3 * 33]); o.z = pg8::cvt_pk_bf16(sp[4 * 33], sp[5 * 33]); o.w = pg8::cvt_pk_bf16(sp[6 * 33], sp[7 * 33]);
        const int drow = (MODE == 0) ? n : 8 * (n >> 2) + 4 * (MODE - 1) + (n & 3);
        *(v4u*)(WT + (size_t)drow * K + k0 + 8 * c) = o; }
    asm volatile("s_waitcnt lgkmcnt(0)" ::: "memory");
}
constexpr int I_G = 16 * 88, I_D = 44 * 32, I_IN = 16 * 112, I_OUT = 16 * 32, I_LAYER = 6 * 1408 + I_IN + I_OUT;
static_assert(I_G == 1408 && I_D == 1408 && I_LAYER % 8 == 0, "items");
__device__ __forceinline__ void wconv_item(const KA a, int l, int r, LAS float* scr, int lane) {
    bf16* wl = (bf16*)(a.ws() + WS_W + (size_t)l * WL_SIZE);
    if (r < I_G) { tr_item<1, 4>(a.in(9) + (size_t)l * D * FF, D, FF, a.in(8) + l * D, (bf16*)((unsigned char*)wl + WL_GU1), scr, r / 88, r % 88, lane); return; } r -= I_G;
    if (r < I_G) { tr_item<2, 4>(a.in(10) + (size_t)l * D * FF, D, FF, a.in(8) + l * D, (bf16*)((unsigned char*)wl + WL_GU1), scr, r / 88, r % 88, lane); return; } r -= I_G;
    if (r < I_D) { tr_item<0, 4>(a.in(11) + (size_t)l * D * FF, FF, D, nullptr, (bf16*)((unsigned char*)wl + WL_D1), scr, r / 32, r % 32, lane); return; } r -= I_D;
    if (r < I_IN) { tr_item<0, 2>(a.in(13) + (size_t)l * D * NPJ, D, NPJ, a.in(12) + l * D, (bf16*)((unsigned char*)wl + WL_IN), scr, r / 112, r % 112, lane); return; } r -= I_IN;
    if (r < I_OUT) { tr_item<0, 4>(a.in(32) + (size_t)l * D * D, D, D, nullptr, (bf16*)((unsigned char*)wl + WL_OUT), scr, r / 32, r % 32, lane); return; } r -= I_OUT;
    if (r < I_G) { tr_item<1, 4>(a.in(34) + (size_t)l * D * FF, D, FF, a.in(33) + l * D, (bf16*)((unsigned char*)wl + WL_GU2), scr, r / 88, r % 88, lane); return; } r -= I_G;
    if (r < I_G) { tr_item<2, 4>(a.in(35) + (size_t)l * D * FF, D, FF, a.in(33) + l * D, (bf16*)((unsigned char*)wl + WL_GU2), scr, r / 88, r % 88, lane); return; } r -= I_G;
    tr_item<0, 4>(a.in(36) + (size_t)l * D * FF, FF, D, nullptr, (bf16*)((unsigned char*)wl + WL_D2), scr, r / 32, r % 32, lane);
}
__device__ __forceinline__ void p0_prologue(const KA a, LAS unsigned char* lds, int tid) {
    const int lane = tid & 63, wave = __builtin_amdgcn_readfirstlane(tid >> 6), gw = blockIdx.x * NWAVES + wave; int NGW = gridDim.x * NWAVES; asm volatile("" : "+s"(NGW));
    LAS float* scr = (LAS float*)(lds + wave * 16384);
    for (int it = gw; it < DEPTH * 32; it += NGW) {
        const int l = it >> 5, r = it & 31; bf16* lw = (bf16*)(a.ws() + WS_LW + (size_t)l * LW_SIZE);
        if (r < 8) tr_item<0, 4>(a.in(16) + (size_t)l * 64 * 256, 64, 256, nullptr, lw, scr, 0, r, lane);
        else if (r < 16) tr_item<0, 4>(a.in(18) + (size_t)l * 64 * 256, 64, 256, nullptr, lw + 256 * 64, scr, 0, r - 8, lane);
        else tr_item<0, 4>(a.in(19) + (size_t)l * 128 * 256, 128, 256, nullptr, lw + 2 * 256 * 64, scr, (r - 16) >> 3, (r - 16) & 7, lane);
    }
    for (int it = gw; it < I_LAYER; it += NGW) wconv_item(a, 0, it, scr, lane);
}
__device__ __forceinline__ void wconv_unit(const KA a, int l, int u, LAS unsigned char* lds, int tid) {
    const int lane = tid & 63, wave = __builtin_amdgcn_readfirstlane(tid >> 6);
    wconv_item(a, l, u * 8 + wave, (LAS float*)(lds + wave * 16384), lane);
}
PHASE_FN __device__ void p0_xinit(const KA a, int tid) {
    const int lane = tid & 63, wave = __builtin_amdgcn_readfirstlane(tid >> 6), gw = blockIdx.x * NWAVES + wave; int NGW = gridDim.x * NWAVES; asm volatile("" : "+s"(NGW));
    float* X = (float*)(a.ws() + WS_X); bf16* XB = (bf16*)(a.ws() + WS_XB); float* SSQ = (float*)(a.ws() + WS_SSQ); bf16* YM = (bf16*)(a.ws() + WS_YM);
    for (int m = gw; m < MP; m += NGW) {
        const float* src = (m < TP) ? a.in(0) + (size_t)m * D : a.in(1) + (size_t)(m - TP) * D;
        f32x4 v[4]; float s = 0.f;
#pragma unroll
        for (int j = 0; j < 4; ++j) { v[j] = (m < TOK) ? ((const f32x4*)src)[lane + 64 * j] : (f32x4){0.f, 0.f, 0.f, 0.f}; s += (v[j][0] * v[j][0] + v[j][1] * v[j][1]) + (v[j][2] * v[j][2] + v[j][3] * v[j][3]); }
        s = wave_sum(s);
#pragma unroll
        for (int j = 0; j < 4; ++j) {
            v2u w; w.x = pg8::cvt_pk_bf16(v[j][0], v[j][1]); w.y = pg8::cvt_pk_bf16(v[j][2], v[j][3]); ((v2u*)(XB + (size_t)m * D))[lane + 64 * j] = w;
            if (m >= TOK) ((v2u*)(YM + (size_t)m * D))[lane + 64 * j] = (v2u){0u, 0u}; }
        if (m < TP) { if (lane < 16) SSQ[(size_t)m * 16 + lane] = (lane == 0) ? s : 0.f; }
        else SSQ[pg8::SSQS_OFF + (size_t)(m - TP) * 64 + lane] = (lane == 0) ? s : 0.f;
    }
}

__device__ __forceinline__ v2u pk4(f32x4 v) { v2u w; w.x = pg8::cvt_pk_bf16(v[0], v[1]); w.y = pg8::cvt_pk_bf16(v[2], v[3]); return w; }
__device__ __forceinline__ f32x4 up4(v2u w) { return (f32x4){bflo(w.x), bfhi(w.x), bflo(w.y), bfhi(w.y)}; }
__device__ __forceinline__ void ld8(float (&d)[8], const bf16* p) { const v4u w = *(const v4u*)p; d[0] = bflo(w.x); d[1] = bfhi(w.x); d[2] = bflo(w.y); d[3] = bfhi(w.y); d[4] = bflo(w.z); d[5] = bfhi(w.z); d[6] = bflo(w.w); d[7] = bfhi(w.w); }
__device__ __forceinline__ void ld4(float (&d)[4], const bf16* p) { const v2u w = *(const v2u*)p; d[0] = bflo(w.x); d[1] = bfhi(w.x); d[2] = bflo(w.y); d[3] = bfhi(w.y); }
__device__ __forceinline__ void rwkv_prep(const KA a, int l, LAS unsigned char* lds, int tid) {
    const int lane = tid & 63, wave = __builtin_amdgcn_readfirstlane(tid >> 6);
    int ngrp = gridDim.x >> 2; asm volatile("" : "+s"(ngrp));
    const int h = blockIdx.x & 3, wv = (blockIdx.x >> 2) * NWAVES + wave, NW = ngrp * NWAVES;
    if ((int)(blockIdx.x >> 2) >= ngrp) return;
    const int fr = lane & 15, fq = lane >> 4;
    const bf16* P = (const bf16*)(a.ws() + WS_P);
    const bf16* w2t = (const bf16*)(a.ws() + WS_LW + (size_t)l * LW_SIZE); const bf16* a2t = w2t + 256 * 64; const bf16* g2t = a2t + 256 * 64;
    LAS bf16* W2 = (LAS bf16*)lds; LAS bf16* A2 = W2 + 64 * 72; LAS bf16* G2 = A2 + 64 * 72;
    { const int r = tid >> 3, c = tid & 7;
      *(LAS v4u*)(W2 + r * 72 + c * 8) = *(const v4u*)(w2t + (size_t)(64 * h + r) * 64 + c * 8); *(LAS v4u*)(A2 + r * 72 + c * 8) = *(const v4u*)(a2t + (size_t)(64 * h + r) * 64 + c * 8);
#pragma unroll
      for (int q = 0; q < 2; ++q) { const int idx = tid + NTHR * q, rr = idx >> 4, cc = idx & 15; *(LAS v4u*)(G2 + rr * 136 + cc * 8) = *(const v4u*)(g2t + (size_t)(64 * h + rr) * 128 + cc * 8); } }
    __syncthreads();
    const float* mu = a.in(14) + l * 1024;
    float* G = (float*)(a.ws() + WS_G); float* SC = (float*)(a.ws() + WS_SC);
    for (int tile = wv; tile < TOK / 16; tile += NW) {
        const int row = tile * 16 + fr;
        bool first; const float* sh = nullptr;
        if (row < TP) first = (row & 2047) == 0; else { const int r = row - TP; first = (r & 3) == 0; sh = a.in(4) + (size_t)(l * 32 + (r >> 2)) * 1024; }
        const bf16* pc = P + (size_t)row * NPP; const bf16* pq = first ? pc : pc - NPP;
        bf16x8 fw[2], fa[2], fg[4];
#pragma unroll
        for (int ks = 0; ks < 8; ++ks) { const int col = 768 + 32 * ks + 8 * fq;
            float c[8], p[8]; ld8(c, pc + col); ld8(p, pq + col);
            const f32x4 m0 = *(const f32x4*)(mu + col), m1 = *(const f32x4*)(mu + col + 4);
            if (first) { if (sh) { const f32x4 s0 = *(const f32x4*)(sh + col), s1 = *(const f32x4*)(sh + col + 4);
#pragma unroll
                    for (int e = 0; e < 4; ++e) { p[e] = s0[e]; p[4 + e] = s1[e]; } } else {
#pragma unroll
                    for (int e = 0; e < 8; ++e) p[e] = 0.f; } }
            float x[8];
#pragma unroll
            for (int e = 0; e < 8; ++e) { const float m = (e < 4) ? m0[e & 3] : m1[e & 3]; const float ps = c[e] + m * (p[e] - c[e]); x[e] = (ks < 2) ? tanhf_(ps) : (ks < 4 ? ps : sigmoidf_(ps)); }
            union { bf16x8 v; unsigned u[4]; } f; f.u[0] = pg8::cvt_pk_bf16(x[0], x[1]); f.u[1] = pg8::cvt_pk_bf16(x[2], x[3]); f.u[2] = pg8::cvt_pk_bf16(x[4], x[5]); f.u[3] = pg8::cvt_pk_bf16(x[6], x[7]);
            if (ks < 2) fw[ks] = f.v; else if (ks < 4) fa[ks - 2] = f.v; else fg[ks - 4] = f.v;
            if (ks & 1) { } }
        {
            f32x4 aw[4], aa[4], ag[4];
#pragma unroll
            for (int t = 0; t < 4; ++t) { const int n = 16 * t + fr;
                const LAS bf16* wp = W2 + n * 72 + 8 * fq; const LAS bf16* ap = A2 + n * 72 + 8 * fq; const LAS bf16* gp = G2 + n * 136 + 8 * fq;
                f32x4 z = (f32x4){0.f, 0.f, 0.f, 0.f};
                aw[t] = __builtin_amdgcn_mfma_f32_16x16x32_bf16(*(const LAS bf16x8*)wp, fw[0], z, 0, 0, 0); aw[t] = __builtin_amdgcn_mfma_f32_16x16x32_bf16(*(const LAS bf16x8*)(wp + 32), fw[1], aw[t], 0, 0, 0);
                aa[t] = __builtin_amdgcn_mfma_f32_16x16x32_bf16(*(const LAS bf16x8*)ap, fa[0], z, 0, 0, 0); aa[t] = __builtin_amdgcn_mfma_f32_16x16x32_bf16(*(const LAS bf16x8*)(ap + 32), fa[1], aa[t], 0, 0, 0);
                ag[t] = __builtin_amdgcn_mfma_f32_16x16x32_bf16(*(const LAS bf16x8*)gp, fg[0], z, 0, 0, 0); ag[t] = __builtin_amdgcn_mfma_f32_16x16x32_bf16(*(const LAS bf16x8*)(gp + 32), fg[1], ag[t], 0, 0, 0);
                ag[t] = __builtin_amdgcn_mfma_f32_16x16x32_bf16(*(const LAS bf16x8*)(gp + 64), fg[2], ag[t], 0, 0, 0); ag[t] = __builtin_amdgcn_mfma_f32_16x16x32_bf16(*(const LAS bf16x8*)(gp + 96), fg[3], ag[t], 0, 0, 0);
                *(f32x4*)(G + (size_t)row * 256 + 64 * h + 16 * t + 4 * fq) = ag[t]; }
            float r[4][4], k[4][4];
#pragma unroll
            for (int t = 0; t < 4; ++t) { const int c = 64 * h + 16 * t + 4 * fq;
#pragma unroll
                for (int part = 0; part < 2; ++part) { const int col = 256 * part + c; float cc[4], pp[4]; ld4(cc, pc + col); ld4(pp, pq + col);
                    const f32x4 m = *(const f32x4*)(mu + col);
                    if (first) { if (sh) { const f32x4 s0 = *(const f32x4*)(sh + col);
#pragma unroll
                            for (int e = 0; e < 4; ++e) pp[e] = s0[e]; } else {
#pragma unroll
                            for (int e = 0; e < 4; ++e) pp[e] = 0.f; } }
#pragma unroll
                    for (int e = 0; e < 4; ++e) { const float ps = cc[e] + m[e] * (pp[e] - cc[e]); if (part == 0) r[t][e] = ps; else k[t][e] = ps; } } }
            float n2 = 0.f;
#pragma unroll
            for (int t = 0; t < 4; ++t) { const int c = l * 256 + 64 * h + 16 * t + 4 * fq;
                const f32x4 w0 = *(const f32x4*)(a.in(15) + c), a0 = *(const f32x4*)(a.in(17) + c), kkw = *(const f32x4*)(a.in(20) + c);
#pragma unroll
                for (int e = 0; e < 4; ++e) { const float wlog = -softplusf_(-(w0[e] + aw[t][e])) - 0.5f; aw[t][e] = __expf(-__expf(wlog)); aa[t][e] = sigmoidf_(a0[e] + aa[t][e]); const float kk = k[t][e] * kkw[e]; n2 += kk * kk; } }
            n2 = pg8::xsum16(n2); n2 = pg8::xsum32(n2);
            const float inv = 1.0f / fmaxf(sqrtf(n2), 1e-12f);
            float br = 0.f, kr = 0.f, bon = 0.f;
#pragma unroll
            for (int t = 0; t < 4; ++t) { const int c = l * 256 + 64 * h + 16 * t + 4 * fq;
                const f32x4 kkw = *(const f32x4*)(a.in(20) + c), kaw = *(const f32x4*)(a.in(21) + c), rkw = *(const f32x4*)(a.in(22) + c);
#pragma unroll
                for (int e = 0; e < 4; ++e) { const float kk = k[t][e] * kkw[e] * inv, av = aa[t][e], kt = k[t][e] * (1.f + (av - 1.f) * kaw[e]);
                    br += kk * av * r[t][e]; kr += kt * r[t][e]; bon += r[t][e] * kt * rkw[e]; } }
            br = pg8::xsum16(br); br = pg8::xsum32(br); kr = pg8::xsum16(kr); kr = pg8::xsum32(kr); bon = pg8::xsum16(bon); bon = pg8::xsum32(bon);
            unsigned char* rec = a.ws() + WS_REC + (size_t)(tile * 4 + h) * REC_BYTES;
            const bool samp = tile >= TP / 16;
            const bool c1 = !samp || (fr & 3) >= 1, c2 = !samp || (fr & 3) >= 2;
            f32x4 At4[4], Rt4[4], Bt4[4], Kt4[4];
#pragma unroll
            for (int t = 0; t < 4; ++t) { const int c = l * 256 + 64 * h + 16 * t + 4 * fq;
                const f32x4 kkw = *(const f32x4*)(a.in(20) + c), kaw = *(const f32x4*)(a.in(21) + c);
                f32x4 vv;
                { const int col = 512 + 64 * h + 16 * t + 4 * fq; float cc[4], pp[4]; ld4(cc, pc + col); ld4(pp, pq + col); const f32x4 m = *(const f32x4*)(mu + col);
                  if (first) { if (sh) { const f32x4 q0 = *(const f32x4*)(sh + col);
#pragma unroll
                          for (int e = 0; e < 4; ++e) pp[e] = q0[e]; } else {
#pragma unroll
                          for (int e = 0; e < 4; ++e) pp[e] = 0.f; } }
#pragma unroll
                  for (int e = 0; e < 4; ++e) vv[e] = cc[e] + m[e] * (pp[e] - cc[e]); }
                f32x4 gend;
#pragma unroll
                for (int e = 0; e < 4; ++e) { const float kk = k[t][e] * kkw[e] * inv, av = aa[t][e], w = aw[t][e], kt = k[t][e] * (1.f + (av - 1.f) * kaw[e]);
                    float g = w, x;
                    x = dpp_shr<1>(g, 1.0f); g *= c1 ? x : 1.0f;
                    x = dpp_shr<2>(g, 1.0f); g *= c2 ? x : 1.0f;
                    x = dpp_shr<4>(g, 1.0f); g *= samp ? 1.0f : x;
                    x = dpp_shr<8>(g, 1.0f); g *= samp ? 1.0f : x;
                    x = dpp_shr<1>(g, 1.0f); const float gm = c1 ? x : 1.0f;
                    const float ig = __builtin_amdgcn_rcpf(g);
                    At4[t][e] = -gm * kk; Rt4[t][e] = gm * (w * r[t][e] - kk * br); Bt4[t][e] = kk * av * ig; Kt4[t][e] = kt * ig; gend[e] = g; }
                const size_t eo = ((size_t)fr * 64 + 16 * t + 4 * fq) * 2;
                *(v2u*)(rec + eo) = pk4(At4[t]); *(v2u*)(rec + 2048 + eo) = pk4(Rt4[t]); *(v2u*)(rec + 4096 + eo) = pk4(Bt4[t]); *(v2u*)(rec + 6144 + eo) = pk4(Kt4[t]); *(v2u*)(rec + 8192 + eo) = pk4(vv);
                if (samp ? ((fr & 3) == 3) : (fr == 15)) *(f32x4*)(rec + REC_G + ((samp ? (fr >> 2) : 0) * 64 + 16 * t + 4 * fq) * 4) = gend; }
            { union FR { bf16x8 v; unsigned u[4]; } fA[2], fR[2], fB[2], fK[2];
#pragma unroll
              for (int ks = 0; ks < 2; ++ks) { const v2u a0 = pk4(At4[2 * ks]), a1 = pk4(At4[2 * ks + 1]), r0 = pk4(Rt4[2 * ks]), r1 = pk4(Rt4[2 * ks + 1]), b0 = pk4(Bt4[2 * ks]), b1 = pk4(Bt4[2 * ks + 1]), k0 = pk4(Kt4[2 * ks]), k1 = pk4(Kt4[2 * ks + 1]);
                  fA[ks].u[0] = a0.x; fA[ks].u[1] = a0.y; fA[ks].u[2] = a1.x; fA[ks].u[3] = a1.y; fR[ks].u[0] = r0.x; fR[ks].u[1] = r0.y; fR[ks].u[2] = r1.x; fR[ks].u[3] = r1.y;
                  fB[ks].u[0] = b0.x; fB[ks].u[1] = b0.y; fB[ks].u[2] = b1.x; fB[ks].u[3] = b1.y; fK[ks].u[0] = k0.x; fK[ks].u[1] = k0.y; fK[ks].u[2] = k1.x; fK[ks].u[3] = k1.y; }
              const f32x4 z4 = (f32x4){0.f, 0.f, 0.f, 0.f};
              f32x4 nba = __builtin_amdgcn_mfma_f32_16x16x32_bf16(fB[0].v, fA[0].v, z4, 0, 0, 0); nba = __builtin_amdgcn_mfma_f32_16x16x32_bf16(fB[1].v, fA[1].v, nba, 0, 0, 0);
              f32x4 nka = __builtin_amdgcn_mfma_f32_16x16x32_bf16(fK[0].v, fA[0].v, z4, 0, 0, 0); nka = __builtin_amdgcn_mfma_f32_16x16x32_bf16(fK[1].v, fA[1].v, nka, 0, 0, 0);
              f32x4 nbr = __builtin_amdgcn_mfma_f32_16x16x32_bf16(fB[0].v, fR[0].v, z4, 0, 0, 0); nbr = __builtin_amdgcn_mfma_f32_16x16x32_bf16(fB[1].v, fR[1].v, nbr, 0, 0, 0);
              f32x4 nkr = __builtin_amdgcn_mfma_f32_16x16x32_bf16(fK[0].v, fR[0].v, z4, 0, 0, 0); nkr = __builtin_amdgcn_mfma_f32_16x16x32_bf16(fK[1].v, fR[1].v, nkr, 0, 0, 0);
              LAS float* Nb = (LAS float*)(lds + 36864) + wave * 288;
#pragma unroll
              for (int e = 0; e < 4; ++e) { const int sN = 4 * fq + e, tN = fr; const bool keep = (sN < tN) && (!samp || (sN >> 2) == (tN >> 2));
                  nba[e] = keep ? nba[e] : 0.f; nka[e] = keep ? nka[e] : 0.f; nbr[e] = keep ? nbr[e] : 0.f; nkr[e] = keep ? nkr[e] : 0.f;
                  Nb[sN * 17 + tN] = nba[e];
                  bf16* np = (bf16*)(rec + REC_N) + sN * 16 + tN; np[0] = f2bf_s(nka[e]); np[256] = f2bf_s(nbr[e]); np[512] = f2bf_s(nkr[e]); }
              asm volatile("s_waitcnt lgkmcnt(0)" ::: "memory");
              float Tr[16];
#pragma unroll
              for (int t = 0; t < 16; ++t) { float acc = (fr == t) ? 1.f : 0.f;
#pragma unroll
                  for (int sN = 0; sN < t; ++sN) acc += Tr[sN] * Nb[sN * 17 + t];
                  Tr[t] = acc; }
              if (fq == 0) { v4u o0, o1; o0.x = pg8::cvt_pk_bf16(Tr[0], Tr[1]); o0.y = pg8::cvt_pk_bf16(Tr[2], Tr[3]); o0.z = pg8::cvt_pk_bf16(Tr[4], Tr[5]); o0.w = pg8::cvt_pk_bf16(Tr[6], Tr[7]);
                  o1.x = pg8::cvt_pk_bf16(Tr[8], Tr[9]); o1.y = pg8::cvt_pk_bf16(Tr[10], Tr[11]); o1.z = pg8::cvt_pk_bf16(Tr[12], Tr[13]); o1.w = pg8::cvt_pk_bf16(Tr[14], Tr[15]);
                  *(v4u*)(rec + REC_T + fr * 32) = o0; *(v4u*)(rec + REC_T + fr * 32 + 16) = o1; }
              asm volatile("s_waitcnt lgkmcnt(0)" ::: "memory"); }
            if (fq == 0) { SC[(size_t)(row * 4 + h) * 2] = kr; SC[(size_t)(row * 4 + h) * 2 + 1] = bon; }
        }
    }
}

PHASE_FN __device__ void prep_elementwise(const KA a, int l, int tid) {
    int skipb = (gridDim.x > 8) ? 4 : 0; asm volatile("" : "+s"(skipb));
    if ((int)blockIdx.x < skipb) return;
    const int gtid = ((int)blockIdx.x - skipb) * NTHR + tid; int GT = ((int)gridDim.x - skipb) * NTHR; asm volatile("" : "+s"(GT));
    const bf16* P = (const bf16*)(a.ws() + WS_P); bf16* XC = (bf16*)(a.ws() + WS_XC); float* DT = (float*)(a.ws() + WS_DT); float* out = a.out();
    const float* cw = a.in(26) + (size_t)l * 4 * 896; const float* cb = a.in(27) + l * 896;
    for (int idx = gtid; idx < (TOK / 4) * 112; idx += GT) {
        const int grp = idx / 112, c8 = idx - grp * 112, col = c8 * 8, row0 = grp * 4;
        int t0, b = 0; if (row0 < TP) t0 = row0 & 2047; else { b = (row0 - TP) >> 2; t0 = 0; }
        float x[7][8];
#pragma unroll
        for (int i = 0; i < 7; ++i) { const int tt = t0 - 3 + i;
            if (tt >= 0) ld8(x[i], P + (size_t)(row0 - 3 + i) * NPP + C_XBC + col);
            else if (row0 < TP) {
#pragma unroll
                for (int e = 0; e < 8; ++e) x[i][e] = 0.f; }
            else { const float* s = a.in(6) + ((size_t)(l * 32 + b) * 3 + i) * 896 + col; const f32x4 s0 = *(const f32x4*)s, s1 = *(const f32x4*)(s + 4);
#pragma unroll
                for (int e = 0; e < 4; ++e) { x[i][e] = s0[e]; x[i][4 + e] = s1[e]; } } }
        float wv[4][8], bv[8];
#pragma unroll
        for (int i = 0; i < 4; ++i) { const f32x4 w0 = *(const f32x4*)(cw + i * 896 + col), w1 = *(const f32x4*)(cw + i * 896 + col + 4);
#pragma unroll
            for (int e = 0; e < 4; ++e) { wv[i][e] = w0[e]; wv[i][4 + e] = w1[e]; } }
        { const f32x4 b0 = *(const f32x4*)(cb + col), b1 = *(const f32x4*)(cb + col + 4);
#pragma unroll
          for (int e = 0; e < 4; ++e) { bv[e] = b0[e]; bv[4 + e] = b1[e]; } }
#pragma unroll
        for (int j = 0; j < 4; ++j) { float y[8];
#pragma unroll
            for (int e = 0; e < 8; ++e) { float acc = bv[e];
#pragma unroll
                for (int i = 0; i < 4; ++i) acc += wv[i][e] * x[j + i][e];
                y[e] = acc * sigmoidf_(acc); }
            v4u o; o.x = pg8::cvt_pk_bf16(y[0], y[1]); o.y = pg8::cvt_pk_bf16(y[2], y[3]); o.z = pg8::cvt_pk_bf16(y[4], y[5]); o.w = pg8::cvt_pk_bf16(y[6], y[7]);
            *(v4u*)(XC + (size_t)(row0 + j) * 896 + col) = o; }
    }
    for (int idx = gtid; idx < TOK * 6; idx += GT) { const int row = idx / 6, h = idx - row * 6;
        DT[(size_t)row * 8 + h] = softplusf_(bf2f(P[(size_t)row * NPP + C_DT + h]) + a.in(28)[l * 6 + h]); }
    for (int idx0 = gtid; idx0 < TOK * 96; idx0 += 4 * GT) {
        v4u w[4];
#pragma unroll
        for (int j = 0; j < 4; ++j) { const int idx = idx0 + j * GT; if (idx < TOK * 96) { const int row = idx / 96, c8 = idx - row * 96; w[j] = *(const v4u*)(P + (size_t)row * NPP + C_K + c8 * 8); } }
#pragma unroll
        for (int j = 0; j < 4; ++j) { const int idx = idx0 + j * GT; if (idx < TOK * 96) { const int row = idx / 96, c8 = idx - row * 96, which = c8 / 48, cc = (c8 - which * 48) * 8;
            float* dst = (row < TP) ? out + (which ? O_PV : O_PK) + ((size_t)l * TP + row) * 384 + cc : out + (which ? O_SV : O_SK) + ((size_t)l * TS + (row - TP)) * 384 + cc;
            *(f32x4*)dst = (f32x4){bflo(w[j].x), bfhi(w[j].x), bflo(w[j].y), bfhi(w[j].y)}; *(f32x4*)(dst + 4) = (f32x4){bflo(w[j].z), bfhi(w[j].z), bflo(w[j].w), bfhi(w[j].w)}; } }
    }
    for (int idx = gtid; idx < 40 * 1024; idx += GT) { const int s = idx >> 10, col = idx & 1023;
        const int row = (s < 8) ? s * 2048 + 2047 : TP + (s - 8) * 4 + 3;
        float* dst = (s < 8) ? out + O_PSH + (size_t)(l * 8 + s) * 1024 + col : out + O_SSH + (size_t)(l * 32 + s - 8) * 1024 + col;
        *dst = bf2f(P[(size_t)row * NPP + col]); }
    for (int idx = gtid; idx < 40 * 2688; idx += GT) { const int s = idx / 2688, rem = idx - s * 2688, i = rem / 896, col = rem - i * 896;
        const int row = (s < 8) ? s * 2048 + 2045 + i : TP + (s - 8) * 4 + 1 + i;
        float* dst = (s < 8) ? out + O_PC + ((size_t)(l * 8 + s) * 3 + i) * 896 + col : out + O_SC + ((size_t)(l * 32 + s - 8) * 3 + i) * 896 + col;
        *dst = bf2f(P[(size_t)row * NPP + C_XBC + col]); }
}

#define LBAR() asm volatile("s_waitcnt lgkmcnt(0)\n\ts_barrier" ::: "memory")
typedef short v4i16_t __attribute__((ext_vector_type(4)));
constexpr int CB_BYTES = 15872;
__device__ __forceinline__ v4i16_t tr4(const LAS bf16* T, int pitch, int col0, int lane) {
    return __builtin_amdgcn_ds_read_tr16_b64_v4i16((LAS v4i16_t*)(T + (4 * (lane >> 4) + ((lane & 15) >> 2)) * pitch + col0 + 4 * (lane & 3)));
}
typedef __bf16 bf2_t __attribute__((ext_vector_type(2))); typedef float f2v_t __attribute__((ext_vector_type(2)));
__device__ __forceinline__ unsigned cvt_pk_c(float lo, float hi) { const f2v_t v = {lo, hi}; return __builtin_bit_cast(unsigned, __builtin_convertvector(v, bf2_t)); }
__device__ __forceinline__ v4i16_t pack4(f32x4 x) { union { v4i16_t v; unsigned u[2]; } p; p.u[0] = cvt_pk_c(x[0], x[1]); p.u[1] = cvt_pk_c(x[2], x[3]); return p.v; }
PHASE_FN __device__ void rwkv_scan_unit(const KA a, int l, int unit, LAS unsigned char* lds, int tid) {
    int b, h, tile0, nch, seg, row_base; const float* s0; float* sout;
    if (unit < 32) { b = unit >> 2; h = unit & 3; tile0 = b * 128; nch = 128; seg = -1; row_base = b * 2048; s0 = nullptr; sout = a.out() + O_PR + (size_t)((l * 8 + b) * 4 + h) * 4096; }
    else { const int u = unit - 32; b = u >> 2; h = u & 3; tile0 = TP / 16 + (b >> 2); nch = 1; seg = b & 3; row_base = TP + b * 4; s0 = a.in(5) + (size_t)((l * 32 + b) * 4 + h) * 4096; sout = a.out() + O_SR + (size_t)((l * 32 + b) * 4 + h) * 4096; }
    const int lane = tid & 63, wave = __builtin_amdgcn_readfirstlane(tid >> 6), c16 = lane & 15, g = lane >> 4;
    const unsigned char* REC = a.ws() + WS_REC; float* YS = (float*)(a.ws() + WS_YS);
    LAS unsigned char* cbuf = lds;
    LAS bf16* SbAll = (LAS bf16*)(lds + 2 * CB_BYTES);
    if (wave >= 4) {
        const int ht = tid - 256;
        v4u ra[4], rb[4];
#define SC_FETCH(R, cc) do { const unsigned char* src_ = REC + (size_t)((tile0 + (cc)) * 4 + h) * REC_BYTES; \
            _Pragma("unroll") for (int q = 0; q < 4; ++q) { const int ci = ht + 256 * q; R[q] = *(const v4u*)(src_ + (ci < 832 ? ci : 831) * 16); } } while (0)
#define SC_PUT(R, cc) do { LAS unsigned char* dst_ = cbuf + ((cc) & 1) * CB_BYTES; \
            _Pragma("unroll") for (int q = 0; q < 4; ++q) { const int ci = ht + 256 * q; \
                if (ci < 640) { const int m_ = ci >> 7, r_ = (ci & 127) >> 3, k_ = ci & 7; *(LAS v4u*)(dst_ + m_ * 2560 + r_ * 160 + k_ * 16) = R[q]; } \
                else if (ci < 832) *(LAS v4u*)(dst_ + 12800 + (ci - 640) * 16) = R[q]; } } while (0)
#define SC_HELP(c, RL, RW) do { if ((c) + 2 < nch) SC_FETCH(RL, (c) + 2); if ((c) + 1 < nch) SC_PUT(RW, (c) + 1); LBAR(); } while (0)
        SC_FETCH(ra, 0); SC_PUT(ra, 0);
        if (1 < nch) SC_FETCH(rb, 1);
        LBAR();
        for (int c = 0; c < nch; c += 2) {
            SC_HELP(c, ra, rb);
            if (c + 1 < nch) SC_HELP(c + 1, rb, ra);
        }
#undef SC_HELP
#undef SC_PUT
#undef SC_FETCH
    } else {
        const int it = wave;
        LAS bf16* Sb = SbAll + it * (16 * 72);
        f32x4 S[4];
#pragma unroll
        for (int jt = 0; jt < 4; ++jt)
#pragma unroll
            for (int e = 0; e < 4; ++e) S[jt][e] = s0 ? s0[(size_t)(16 * it + 4 * g + e) * 64 + 16 * jt + c16] : 0.f;
        const bool mine = (seg < 0) || (g == seg);
        const v4i16_t zf = (v4i16_t){0, 0, 0, 0};
        LBAR();
        for (int c = 0; c < nch; ++c) {
            const LAS unsigned char* cb = cbuf + (c & 1) * CB_BYTES;
            const LAS bf16* At = (const LAS bf16*)cb; const LAS bf16* Rt = At + 1280; const LAS bf16* Bt = At + 2560; const LAS bf16* Kt = At + 3840; const LAS bf16* Vt = At + 5120;
            const LAS bf16* Nka = (const LAS bf16*)(cb + 12800); const LAS bf16* Nbr = Nka + 256; const LAS bf16* Nkr = Nka + 512; const LAS bf16* Tm = Nka + 768;
            const LAS float* Gam = (const LAS float*)(cb + 14848) + (seg < 0 ? 0 : seg) * 64;
#pragma unroll
            for (int jt = 0; jt < 4; ++jt)
#pragma unroll
                for (int e = 0; e < 4; ++e) Sb[(4 * g + e) * 72 + 16 * jt + c16] = f2bf_s(S[jt][e]);
            asm volatile("s_waitcnt lgkmcnt(0)" ::: "memory");
            const bf16x8 sb0 = *(const LAS bf16x8*)(Sb + c16 * 72 + 8 * g), sb1 = *(const LAS bf16x8*)(Sb + c16 * 72 + 32 + 8 * g);
            v4i16_t fV = tr4(Vt, 80, 16 * it, lane); if (!mine) fV = zf;
            f32x4 a0 = __builtin_amdgcn_mfma_f32_16x16x32_bf16(*(const LAS bf16x8*)(At + c16 * 80 + 8 * g), sb0, (f32x4){0.f, 0.f, 0.f, 0.f}, 0, 0, 0);
            a0 = __builtin_amdgcn_mfma_f32_16x16x32_bf16(*(const LAS bf16x8*)(At + c16 * 80 + 32 + 8 * g), sb1, a0, 0, 0, 0);
            a0 = __builtin_amdgcn_mfma_f32_16x16x16bf16_1k(tr4(Nka, 16, 0, lane), fV, a0, 0, 0, 0);
            const f32x4 ut = __builtin_amdgcn_mfma_f32_16x16x16bf16_1k(tr4(Tm, 16, 0, lane), pack4(a0), (f32x4){0.f, 0.f, 0.f, 0.f}, 0, 0, 0);
            v4i16_t utp = pack4(ut); if (!mine) utp = zf;
            f32x4 z = __builtin_amdgcn_mfma_f32_16x16x32_bf16(*(const LAS bf16x8*)(Rt + c16 * 80 + 8 * g), sb0, (f32x4){0.f, 0.f, 0.f, 0.f}, 0, 0, 0);
            z = __builtin_amdgcn_mfma_f32_16x16x32_bf16(*(const LAS bf16x8*)(Rt + c16 * 80 + 32 + 8 * g), sb1, z, 0, 0, 0);
            z = __builtin_amdgcn_mfma_f32_16x16x16bf16_1k(tr4(Nbr, 16, 0, lane), utp, z, 0, 0, 0);
            z = __builtin_amdgcn_mfma_f32_16x16x16bf16_1k(tr4(Nkr, 16, 0, lane), fV, z, 0, 0, 0);
#pragma unroll
            for (int e = 0; e < 4; ++e) { const int t = 4 * g + e; const int row = (seg < 0) ? row_base + 16 * c + t : row_base + (t & 3);
                if (mine) YS[(size_t)row * 256 + h * 64 + 16 * it + c16] = z[e]; }
#pragma unroll
            for (int jt = 0; jt < 4; ++jt) { f32x4 acc = __builtin_amdgcn_mfma_f32_16x16x16bf16_1k(utp, tr4(Bt, 80, 16 * jt, lane), S[jt], 0, 0, 0);
                acc = __builtin_amdgcn_mfma_f32_16x16x16bf16_1k(fV, tr4(Kt, 80, 16 * jt, lane), acc, 0, 0, 0);
                S[jt] = acc * Gam[16 * jt + c16]; }
            LBAR();
        }
#pragma unroll
        for (int jt = 0; jt < 4; ++jt)
#pragma unroll
            for (int e = 0; e < 4; ++e) sout[(size_t)(16 * it + 4 * g + e) * 64 + 16 * jt + c16] = S[jt][e];
    }
}

constexpr int SD_PC = 144, SD_PX = 80;
__device__ __forceinline__ bf16x8 tr_frag(const LAS bf16* T, int pitch, int k0, int col0, int lane) {
    const int g = lane >> 4, q = (lane & 15) >> 2, p = lane & 3;
    const LAS bf16* a0 = T + (k0 + 8 * g + q) * pitch + col0 + 4 * p;
    union { bf16x8 v; v4i16_t h[2]; } f;
    f.h[0] = __builtin_amdgcn_ds_read_tr16_b64_v4i16((LAS v4i16_t*)a0); f.h[1] = __builtin_amdgcn_ds_read_tr16_b64_v4i16((LAS v4i16_t*)(a0 + 4 * pitch));
    return f.v;
}
PHASE_FN __device__ void ssd_unit(const KA a, int l, int unit, LAS unsigned char* lds, int tid) {
    int b, h, row_base, T; const float* h0; float* hout;
    if (unit < 48) { b = unit / 6; h = unit - b * 6; row_base = b * 2048; T = 2048; h0 = nullptr; hout = a.out() + O_PS + (size_t)((l * 8 + b) * 6 + h) * 8192; }
    else { const int u = unit - 48; b = u / 6; h = u - b * 6; row_base = TP + b * 4; T = 4; h0 = a.in(7) + (size_t)((l * 32 + b) * 6 + h) * 8192; hout = a.out() + O_SS + (size_t)((l * 32 + b) * 6 + h) * 8192; }
    const int g = h / 3, lane = tid & 63, wave = __builtin_amdgcn_readfirstlane(tid >> 6), fr = lane & 15, fq = lane >> 4;
    LAS bf16* Cs = (LAS bf16*)lds;
    LAS bf16* Bs = Cs + 64 * SD_PC;
    LAS bf16* hb = Bs + 64 * SD_PC;
    LAS bf16* xs = hb + 64 * SD_PC;
    LAS bf16* xw = xs + 64 * SD_PX;
    LAS bf16* Sc = xw + 64 * SD_PX;
    LAS float* dt_all = (LAS float*)(Sc + 64 * SD_PX);
    LAS float* ac_all = dt_all + 2048;
    LAS float* a_tmp = ac_all + 2048;
    const bf16* XC = (const bf16*)(a.ws() + WS_XC); const float* DT = (const float*)(a.ws() + WS_DT); bf16* YC = (bf16*)(a.ws() + WS_YC);
    const float A = -__expf(a.in(29)[l * 6 + h]), Dh = a.in(30)[l * 6 + h];
    const int nch = (T + 63) >> 6, TPAD = nch * 64;
    { f32x4 d = (f32x4){0.f, 0.f, 0.f, 0.f};
      if (4 * tid < TPAD) {
#pragma unroll
          for (int e = 0; e < 4; ++e) d[e] = (4 * tid + e < T) ? DT[(size_t)(row_base + 4 * tid + e) * 8 + h] : 0.f;
          *(LAS f32x4*)(dt_all + 4 * tid) = d; *(LAS f32x4*)(a_tmp + 4 * tid) = d * A; }
      __syncthreads();
      if (4 * tid < TPAD) { const int c0 = (4 * tid) & ~63; float s = 0.f;
          for (int k = c0; k < 4 * tid; k += 4) { const f32x4 v = *(const LAS f32x4*)(a_tmp + k); s += (v[0] + v[1]) + (v[2] + v[3]); }
          f32x4 o; o[0] = s + d[0] * A; o[1] = o[0] + d[1] * A; o[2] = o[1] + d[2] * A; o[3] = o[2] + d[3] * A;
          *(LAS f32x4*)(ac_all + 4 * tid) = o; } }
    const int pt = wave >> 1, nt0 = (wave & 1) * 4;
    f32x4 hs[4];
#pragma unroll
    for (int q = 0; q < 4; ++q)
#pragma unroll
        for (int e = 0; e < 4; ++e) hs[q][e] = h0 ? h0[(size_t)(16 * pt + 4 * fq + e) * 128 + 16 * (nt0 + q) + fr] : 0.f;
    v4u pC[2], pB[2], pX;
    const v4u z4 = (v4u){0u, 0u, 0u, 0u};
#pragma unroll
    for (int q = 0; q < 2; ++q) { const int idx = tid + NTHR * q, r = idx >> 4, pc = idx & 15;
        pC[q] = (r < T) ? *(const v4u*)(XC + (size_t)(row_base + r) * 896 + 640 + g * 128 + pc * 8) : z4; pB[q] = (r < T) ? *(const v4u*)(XC + (size_t)(row_base + r) * 896 + 384 + g * 128 + pc * 8) : z4; }
    pX = ((tid >> 3) < T) ? *(const v4u*)(XC + (size_t)(row_base + (tid >> 3)) * 896 + h * 64 + (tid & 7) * 8) : z4;
    LBAR();
    for (int c = 0; c < nch; ++c) {
        const int r0 = row_base + c * 64, nv = (T - c * 64) < 64 ? (T - c * 64) : 64;
        const LAS float* acum = ac_all + c * 64; const LAS float* dtv = dt_all + c * 64;
        const float alast = acum[63];
#pragma unroll
        for (int q = 0; q < 4; ++q)
#pragma unroll
            for (int e = 0; e < 4; ++e) hb[(16 * pt + 4 * fq + e) * SD_PC + 16 * (nt0 + q) + fr] = f2bf_s(hs[q][e]);
#pragma unroll
        for (int q = 0; q < 2; ++q) { const int idx = tid + NTHR * q, r = idx >> 4, pc = idx & 15;
            *(LAS v4u*)(Cs + r * SD_PC + pc * 8) = pC[q]; *(LAS v4u*)(Bs + r * SD_PC + pc * 8) = pB[q]; }
        { const int r = tid >> 3, pc = tid & 7; const float te = __expf(alast - acum[r]) * dtv[r];
          *(LAS v4u*)(xs + r * SD_PX + pc * 8) = pX;
          v4u w; w.x = pg8::cvt_pk_bf16(bflo(pX.x) * te, bfhi(pX.x) * te); w.y = pg8::cvt_pk_bf16(bflo(pX.y) * te, bfhi(pX.y) * te); w.z = pg8::cvt_pk_bf16(bflo(pX.z) * te, bfhi(pX.z) * te); w.w = pg8::cvt_pk_bf16(bflo(pX.w) * te, bfhi(pX.w) * te);
          *(LAS v4u*)(xw + r * SD_PX + pc * 8) = w; }
        if (c + 1 < nch) { const int rn = r0 + 64, nvn = (T - (c + 1) * 64) < 64 ? (T - (c + 1) * 64) : 64;
#pragma unroll
            for (int q = 0; q < 2; ++q) { const int idx = tid + NTHR * q, r = idx >> 4, pc = idx & 15;
                pC[q] = (r < nvn) ? *(const v4u*)(XC + (size_t)(rn + r) * 896 + 640 + g * 128 + pc * 8) : z4; pB[q] = (r < nvn) ? *(const v4u*)(XC + (size_t)(rn + r) * 896 + 384 + g * 128 + pc * 8) : z4; }
            pX = ((tid >> 3) < nvn) ? *(const v4u*)(XC + (size_t)(rn + (tid >> 3)) * 896 + h * 64 + (tid & 7) * 8) : z4; }
        LBAR();
        const int lt = wave >> 1;
#pragma unroll 1
        for (int q = 0; q < 2; ++q) { const int st = (wave & 1) * 2 + q;
            f32x4 gacc = tile_mma<128>((f32x4){0.f, 0.f, 0.f, 0.f}, Cs + lt * 16 * SD_PC, SD_PC, Bs + st * 16 * SD_PC, SD_PC, lane);
            const int s = 16 * st + fr; const float as = acum[s], ds = dtv[s];
#pragma unroll
            for (int e = 0; e < 4; ++e) { const int ll = 16 * lt + 4 * fq + e; const float v = (s <= ll) ? gacc[e] * __expf(acum[ll] - as) * ds : 0.f; Sc[ll * SD_PX + s] = f2bf_s(v); } }
        LBAR();
#pragma unroll 1
        for (int q = 0; q < 2; ++q) { const int ptl = (wave & 1) * 2 + q;
            f32x4 yi = (f32x4){0.f, 0.f, 0.f, 0.f};
#pragma unroll
            for (int ks = 0; ks < 2; ++ks) yi = __builtin_amdgcn_mfma_f32_16x16x32_bf16(*(const LAS bf16x8*)(Sc + (lt * 16 + fr) * SD_PX + 32 * ks + 8 * fq), tr_frag(xs, SD_PX, 32 * ks, 16 * ptl, lane), yi, 0, 0, 0);
            const f32x4 yo = tile_mma<128>((f32x4){0.f, 0.f, 0.f, 0.f}, Cs + lt * 16 * SD_PC, SD_PC, hb + ptl * 16 * SD_PC, SD_PC, lane);
            const int p = 16 * ptl + fr;
#pragma unroll
            for (int e = 0; e < 4; ++e) { const int ll = 16 * lt + 4 * fq + e;
                if (ll < nv) YC[(size_t)(r0 + ll) * 384 + h * 64 + p] = f2bf_s(yi[e] + __expf(acum[ll]) * yo[e] + Dh * bf2f(xs[ll * SD_PX + p])); } }
        { const float cd = __expf(alast);
#pragma unroll
          for (int q = 0; q < 4; ++q) hs[q] = hs[q] * cd;
#pragma unroll
          for (int ks = 0; ks < 2; ++ks) { const bf16x8 af = tr_frag(xw, SD_PX, 32 * ks, 16 * pt, lane);
#pragma unroll
              for (int q = 0; q < 4; ++q) hs[q] = __builtin_amdgcn_mfma_f32_16x16x32_bf16(af, tr_frag(Bs, SD_PC, 32 * ks, 16 * (nt0 + q), lane), hs[q], 0, 0, 0); } }
        LBAR();
    }
#pragma unroll
    for (int q = 0; q < 4; ++q)
#pragma unroll
        for (int e = 0; e < 4; ++e) hout[(size_t)(16 * pt + 4 * fq + e) * 128 + 16 * (nt0 + q) + fr] = hs[q][e];
}

constexpr int AT_PV = 264, AT_PK = 72;
__device__ __forceinline__ void attn_prompt_unit(const KA a, int l, int su, LAS unsigned char* lds, int tid) {
    const int quarter = su & 3, bhbr = su >> 2, br = bhbr % 3, bh = bhbr / 3, b = bh / 6, h = bh - b * 6;
    const int dil = (br == 0) ? 1 : (br == 1 ? 4 : 16), nblk = 16 / dil;
    const int lane = tid & 63, wave = __builtin_amdgcn_readfirstlane(tid >> 6), fr = lane & 15, fq = lane >> 4;
    const bf16* P = (const bf16*)(a.ws() + WS_P);
    LAS bf16* VT = (LAS bf16*)lds;
    LAS bf16* KL = VT + 64 * AT_PV;
    const size_t rowb = (size_t)b * 2048;
    const int kj_s = tid >> 1, hf = tid & 1, qi = 16 * wave + fr;
    const float slope = exp2f(-8.0f * (float)(h + 1) / 6.0f) * (float)dil;
    bf16* AP = (bf16*)(a.ws() + WS_AP) + (size_t)br * TOK * 384; float* AM = (float*)(a.ws() + WS_AM) + (size_t)br * TOK * 8; float* AL = (float*)(a.ws() + WS_AL) + (size_t)br * TOK * 8;
    v4u pv[4], pk[4]; bf16x8 q0, q1;
#define AT_LOAD(cn_) do { const int cls_ = (cn_) / nblk, n_ = (cn_) - cls_ * nblk; int ks_ = (n_ - 1) * 128 + kj_s; if (ks_ < 0) ks_ = 0; \
        const bf16* src_ = P + (rowb + (size_t)ks_ * dil + cls_) * NPP + h * 64 + hf * 32; \
        _Pragma("unroll") for (int q_ = 0; q_ < 4; ++q_) { pv[q_] = *(const v4u*)(src_ + C_V + q_ * 8); pk[q_] = *(const v4u*)(src_ + C_K + q_ * 8); } \
        const bf16* qp_ = P + (rowb + (size_t)(n_ * 128 + qi) * dil + cls_) * NPP + C_Q + h * 64 + 8 * fq; q0 = *(const bf16x8*)qp_; q1 = *(const bf16x8*)(qp_ + 32); } while (0)
    AT_LOAD(quarter * 4);
#pragma unroll 1
    for (int j = 0; j < 4; ++j) {
        const int cn = quarter * 4 + j, cls = cn / nblk, n = cn - cls * nblk;
#pragma unroll
        for (int q = 0; q < 4; ++q) { *(LAS v4u*)(KL + kj_s * AT_PK + hf * 32 + q * 8) = pk[q]; const unsigned wv[4] = {pv[q].x, pv[q].y, pv[q].z, pv[q].w};
#pragma unroll
            for (int e = 0; e < 4; ++e) { VT[(hf * 32 + q * 8 + 2 * e) * AT_PV + kj_s] = (bf16)(wv[e] & 0xffffu); VT[(hf * 32 + q * 8 + 2 * e + 1) * AT_PV + kj_s] = (bf16)(wv[e] >> 16); } }
        const bf16x8 cq0 = q0, cq1 = q1;
        if (j < 3) AT_LOAD(cn + 1);
        LBAR();
        const int ktlo = (n == 0 && wave < 8) ? (8 > wave ? 8 : wave) : wave, kthi = wave + 8;
        const float sl4[4] = {0.f, slope, 2.f * slope, 3.f * slope};
#define AT_SCORE(acc_, kt_) do { const LAS bf16* kp_ = KL + (16 * (kt_) + fr) * AT_PK + 8 * fq; \
            acc_ = __builtin_amdgcn_mfma_f32_16x16x32_bf16(*(const LAS bf16x8*)kp_, cq0, (f32x4){0.f, 0.f, 0.f, 0.f}, 0, 0, 0); \
            acc_ = __builtin_amdgcn_mfma_f32_16x16x32_bf16(*(const LAS bf16x8*)(kp_ + 32), cq1, acc_, 0, 0, 0); \
            const int d0_ = 128 + qi - 16 * (kt_) - 4 * fq; const float b0_ = -slope * (float)d0_; \
            _Pragma("unroll") for (int e_ = 0; e_ < 4; ++e_) acc_[e_] = acc_[e_] * 0.125f + (b0_ + sl4[e_]); \
            if ((kt_) == wave || (kt_) == wave + 8) { _Pragma("unroll") for (int e_ = 0; e_ < 4; ++e_) { const int dl_ = d0_ - e_; if (dl_ < 0 || dl_ > 128) acc_[e_] = NEG_INF; } } } while (0)
        float m = NEG_INF;
#pragma unroll
        for (int rel = 0; rel < 9; ++rel) { const int kt = wave + rel;
            if (kt >= ktlo) { f32x4 acc; AT_SCORE(acc, kt); m = fmaxf(fmaxf(m, fmaxf(acc[0], acc[1])), fmaxf(acc[2], acc[3])); }
            if (rel & 1) asm volatile("" ::: "memory"); }
        m = pg8::xmax16(m); m = pg8::xmax32(m);
        float lsum = 0.f;
        f32x4 o[4];
#pragma unroll
        for (int dt = 0; dt < 4; ++dt) o[dt] = (f32x4){0.f, 0.f, 0.f, 0.f};
#pragma unroll
        for (int rel = 0; rel < 9; ++rel) { const int kt = wave + rel;
            if (kt >= ktlo) { f32x4 sc; AT_SCORE(sc, kt);
#pragma unroll
                for (int e = 0; e < 4; ++e) { sc[e] = __expf(sc[e] - m); lsum += sc[e]; }
                const v4i16_t pa = pack4(sc);
#pragma unroll
                for (int dt = 0; dt < 4; ++dt) { const v4i16_t vb = *(const LAS v4i16_t*)(VT + (16 * dt + fr) * AT_PV + 16 * kt + 4 * fq);
                    o[dt] = __builtin_amdgcn_mfma_f32_16x16x16bf16_1k(pa, vb, o[dt], 0, 0, 0); } }
            if (rel & 1) asm volatile("" ::: "memory"); }
#undef AT_SCORE
        lsum = pg8::xsum16(lsum); lsum = pg8::xsum32(lsum);
#pragma unroll
        for (int e = 0; e < 4; ++e) { const int qq = 16 * wave + 4 * fq + e; const size_t row = rowb + (size_t)(n * 128 + qq) * dil + cls;
#pragma unroll
            for (int dt = 0; dt < 4; ++dt) AP[row * 384 + h * 64 + 16 * dt + fr] = f2bf_s(o[dt][e]); }
        if (fq == 0) { const size_t row = rowb + (size_t)(n * 128 + qi) * dil + cls; AM[row * 8 + h] = m; AL[row * 8 + h] = lsum; }
        LBAR();
    }
#undef AT_LOAD
}

PHASE_FN __device__ void attn_sample_task(const KA a, int l, int task0, LAS unsigned char* lds, int tid) {
    const int lane = tid & 63, wave = __builtin_amdgcn_readfirstlane(tid >> 6), task = task0 + wave;
    const int t = task & 3, bh = task >> 2, b = bh / 6, h = bh - b * 6;
    const bf16* P = (const bf16*)(a.ws() + WS_P);
    const float* ck = a.in(2) + ((size_t)(l * 32 + b) * 2048) * 384 + h * 64; const float* cv = a.in(3) + ((size_t)(l * 32 + b) * 2048) * 384 + h * 64;
    const int row = TP + b * 4 + t;
    LAS float* pl = (LAS float*)lds + wave * 512;
    LAS float* q = pl + 448;
    q[lane] = bf2f(P[(size_t)row * NPP + C_Q + h * 64 + lane]) * 0.125f;
    asm volatile("s_waitcnt lgkmcnt(0)" ::: "memory");
    const float slope = exp2f(-8.0f * (float)(h + 1) / 6.0f);
    float m = NEG_INF;
#pragma unroll 1
    for (int ps = 0; ps < 7; ++ps) {
        const int e = ps * 64 + lane; float v = NEG_INF;
        if (e < 387) { const int br = e / 129, st = e - br * 129, dil = (br == 0) ? 1 : (br == 1 ? 4 : 16), idx = 2048 + t - dil * st;
            float dot = 0.f;
            if (idx >= 2048) { const bf16* kp = P + (size_t)(TP + b * 4 + (idx - 2048)) * NPP + C_K + h * 64;
#pragma unroll
                for (int i = 0; i < 8; ++i) { const v4u w = *(const v4u*)(kp + i * 8); const f32x4 qa = *(const LAS f32x4*)(q + 8 * i), qb = *(const LAS f32x4*)(q + 8 * i + 4); dot += qa[0] * bflo(w.x) + qa[1] * bfhi(w.x) + qa[2] * bflo(w.y) + qa[3] * bfhi(w.y) + qb[0] * bflo(w.z) + qb[1] * bfhi(w.z) + qb[2] * bflo(w.w) + qb[3] * bfhi(w.w); } }
            else { const float* kp = ck + (size_t)idx * 384;
#pragma unroll
                for (int i = 0; i < 8; ++i) { const f32x4 w = *(const f32x4*)(kp + 4 * i); const f32x4 qa = *(const LAS f32x4*)(q + 4 * i); dot += qa[0] * w[0] + qa[1] * w[1] + qa[2] * w[2] + qa[3] * w[3]; }
#pragma unroll
                for (int i = 8; i < 16; ++i) { const f32x4 w = *(const f32x4*)(kp + 4 * i); const f32x4 qa = *(const LAS f32x4*)(q + 4 * i); dot += qa[0] * w[0] + qa[1] * w[1] + qa[2] * w[2] + qa[3] * w[3]; } }
            v = dot - slope * (float)(dil * st); }
        pl[e] = v; m = fmaxf(m, v);
    }
    m = wave_max(m);
    float ls = 0.f;
#pragma unroll
    for (int ps = 0; ps < 7; ++ps) { const float p = __expf(pl[ps * 64 + lane] - m); ls += p; pl[ps * 64 + lane] = p; }
    ls = wave_sum(ls);
    asm volatile("s_waitcnt lgkmcnt(0)" ::: "memory");
    float acc = 0.f;
    const bf16* pvn = P + (size_t)(TP + b * 4) * NPP + C_V + h * 64 + lane;
#pragma unroll 1
    for (int br = 0; br < 3; ++br) { const int dil = (br == 0) ? 1 : (br == 1 ? 4 : 16); const LAS float* pb = pl + br * 129;
#pragma unroll 1
        for (int s0 = 0; s0 < 128; s0 += 32) { float vv[32];
#pragma unroll
            for (int j = 0; j < 32; ++j) { const int idx = 2048 + t - dil * (s0 + j);
                vv[j] = (idx >= 2048) ? bf2f(pvn[(size_t)(idx - 2048) * NPP]) : cv[(size_t)idx * 384 + lane]; }
#pragma unroll
            for (int j = 0; j < 32; ++j) acc += pb[s0 + j] * vv[j]; }
        { const int idx = 2048 + t - dil * 128; acc += pb[128] * cv[(size_t)idx * 384 + lane]; } }
    bf16* AP = (bf16*)(a.ws() + WS_AP); float* AM = (float*)(a.ws() + WS_AM); float* AL = (float*)(a.ws() + WS_AL);
    AP[(size_t)row * 384 + h * 64 + lane] = f2bf_s(acc); AP[((size_t)TOK + row) * 384 + h * 64 + lane] = 0; AP[((size_t)2 * TOK + row) * 384 + h * 64 + lane] = 0;
    if (lane == 0) { AM[(size_t)row * 8 + h] = m; AL[(size_t)row * 8 + h] = ls; AM[((size_t)TOK + row) * 8 + h] = NEG_INF; AL[((size_t)TOK + row) * 8 + h] = 0.f; AM[((size_t)2 * TOK + row) * 8 + h] = NEG_INF; AL[((size_t)2 * TOK + row) * 8 + h] = 0.f; }
}

PHASE_FN __device__ void post_rwkv(const KA a, int l, int tid) {
    const int lane = tid & 63, gw = blockIdx.x * NWAVES + __builtin_amdgcn_readfirstlane(tid >> 6); int NGW = gridDim.x * NWAVES; asm volatile("" : "+s"(NGW));
    const float* YS = (const float*)(a.ws() + WS_YS); const unsigned char* REC = a.ws() + WS_REC; const float* SC = (const float*)(a.ws() + WS_SC); const float* G = (const float*)(a.ws() + WS_G);
    bf16* YM = (bf16*)(a.ws() + WS_YM);
    float lw[4], lb[4];
#pragma unroll
    for (int hh = 0; hh < 4; ++hh) { lw[hh] = a.in(23)[l * 256 + hh * 64 + lane]; lb[hh] = a.in(24)[l * 256 + hh * 64 + lane]; }
    for (int row0 = gw * 2; row0 < TOK; row0 += 2 * NGW) {
        float v[2][4], ys[2][4], g[2][4], kr[2][4], bon[2][4];
#pragma unroll
        for (int r = 0; r < 2; ++r)
#pragma unroll
            for (int hh = 0; hh < 4; ++hh) { const int row = row0 + r, c = hh * 64 + lane;
                v[r][hh] = bf2f(*(const bf16*)(REC + (size_t)((row >> 4) * 4 + hh) * REC_BYTES + 8192 + ((row & 15) * 64 + lane) * 2)); ys[r][hh] = YS[(size_t)row * 256 + c]; g[r][hh] = G[(size_t)row * 256 + c];
                kr[r][hh] = SC[(size_t)(row * 4 + hh) * 2]; bon[r][hh] = SC[(size_t)(row * 4 + hh) * 2 + 1]; }
#pragma unroll
        for (int r = 0; r < 2; ++r)
#pragma unroll
            for (int hh = 0; hh < 4; ++hh) { const float y = ys[r][hh] + v[r][hh] * kr[r][hh];
                const float mu = wave_sum(y) * (1.f / 64.f), d = y - mu, var = wave_sum(d * d) * (1.f / 64.f);
                const float yn = d * rsqrtf(var + GN_EPS) * lw[hh] + lb[hh];
                YM[(size_t)(row0 + r) * D + hh * 64 + lane] = f2bf_s((yn + bon[r][hh] * v[r][hh]) * g[r][hh]); }
    }
}
PHASE_FN __device__ void post_att(const KA a, int l, int tid) {
    const int lane = tid & 63, gw = blockIdx.x * NWAVES + __builtin_amdgcn_readfirstlane(tid >> 6); int NGW = gridDim.x * NWAVES; asm volatile("" : "+s"(NGW));
    const bf16* AP = (const bf16*)(a.ws() + WS_AP); const float* AM = (const float*)(a.ws() + WS_AM); const float* AL = (const float*)(a.ws() + WS_AL); bf16* YM = (bf16*)(a.ws() + WS_YM);
    float nw[6];
#pragma unroll
    for (int hd = 0; hd < 6; ++hd) nw[hd] = a.in(25)[l * 384 + hd * 64 + lane];
    for (int row0 = gw * 2; row0 < TOK; row0 += 2 * NGW) {
        float ap[2][3][6], am[2][3], al[2][3];
#pragma unroll
        for (int r = 0; r < 2; ++r)
#pragma unroll
            for (int br = 0; br < 3; ++br) { const size_t rb = (size_t)br * TOK + row0 + r;
                am[r][br] = AM[rb * 8 + (lane & 7)]; al[r][br] = AL[rb * 8 + (lane & 7)];
#pragma unroll
                for (int hd = 0; hd < 6; ++hd) ap[r][br][hd] = bf2f(AP[rb * 384 + hd * 64 + lane]); }
#pragma unroll
        for (int r = 0; r < 2; ++r) {
            const float M = fmaxf(am[r][0], fmaxf(am[r][1], am[r][2]));
            const float e0 = __expf(am[r][0] - M), e1 = __expf(am[r][1] - M), e2 = __expf(am[r][2] - M);
            const float inv = 1.0f / (e0 * al[r][0] + e1 * al[r][1] + e2 * al[r][2]);
            float ob[6], ss = 0.f;
#pragma unroll
            for (int hd = 0; hd < 6; ++hd) { const float w0 = __uint_as_float(__builtin_amdgcn_readlane(__float_as_uint(e0 * inv), hd));
                const float w1 = __uint_as_float(__builtin_amdgcn_readlane(__float_as_uint(e1 * inv), hd)), w2 = __uint_as_float(__builtin_amdgcn_readlane(__float_as_uint(e2 * inv), hd));
                ob[hd] = w0 * ap[r][0][hd] + w1 * ap[r][1][hd] + w2 * ap[r][2][hd]; ss += ob[hd] * ob[hd]; }
            ss = wave_sum(ss); const float rs = rsqrtf(ss * (1.f / 384.f) + NORM_EPS);
#pragma unroll
            for (int hd = 0; hd < 6; ++hd) YM[(size_t)(row0 + r) * D + 256 + hd * 64 + lane] = f2bf_s(ob[hd] * rs * nw[hd]);
        }
    }
}
PHASE_FN __device__ void post_ssd(const KA a, int l, int tid) {
    const int lane = tid & 63, gw = blockIdx.x * NWAVES + __builtin_amdgcn_readfirstlane(tid >> 6); int NGW = gridDim.x * NWAVES; asm volatile("" : "+s"(NGW));
    const bf16* YC = (const bf16*)(a.ws() + WS_YC); const bf16* P = (const bf16*)(a.ws() + WS_P); bf16* YM = (bf16*)(a.ws() + WS_YM);
    float nw[6];
#pragma unroll
    for (int hd = 0; hd < 6; ++hd) nw[hd] = a.in(31)[l * 384 + hd * 64 + lane];
    for (int row0 = gw * 2; row0 < TOK; row0 += 2 * NGW) {
        float yc[2][6], z[2][6];
#pragma unroll
        for (int r = 0; r < 2; ++r)
#pragma unroll
            for (int hd = 0; hd < 6; ++hd) { yc[r][hd] = bf2f(YC[(size_t)(row0 + r) * 384 + hd * 64 + lane]); z[r][hd] = bf2f(P[(size_t)(row0 + r) * NPP + C_Z + hd * 64 + lane]); }
#pragma unroll
        for (int r = 0; r < 2; ++r) { float ob[6], ss = 0.f;
#pragma unroll
            for (int hd = 0; hd < 6; ++hd) { ob[hd] = yc[r][hd] * (z[r][hd] * sigmoidf_(z[r][hd])); ss += ob[hd] * ob[hd]; }
            ss = wave_sum(ss); const float rs = rsqrtf(ss * (1.f / 384.f) + NORM_EPS);
#pragma unroll
            for (int hd = 0; hd < 6; ++hd) YM[(size_t)(row0 + r) * D + 640 + hd * 64 + lane] = f2bf_s(ob[hd] * rs * nw[hd]); }
    }
}
PHASE_FN __device__ void final_rows(const KA a, int tid) {
    const int lane = tid & 63, gw = blockIdx.x * NWAVES + __builtin_amdgcn_readfirstlane(tid >> 6); int NGW = gridDim.x * NWAVES; asm volatile("" : "+s"(NGW));
    const float* X = (const float*)(a.ws() + WS_X); const float* SSQ = (const float*)(a.ws() + WS_SSQ);
    for (int row = gw; row < TOK; row += NGW) {
        const float rs = pg8::row_rstd(SSQ, row);
        float* dst = (row < TP) ? a.out() + O_YP + (size_t)row * D : a.out() + O_YS + (size_t)(row - TP) * D;
#pragma unroll
        for (int j = 0; j < 4; ++j) { const f32x4 v = ((const f32x4*)(X + (size_t)row * D))[lane + 64 * j], w = ((const f32x4*)a.in(37))[lane + 64 * j]; ((f32x4*)dst)[lane + 64 * j] = v * rs * w; }
    }
}

constexpr int Q_SCAN = 32, Q_SSD = Q_SCAN + 48, Q_ATS = Q_SSD + 96, Q_ATT = Q_ATS + 576, Q_SCS = Q_ATT + 128, NU_MIX = Q_SCS + 192;
#ifndef REP_MIX
#define REP_MIX 1
#endif
#ifndef REP_PP
#define REP_PP 1
#endif
#ifndef REP_G
#define REP_G 1
#endif
#ifndef DUP_MASK
#define DUP_MASK 0
#endif
#ifndef REP_PRO
#define REP_PRO 1
#endif
#ifndef REP_R
#define REP_R 1
#endif

template <int KSTEPS> PHASE_FN __device__ void skinny_res(const KA a, size_t a_off, size_t b_off, float scale, int write_f32, LAS unsigned char* lds, int tid) {
    constexpr int K = KSTEPS * 32 * 4;
    const int lane = tid & 63, wave = __builtin_amdgcn_readfirstlane(tid >> 6), fr = lane & 15, fq = lane >> 4, ct = wave & 1, kq = wave >> 1;
    const bf16* A = (const bf16*)(a.ws() + a_off); const bf16* Bt = (const bf16*)(a.ws() + b_off);
    float* X = (float*)(a.ws() + WS_X); bf16* XB = (bf16*)(a.ws() + WS_XB); float* SSQ = (float*)(a.ws() + WS_SSQ);
    LAS f32x4* red = (LAS f32x4*)lds;
    for (int piece = blockIdx.x; piece < 256; piece += gridDim.x) {
        const int rt = piece >> 5, cg = piece & 31;
        const bf16* ap = A + (size_t)(TP + rt * 16 + fr) * K + kq * (K / 4) + 8 * fq; const bf16* wp = Bt + (size_t)(cg * 32 + ct * 16 + fr) * K + kq * (K / 4) + 8 * fq;
        f32x4 acc = (f32x4){0.f, 0.f, 0.f, 0.f};
#pragma unroll
        for (int ks = 0; ks < KSTEPS; ++ks) acc = __builtin_amdgcn_mfma_f32_16x16x32_bf16(*(const bf16x8*)(wp + 32 * ks), *(const bf16x8*)(ap + 32 * ks), acc, 0, 0, 0);
        red[wave * 64 + lane] = acc;
        __syncthreads();
        if (kq == 0) {
            acc = (red[ct * 64 + lane] + red[(ct + 2) * 64 + lane]) + (red[(ct + 4) * 64 + lane] + red[(ct + 6) * 64 + lane]);
            const int rl = rt * 16 + fr, row = TP + rl, c0 = cg * 32 + ct * 16 + 4 * fq;
            const f32x4 x = up4(*(const v2u*)(XB + (size_t)row * D + c0)) + acc * scale; if (write_f32) *(f32x4*)(X + (size_t)row * D + c0) = x;
            v2u w; w.x = pg8::cvt_pk_bf16(x[0], x[1]); w.y = pg8::cvt_pk_bf16(x[2], x[3]); *(v2u*)(XB + (size_t)row * D + c0) = w;
            float ss = (x[0] * x[0] + x[1] * x[1]) + (x[2] * x[2] + x[3] * x[3]); ss = pg8::xsum16(ss); ss = pg8::xsum32(ss);
            if (fq == 0) SSQ[pg8::SSQS_OFF + (size_t)rl * 64 + cg * 2 + ct] = ss;
        }
        __syncthreads();
    }
}
#define MIX_PHASE(QREP) \
        for (;;) { \
            { WSL(w); if (fresh_tid() == 0) MISC[0] = __hip_atomic_fetch_add((unsigned*)((gu32*)(w + WS_CTL) + CW_Q + 64 * (l + 4 * (QREP))), 1u, __ATOMIC_RELAXED, __HIP_MEMORY_SCOPE_AGENT); } \
            __syncthreads(); \
            const int u = (int)MISC[0]; \
            __syncthreads(); \
            if (u >= NU_MIX + ((l < DEPTH - 1) ? I_LAYER / 8 : 0)) break; \
            if (u < Q_SCAN) { rwkv_scan_unit(make_ka(), l, u, lds, fresh_tid()); if (DUP_MASK & 1) { __syncthreads(); rwkv_scan_unit(make_ka(), l, u, lds, fresh_tid()); } } \
            else if (u < Q_SSD) { ssd_unit(make_ka(), l, u - Q_SCAN, lds, fresh_tid()); if (DUP_MASK & 2) { __syncthreads(); ssd_unit(make_ka(), l, u - Q_SCAN, lds, fresh_tid()); } } \
            else if (u < Q_ATS) { attn_sample_task(make_ka(), l, (u - Q_SSD) * 8, lds, fresh_tid()); if (DUP_MASK & 4) { __syncthreads(); attn_sample_task(make_ka(), l, (u - Q_SSD) * 8, lds, fresh_tid()); } } \
            else if (u < Q_ATT) { attn_prompt_unit(make_ka(), l, u - Q_ATS, lds, fresh_tid()); if (DUP_MASK & 8) { __syncthreads(); attn_prompt_unit(make_ka(), l, u - Q_ATS, lds, fresh_tid()); } } \
            else if (u < Q_SCS) { rwkv_scan_unit(make_ka(), l, 32 + (u - Q_ATT), lds, fresh_tid()); if (DUP_MASK & 16) { __syncthreads(); rwkv_scan_unit(make_ka(), l, 32 + (u - Q_ATT), lds, fresh_tid()); } } \
            else if (u < NU_MIX) { ssd_unit(make_ka(), l, 48 + (u - Q_SCS), lds, fresh_tid()); if (DUP_MASK & 32) { __syncthreads(); ssd_unit(make_ka(), l, 48 + (u - Q_SCS), lds, fresh_tid()); } } \
            else wconv_unit(make_ka(), l + 1, u - NU_MIX, lds, fresh_tid()); \
        } \
        GRID_BAR();
__global__ void __launch_bounds__(NTHR, 2) hymba_fwd(KArgs args) {
    extern __shared__ __attribute__((aligned(16))) unsigned char lds_raw[];
    LAS unsigned char* lds = (LAS unsigned char*)lds_raw;
    volatile LAS unsigned* MISC = (volatile LAS unsigned*)(lds + MISC_OFF);
    { const int tid = threadIdx.x; for (int u = tid; u < (LDS_BYTES - LDSCTL_OFF) / 4; u += NTHR) ((LAS unsigned*)(lds + LDSCTL_OFF))[u] = 0u; }
    __syncthreads();
    XcdBarrier bar = xcd_barrier_post((unsigned*)((gu32*)(args.ws + WS_CTL) + CW_BAR), MISC + 8);
#define GRID_BAR() do { XcdBarrier b_ = bar; asm volatile("" : "+s"(b_.bar), "+s"(b_.x)); xcd_barrier(b_); } while (0)
#define WSL(name) unsigned char* name = make_ka().ws()
#define GL(name) int name = gridDim.x; asm volatile("" : "+s"(name)); int bx_ = blockIdx.x; asm volatile("" : "+s"(bx_))

#ifndef NO_PRO
    p0_prologue(make_ka(), lds, fresh_tid()); p0_xinit(make_ka(), fresh_tid());
#endif
    GRID_BAR();
#if REP_PRO > 1
    p0_prologue(make_ka(), lds, fresh_tid()); p0_xinit(make_ka(), fresh_tid());
    GRID_BAR();
#endif
    for (int l = 0; l < DEPTH; ++l) {
        { WSL(w); GL(G); pg8::Gemm g{(const bf16*)(w + WS_XB), (const bf16*)(w + WS_W + (size_t)l * WL_SIZE + WL_GU1), MP, 2 * FF, D}; pg8::StaticOrder S; S.init(MP, 2 * FF, G, bx_, WGM_GU); pg8::EpiGU E{(bf16*)(w + WS_H), (const float*)(w + WS_SSQ)};
          pg8::gemm_phase<pg8::EpiGU, pg8::StaticOrder, true, true>(lds, g, S, E); }
        GRID_BAR();
#if REP_G > 1
        { WSL(w); GL(G); pg8::Gemm g{(const bf16*)(w + WS_XB), (const bf16*)(w + WS_W + (size_t)l * WL_SIZE + WL_GU1), MP, 2 * FF, D}; pg8::StaticOrder S; S.init(MP, 2 * FF, G, bx_, WGM_GU); pg8::EpiGU E{(bf16*)(w + WS_H), (const float*)(w + WS_SSQ)};
          pg8::gemm_phase<pg8::EpiGU, pg8::StaticOrder, true, true>(lds, g, S, E); }
        GRID_BAR();
#endif
        skinny_res<22>(make_ka(), WS_H, WS_W + (size_t)l * WL_SIZE + WL_D1, 0.5f, 0, lds, fresh_tid());
        { WSL(w); GL(G); pg8::Gemm g{(const bf16*)(w + WS_H), (const bf16*)(w + WS_W + (size_t)l * WL_SIZE + WL_D1), TP, D, FF}; pg8::StaticOrder S; S.init(TP, D, G, bx_, WGM_R); pg8::EpiRes E{(float*)nullptr, (bf16*)(w + WS_XB), (float*)(w + WS_SSQ), 0.5f};
          pg8::gemm_phase<pg8::EpiRes, pg8::StaticOrder, true, true>(lds, g, S, E); }
        GRID_BAR();
#if REP_R > 1
        skinny_res<22>(make_ka(), WS_H, WS_W + (size_t)l * WL_SIZE + WL_D1, 0.0f, 0, lds, fresh_tid());
        { WSL(w); GL(G); pg8::Gemm g{(const bf16*)(w + WS_H), (const bf16*)(w + WS_W + (size_t)l * WL_SIZE + WL_D1), TP, D, FF}; pg8::StaticOrder S; S.init(TP, D, G, bx_, WGM_R); pg8::EpiRes E{(float*)nullptr, (bf16*)(w + WS_XB), (float*)(w + WS_SSQ), 0.0f};
          pg8::gemm_phase<pg8::EpiRes, pg8::StaticOrder, true, true>(lds, g, S, E); }
        GRID_BAR();
#endif
        { WSL(w); GL(G); pg8::Gemm g{(const bf16*)(w + WS_XB), (const bf16*)(w + WS_W + (size_t)l * WL_SIZE + WL_IN), MP, NPP, D}; pg8::StaticOrder S; S.init(MP, NPP, G, bx_, WGM_IN); pg8::EpiIn E{(bf16*)(w + WS_P), (const float*)(w + WS_SSQ)};
          pg8::gemm_phase<pg8::EpiIn, pg8::StaticOrder, true, true>(lds, g, S, E); }
        GRID_BAR();
#if REP_G > 1
        { WSL(w); GL(G); pg8::Gemm g{(const bf16*)(w + WS_XB), (const bf16*)(w + WS_W + (size_t)l * WL_SIZE + WL_IN), MP, NPP, D}; pg8::StaticOrder S; S.init(MP, NPP, G, bx_, WGM_IN); pg8::EpiIn E{(bf16*)(w + WS_P), (const float*)(w + WS_SSQ)};
          pg8::gemm_phase<pg8::EpiIn, pg8::StaticOrder, true, true>(lds, g, S, E); }
        GRID_BAR();
#endif
#ifndef NO_PREP
        rwkv_prep(make_ka(), l, lds, fresh_tid());
#endif
#ifndef NO_PREPE
        prep_elementwise(make_ka(), l, fresh_tid());
#endif
        GRID_BAR();
#if REP_PP > 1
        rwkv_prep(make_ka(), l, lds, fresh_tid());
        prep_elementwise(make_ka(), l, fresh_tid());
        GRID_BAR();
#endif
        MIX_PHASE(0)
#if REP_MIX > 1
        MIX_PHASE(1)
#endif
#ifndef NO_POST
        post_rwkv(make_ka(), l, fresh_tid()); post_att(make_ka(), l, fresh_tid()); post_ssd(make_ka(), l, fresh_tid());
#endif
        GRID_BAR();
#if REP_PP > 1
        post_rwkv(make_ka(), l, fresh_tid()); post_att(make_ka(), l, fresh_tid()); post_ssd(make_ka(), l, fresh_tid());
        GRID_BAR();
#endif
        skinny_res<8>(make_ka(), WS_YM, WS_W + (size_t)l * WL_SIZE + WL_OUT, 1.0f, 0, lds, fresh_tid());
        { WSL(w); GL(G); pg8::Gemm g{(const bf16*)(w + WS_YM), (const bf16*)(w + WS_W + (size_t)l * WL_SIZE + WL_OUT), TP, D, D}; pg8::StaticOrder S; S.init(TP, D, G, bx_, WGM_R); pg8::EpiRes E{(float*)nullptr, (bf16*)(w + WS_XB), (float*)(w + WS_SSQ), 1.0f};
          pg8::gemm_phase<pg8::EpiRes, pg8::StaticOrder, true, true>(lds, g, S, E); }
        GRID_BAR();
#if REP_R > 1
        skinny_res<8>(make_ka(), WS_YM, WS_W + (size_t)l * WL_SIZE + WL_OUT, 0.0f, 0, lds, fresh_tid());
        { WSL(w); GL(G); pg8::Gemm g{(const bf16*)(w + WS_YM), (const bf16*)(w + WS_W + (size_t)l * WL_SIZE + WL_OUT), TP, D, D}; pg8::StaticOrder S; S.init(TP, D, G, bx_, WGM_R); pg8::EpiRes E{(float*)nullptr, (bf16*)(w + WS_XB), (float*)(w + WS_SSQ), 0.0f};
          pg8::gemm_phase<pg8::EpiRes, pg8::StaticOrder, true, true>(lds, g, S, E); }
        GRID_BAR();
#endif
        { WSL(w); GL(G); pg8::Gemm g{(const bf16*)(w + WS_XB), (const bf16*)(w + WS_W + (size_t)l * WL_SIZE + WL_GU2), MP, 2 * FF, D}; pg8::StaticOrder S; S.init(MP, 2 * FF, G, bx_, WGM_GU); pg8::EpiGU E{(bf16*)(w + WS_H), (const float*)(w + WS_SSQ)};
          pg8::gemm_phase<pg8::EpiGU, pg8::StaticOrder, true, true>(lds, g, S, E); }
        GRID_BAR();
#if REP_G > 1
        { WSL(w); GL(G); pg8::Gemm g{(const bf16*)(w + WS_XB), (const bf16*)(w + WS_W + (size_t)l * WL_SIZE + WL_GU2), MP, 2 * FF, D}; pg8::StaticOrder S; S.init(MP, 2 * FF, G, bx_, WGM_GU); pg8::EpiGU E{(bf16*)(w + WS_H), (const float*)(w + WS_SSQ)};
          pg8::gemm_phase<pg8::EpiGU, pg8::StaticOrder, true, true>(lds, g, S, E); }
        GRID_BAR();
#endif
        skinny_res<22>(make_ka(), WS_H, WS_W + (size_t)l * WL_SIZE + WL_D2, 0.5f, (l == DEPTH - 1) ? 1 : 0, lds, fresh_tid());
        { WSL(w); GL(G); pg8::Gemm g{(const bf16*)(w + WS_H), (const bf16*)(w + WS_W + (size_t)l * WL_SIZE + WL_D2), TP, D, FF}; pg8::StaticOrder S; S.init(TP, D, G, bx_, WGM_R); pg8::EpiRes E{((l == DEPTH - 1) ? (float*)(w + WS_X) : (float*)nullptr), (bf16*)(w + WS_XB), (float*)(w + WS_SSQ), 0.5f};
          pg8::gemm_phase<pg8::EpiRes, pg8::StaticOrder, true, true>(lds, g, S, E); }
        GRID_BAR();
#if REP_R > 1
        skinny_res<22>(make_ka(), WS_H, WS_W + (size_t)l * WL_SIZE + WL_D2, 0.0f, (l == DEPTH - 1) ? 1 : 0, lds, fresh_tid());
        { WSL(w); GL(G); pg8::Gemm g{(const bf16*)(w + WS_H), (const bf16*)(w + WS_W + (size_t)l * WL_SIZE + WL_D2), TP, D, FF}; pg8::StaticOrder S; S.init(TP, D, G, bx_, WGM_R); pg8::EpiRes E{((l == DEPTH - 1) ? (float*)(w + WS_X) : (float*)nullptr), (bf16*)(w + WS_XB), (float*)(w + WS_SSQ), 0.0f};
          pg8::gemm_phase<pg8::EpiRes, pg8::StaticOrder, true, true>(lds, g, S, E); }
        GRID_BAR();
#endif
    }
    final_rows(make_ka(), fresh_tid());
}

extern "C" void kernel_launch(void* const* d_in, const int* in_sizes, int n_in, void* d_out, int out_size, void* d_ws, size_t ws_size, hipStream_t stream) {
    static int grid = 0;
    if (grid == 0) {
        if (n_in != 38 || (size_t)out_size != O_END || ws_size < WS_END) { fprintf(stderr, "kernel_launch: unexpected shapes: n_in %d out %d ws %zu\n", n_in, out_size, ws_size); grid = -1; return; }
        int dev = 0, cus = 0, per_cu = 0;
        if (hipGetDevice(&dev) != hipSuccess || hipDeviceGetAttribute(&cus, hipDeviceAttributeMultiprocessorCount, dev) != hipSuccess) { grid = -1; return; }
        if (hipFuncSetAttribute((const void*)hymba_fwd, hipFuncAttributeMaxDynamicSharedMemorySize, LDS_BYTES) != hipSuccess) { fprintf(stderr, "kernel_launch: hipFuncSetAttribute failed\n"); grid = -1; return; }
        if (hipOccupancyMaxActiveBlocksPerMultiprocessor(&per_cu, (const void*)hymba_fwd, NTHR, LDS_BYTES) != hipSuccess || per_cu < 1) { fprintf(stderr, "kernel_launch: occupancy query says %d\n", per_cu); }
        (void)hipGetLastError();
        grid = cus;
    }
    if (grid < 0) return;
    if (hipMemsetAsync((char*)d_ws + WS_CTL, 0, CTL_ZERO_BYTES, stream) != hipSuccess) return;
    KArgs a{};
    for (int i = 0; i < 38; ++i) a.in[i] = (const float*)d_in[i];
    a.out = (float*)d_out; a.ws = (unsigned char*)d_ws;
    hipLaunchKernelGGL(hymba_fwd, dim3(grid), dim3(NTHR), LDS_BYTES, stream, a);
}
```

```cpp
#include <hip/hip_runtime.h>
#include <cstdio>
#include <cstdint>
namespace pg8 {
#define PG8_LAS __attribute__((address_space(3)))
typedef unsigned short bf16_t;
typedef short bf16x8 __attribute__((ext_vector_type(8)));
typedef float f32x4 __attribute__((ext_vector_type(4)));
typedef unsigned u32x4 __attribute__((ext_vector_type(4)));
constexpr int BM = 256, BK = 64, HALF = 128, HTB = HALF * BK * 2  , STAGE_BYTES = 8 * HTB, NXCD = 8, WGM = 4;

__host__ __device__ __forceinline__ int lds_byte(int r, int c) { const int st = (r >> 4) * 2 + (c >> 5), rr = r & 15, cc = c & 31, ob = rr * 64 + cc * 2; return st * 1024 + (ob ^ (((ob >> 9) & 1) << 5)); }
__host__ __device__ __forceinline__ void stage_rc(int b, int& R, int& C) { const int st = b / 1024, sb = b % 1024, swz = sb ^ (((sb >> 9) & 1) << 5); R = (st >> 1) * 16 + swz / 64; C = (st & 1) * 32 + (swz % 64) / 2; }
__host__ __device__ __forceinline__ int perm32(int rho) { const int n = rho >> 4, i = rho & 15; return 8 * (i >> 2) + 4 * n + (i & 3); }

struct Unit { int pm, pn; };
struct Gemm { const bf16_t* A; const bf16_t* Bt; int M, N, K; };

struct StaticOrder {
    int nM, nN, nwg, G, c, wgm;
    __host__ __device__ void init(int M, int N, int G_, int c_, int wgm_ = WGM) { nM = M / BM; nN = N / BM; nwg = nM * nN; G = G_; c = c_; wgm = wgm_; }
    __host__ __device__ bool next(int i, Unit& u) const {
        const long L = (long)i * G + c; if (L >= nwg) return false;
        int wgid = (int)L; { const int q = nwg / NXCD, r = nwg % NXCD, xcd = wgid % NXCD, off = wgid / NXCD; wgid = (xcd < r ? xcd * (q + 1) : r * (q + 1) + (xcd - r) * q) + off; }
        const int nig = wgm * nN, gid = wgid / nig, fm = gid * wgm, gsz = (nM - fm) < wgm ? (nM - fm) : wgm;
        u.pm = fm + ((wgid % nig) % gsz); u.pn = (wgid % nig) / gsz; return true;
    }
    __device__ __forceinline__ void a_ready(const Unit&) const {}
    __device__ __forceinline__ void done(const Unit&) const {}
};

typedef __bf16 bf2c_t __attribute__((ext_vector_type(2))); typedef float f2c_t __attribute__((ext_vector_type(2)));
__device__ __forceinline__ unsigned cvt_pk_bf16(float lo, float hi) { const f2c_t v = {lo, hi}; return __builtin_bit_cast(unsigned, __builtin_convertvector(v, bf2c_t)); }
typedef float f32x2 __attribute__((ext_vector_type(2)));

typedef unsigned u32x2 __attribute__((ext_vector_type(2)));
__device__ __forceinline__ float xsum16(float v) { const auto r = __builtin_amdgcn_permlane16_swap(__float_as_uint(v), __float_as_uint(v), false, false); return __uint_as_float(r[0]) + __uint_as_float(r[1]); }
__device__ __forceinline__ float xsum32(float v) { const auto r = __builtin_amdgcn_permlane32_swap(__float_as_uint(v), __float_as_uint(v), false, false); return __uint_as_float(r[0]) + __uint_as_float(r[1]); }
__device__ __forceinline__ float xmax16(float v) { const auto r = __builtin_amdgcn_permlane16_swap(__float_as_uint(v), __float_as_uint(v), false, false); return fmaxf(__uint_as_float(r[0]), __uint_as_float(r[1])); }
__device__ __forceinline__ float xmax32(float v) { const auto r = __builtin_amdgcn_permlane32_swap(__float_as_uint(v), __float_as_uint(v), false, false); return fmaxf(__uint_as_float(r[0]), __uint_as_float(r[1])); }
constexpr int E_FF = 2816, E_NPP = 3584, E_D = 1024;
constexpr int SSQS_OFF = 524288;
__device__ __forceinline__ float row_rstd(const float* ssq, int row) {
    float t;
    if (row < 16384) { const f32x4* sp = (const f32x4*)(ssq + (size_t)row * 16); const f32x4 s = (sp[0] + sp[1]) + (sp[2] + sp[3]); t = (s[0] + s[1]) + (s[2] + s[3]); }
    else { const f32x4* sp = (const f32x4*)(ssq + SSQS_OFF + (size_t)(row - 16384) * 64); f32x4 s = sp[0];
#pragma unroll
        for (int i = 1; i < 16; ++i) s += sp[i];
        t = (s[0] + s[1]) + (s[2] + s[3]); }
    return __builtin_amdgcn_rsqf(t * (1.0f / 1024.0f) + 1e-6f);
}
__device__ __forceinline__ float silu_f(float g) { return g * __builtin_amdgcn_rcpf(1.0f + __builtin_amdgcn_exp2f(-1.4426950408889634f * g)); }
__device__ __forceinline__ float row_rstd_coop(const float* ssq, int row, int fq) {
    float t;
    if (row < 16384) { const f32x4 s = ((const f32x4*)(ssq + (size_t)row * 16))[fq]; t = (s[0] + s[1]) + (s[2] + s[3]); }
    else { const f32x4* sp = (const f32x4*)(ssq + SSQS_OFF + (size_t)(row - 16384) * 64) + 4 * fq; const f32x4 s = (sp[0] + sp[1]) + (sp[2] + sp[3]); t = (s[0] + s[1]) + (s[2] + s[3]); }
    t = xsum16(t); t = xsum32(t);
    return __builtin_amdgcn_rsqf(t * (1.0f / 1024.0f) + 1e-6f);
}
struct EpiGU {
    static constexpr bool PERM = true, AFTER_DRAIN = false;
    bf16_t* H; const float* ssq;
    __device__ __forceinline__ void operator()(const f32x4 (&acc)[2][2][4][2], const Unit& u, int wr, int wc, int fr, int fq) const {
        const int row0 = u.pm * BM + wr * 64 + fr, hc0 = u.pn * 128 + wc * 16 + 4 * fq;
#pragma unroll
        for (int ai = 0; ai < 2; ++ai)
#pragma unroll
            for (int m = 0; m < 4; ++m) { const int row = row0 + ai * HALF + m * 16; const float rs = row_rstd_coop(ssq, row, fq);
#pragma unroll
                for (int bj = 0; bj < 2; ++bj) { const f32x4 g = acc[ai][bj][m][0] * rs, up = acc[ai][bj][m][1] * rs;
                    u32x2 w; w.x = cvt_pk_bf16(silu_f(g[0]) * up[0], silu_f(g[1]) * up[1]); w.y = cvt_pk_bf16(silu_f(g[2]) * up[2], silu_f(g[3]) * up[3]);
                    *(u32x2*)(H + (size_t)row * E_FF + hc0 + bj * 64) = w; } asm volatile("" ::: "memory"); }
    }
};
struct EpiIn {
    static constexpr bool PERM = true, AFTER_DRAIN = false;
    bf16_t* P; const float* ssq;
    __device__ __forceinline__ void operator()(const f32x4 (&acc)[2][2][4][2], const Unit& u, int wr, int wc, int fr, int fq) const {
        const int row0 = u.pm * BM + wr * 64 + fr, col0 = u.pn * BM + wc * 32 + 8 * fq;
#pragma unroll
        for (int ai = 0; ai < 2; ++ai)
#pragma unroll
            for (int m = 0; m < 4; ++m) { const int row = row0 + ai * HALF + m * 16; const float rs = row_rstd_coop(ssq, row, fq);
#pragma unroll
                for (int bj = 0; bj < 2; ++bj) { const f32x4 v0 = acc[ai][bj][m][0] * rs, v1 = acc[ai][bj][m][1] * rs;
                    u32x4 w; w.x = cvt_pk_bf16(v0[0], v0[1]); w.y = cvt_pk_bf16(v0[2], v0[3]); w.z = cvt_pk_bf16(v1[0], v1[1]); w.w = cvt_pk_bf16(v1[2], v1[3]);
                    *(u32x4*)(P + (size_t)row * E_NPP + col0 + bj * HALF) = w; } asm volatile("" ::: "memory"); }
    }
};
struct EpiRes {
    static constexpr bool PERM = true, AFTER_DRAIN = false;
    float* Xf; bf16_t* XB; float* ssq; float scale;
    __device__ __forceinline__ void operator()(const f32x4 (&acc)[2][2][4][2], const Unit& u, int wr, int wc, int fr, int fq) const {
        const int row0 = u.pm * BM + wr * 64 + fr, col0 = u.pn * BM + wc * 32 + 8 * fq;
#pragma unroll
        for (int ai = 0; ai < 2; ++ai)
#pragma unroll
            for (int m = 0; m < 4; ++m) { const int row = row0 + ai * HALF + m * 16; float ss = 0.f;
#pragma unroll
                for (int bj = 0; bj < 2; ++bj) { bf16_t* xp = XB + (size_t)row * E_D + col0 + bj * HALF; const u32x4 o = *(const u32x4*)xp;
                    f32x4 x0, x1;
                    x0[0] = __uint_as_float(o.x << 16); x0[1] = __uint_as_float(o.x & 0xffff0000u); x0[2] = __uint_as_float(o.y << 16); x0[3] = __uint_as_float(o.y & 0xffff0000u);
                    x1[0] = __uint_as_float(o.z << 16); x1[1] = __uint_as_float(o.z & 0xffff0000u); x1[2] = __uint_as_float(o.w << 16); x1[3] = __uint_as_float(o.w & 0xffff0000u);
                    x0 += acc[ai][bj][m][0] * scale; x1 += acc[ai][bj][m][1] * scale;
                    if (Xf) { float* fp = Xf + (size_t)row * E_D + col0 + bj * HALF; *(f32x4*)fp = x0; *(f32x4*)(fp + 4) = x1; }
                    ss += (x0[0] * x0[0] + x0[1] * x0[1]) + (x0[2] * x0[2] + x0[3] * x0[3]) + (x1[0] * x1[0] + x1[1] * x1[1]) + (x1[2] * x1[2] + x1[3] * x1[3]);
                    u32x4 w; w.x = cvt_pk_bf16(x0[0], x0[1]); w.y = cvt_pk_bf16(x0[2], x0[3]); w.z = cvt_pk_bf16(x1[0], x1[1]); w.w = cvt_pk_bf16(x1[2], x1[3]);
                    *(u32x4*)xp = w; }
                ss = xsum16(ss); ss = xsum32(ss);
                if (fq == 0) ssq[(size_t)row * 16 + u.pn * 4 + wc] = ss; if (m & 1) asm volatile("" ::: "memory"); }
    }
};
template <class Epi, class Sched, bool ALIGN_EPI = false, bool SP2 = false>
__device__ __forceinline__ void gemm_phase(PG8_LAS unsigned char* lds, const Gemm g, const Sched& S, const Epi& E) {
    int tid = threadIdx.x; asm volatile("" : "+v"(tid)); const int wid = __builtin_amdgcn_readfirstlane(tid >> 6), lane = tid & 63, wr = wid >> 2, wc = wid & 3, fr = lane & 15, fq = lane >> 4;
    const int K = g.K, nt = K / BK;
    unsigned voffA[2], voffB[2];
#pragma unroll
    for (int i = 0; i < 2; ++i) { int R, C; stage_rc(tid * 16 + i * 8192, R, C); const int Rb = Epi::PERM ? ((R & ~31) + perm32(R & 31)) : R;
        voffA[i] = (unsigned)(R * K + C) * 2u; voffB[i] = (unsigned)(Rb * K + C) * 2u; }
    const size_t kstep = (size_t)(BK * 2);
    const size_t hstep = (size_t)HALF * K * 2;
    const size_t tstep = 2 * hstep;
    const unsigned ldsw = (unsigned)wid * 1024u;
    const int aoff = lds_byte(wr * 64 + fr, fq * 8), boff = lds_byte(wc * 32 + fr, fq * 8);
#define PG8_SA(b, h) (((b) * 2 + (h)) * HTB)
#define PG8_SB(b, h) ((4 + (b) * 2 + (h)) * HTB)
#define PG8_STAGE(bufoff, gbase, voff) do { _Pragma("unroll") for (int _i = 0; _i < 2; ++_i) \
        __builtin_amdgcn_global_load_lds((const unsigned*)((const char*)(gbase) + (voff)[_i]), (PG8_LAS unsigned*)(lds + (bufoff) + ldsw + _i * 8192), 16, 0, 0); } while (0)
#define PG8_LDA(dst, b, h) do { _Pragma("unroll") for (int m = 0; m < 4; ++m) _Pragma("unroll") for (int k = 0; k < 2; ++k) dst[m][k] = *(const PG8_LAS bf16x8*)(lds + PG8_SA(b, h) + aoff + m * 2048 + k * 1024); } while (0)
#define PG8_LDB(dst, b, h) do { _Pragma("unroll") for (int n = 0; n < 2; ++n) _Pragma("unroll") for (int k = 0; k < 2; ++k) dst[n][k] = *(const PG8_LAS bf16x8*)(lds + PG8_SB(b, h) + boff + n * 2048 + k * 1024); } while (0)
#define PG8_MMA(ai, bj, At, Bt) do { __builtin_amdgcn_s_setprio(1); _Pragma("unroll") for (int m = 0; m < 4; ++m) _Pragma("unroll") for (int n = 0; n < 2; ++n) _Pragma("unroll") for (int k = 0; k < 2; ++k) \
        acc[ai][bj][m][n] = __builtin_amdgcn_mfma_f32_16x16x32_bf16(Bt[n][k], At[m][k], acc[ai][bj][m][n], 0, 0, 0); __builtin_amdgcn_s_setprio(0); } while (0)
#define PG8_WAIT_V(n) asm volatile("s_waitcnt vmcnt(" #n ")" ::: "memory")
#define PG8_WAIT_L(n) asm volatile("s_waitcnt lgkmcnt(" #n ")" ::: "memory")
#define PG8_BAR __builtin_amdgcn_s_barrier()
#define PG8_SCHED __builtin_amdgcn_sched_barrier(0)
    Unit cur, nxt; int ui = 0;
    if (!S.next(0, cur)) return;
    f32x4 acc[2][2][4][2];
#pragma unroll
    for (int a = 0; a < 2; ++a)
#pragma unroll
        for (int b = 0; b < 2; ++b)
#pragma unroll
            for (int m = 0; m < 4; ++m)
#pragma unroll
                for (int n = 0; n < 2; ++n) acc[a][b][m][n] = (f32x4){0.f, 0.f, 0.f, 0.f};
    bf16x8 At[4][2], B0[2][2], B1[2][2];
    const char* cA = (const char*)g.A + (size_t)cur.pm * tstep; const char* cB = (const char*)g.Bt + (size_t)cur.pn * tstep;
    S.a_ready(cur);
    if constexpr (SP2) {
        PG8_STAGE(PG8_SB(0, 0), cB, voffB); PG8_STAGE(PG8_SB(0, 1), cB + hstep, voffB); PG8_STAGE(PG8_SA(0, 0), cA, voffA); PG8_STAGE(PG8_SA(0, 1), cA + hstep, voffA);
        if (wr == 1) PG8_BAR;
        PG8_WAIT_V(2); PG8_BAR;
        PG8_STAGE(PG8_SB(1, 0), cB + kstep, voffB); PG8_STAGE(PG8_SA(1, 0), cA + kstep, voffA); PG8_STAGE(PG8_SB(1, 1), cB + hstep + kstep, voffB);
        PG8_WAIT_V(6); PG8_BAR;
    } else {
        PG8_STAGE(PG8_SB(0, 0), cB, voffB); PG8_STAGE(PG8_SA(0, 0), cA, voffA); PG8_STAGE(PG8_SB(0, 1), cB + hstep, voffB); PG8_STAGE(PG8_SA(0, 1), cA + hstep, voffA);
        if (wr == 1) PG8_BAR;
        PG8_WAIT_V(4); PG8_BAR;
        PG8_STAGE(PG8_SB(1, 0), cB + kstep, voffB); PG8_STAGE(PG8_SA(1, 0), cA + kstep, voffA); PG8_STAGE(PG8_SB(1, 1), cB + hstep + kstep, voffB);
        PG8_WAIT_V(6); PG8_BAR;
    }
    for (;;) {
        const bool has_next = S.next(ui + 1, nxt);
        const char* nA = has_next ? (const char*)g.A + (size_t)nxt.pm * tstep : cA; const char* nB = has_next ? (const char*)g.Bt + (size_t)nxt.pn * tstep : cB;
        for (int t = 0; t < nt; t += 2) {
            const bool last = (t == nt - 2);
            const char* a1 = cA + (size_t)(t + 1) * kstep;
            const char* a2 = last ? nA : cA + (size_t)(t + 2) * kstep; const char* b2 = last ? nB : cB + (size_t)(t + 2) * kstep;
            const char* a3 = a2 + kstep; const char* b3 = b2 + kstep;
            if (last && has_next) S.a_ready(nxt);
            if constexpr (SP2) {
            PG8_LDB(B0, 0, 0); PG8_LDB(B1, 0, 1); PG8_SCHED; PG8_LDA(At, 0, 0); PG8_STAGE(PG8_SA(1, 1), a1 + hstep, voffA);
            PG8_WAIT_V(8); PG8_WAIT_L(0); PG8_BAR; PG8_MMA(0, 0, At, B0); PG8_MMA(0, 1, At, B1); PG8_BAR; PG8_SCHED;
            PG8_LDA(At, 0, 1); PG8_STAGE(PG8_SB(0, 0), b2, voffB); PG8_STAGE(PG8_SB(0, 1), b2 + hstep, voffB); PG8_STAGE(PG8_SA(0, 0), a2, voffA);
            PG8_WAIT_V(8); PG8_WAIT_L(0); PG8_BAR; PG8_MMA(1, 0, At, B0); PG8_MMA(1, 1, At, B1); PG8_BAR; PG8_SCHED;
            PG8_LDB(B0, 1, 0); PG8_LDB(B1, 1, 1); PG8_SCHED; PG8_LDA(At, 1, 0); PG8_STAGE(PG8_SA(0, 1), a2 + hstep, voffA);
            PG8_WAIT_V(8); PG8_WAIT_L(0); PG8_BAR; PG8_MMA(0, 0, At, B0); PG8_MMA(0, 1, At, B1); PG8_BAR; PG8_SCHED;
            PG8_LDA(At, 1, 1); PG8_STAGE(PG8_SB(1, 0), b3, voffB); PG8_STAGE(PG8_SB(1, 1), b3 + hstep, voffB); PG8_STAGE(PG8_SA(1, 0), a3, voffA);
            PG8_WAIT_V(8); PG8_WAIT_L(0); PG8_BAR; PG8_MMA(1, 0, At, B0); PG8_MMA(1, 1, At, B1); PG8_BAR; PG8_SCHED;
            } else {
            PG8_LDB(B0, 0, 0); PG8_SCHED; PG8_LDA(At, 0, 0); PG8_STAGE(PG8_SA(1, 1), a1 + hstep, voffA);
            PG8_WAIT_L(8); PG8_BAR; PG8_WAIT_L(0); PG8_MMA(0, 0, At, B0); PG8_BAR; PG8_SCHED;
            PG8_LDB(B1, 0, 1); PG8_STAGE(PG8_SB(0, 0), b2, voffB);
            PG8_BAR; PG8_WAIT_L(0); PG8_MMA(0, 1, At, B1); PG8_BAR;
            PG8_LDA(At, 0, 1); PG8_STAGE(PG8_SA(0, 0), a2, voffA);
            PG8_BAR; PG8_WAIT_L(0); PG8_MMA(1, 0, At, B0); PG8_BAR; PG8_SCHED;
            PG8_STAGE(PG8_SB(0, 1), b2 + hstep, voffB);
            PG8_WAIT_V(6); PG8_BAR; PG8_MMA(1, 1, At, B1); PG8_BAR;
            PG8_LDB(B0, 1, 0); PG8_SCHED; PG8_LDA(At, 1, 0); PG8_STAGE(PG8_SA(0, 1), a2 + hstep, voffA);
            PG8_WAIT_L(8); PG8_BAR; PG8_WAIT_L(0); PG8_MMA(0, 0, At, B0); PG8_BAR; PG8_SCHED;
            PG8_LDB(B1, 1, 1); PG8_STAGE(PG8_SB(1, 0), b3, voffB);
            PG8_BAR; PG8_WAIT_L(0); PG8_MMA(0, 1, At, B1); PG8_BAR;
            PG8_LDA(At, 1, 1); PG8_STAGE(PG8_SA(1, 0), a3, voffA);
            PG8_BAR; PG8_WAIT_L(0); PG8_MMA(1, 0, At, B0); PG8_BAR; PG8_SCHED;
            PG8_STAGE(PG8_SB(1, 1), b3 + hstep, voffB);
            PG8_WAIT_V(6); PG8_BAR; PG8_MMA(1, 1, At, B1); PG8_BAR;
            }
        }
        if constexpr (ALIGN_EPI) { if (wr == 0) PG8_BAR; }
        if constexpr (!Epi::AFTER_DRAIN) { E(acc, cur, wr, wc, fr, fq); S.done(cur); }
        if (!has_next) break;
#pragma unroll
        for (int a = 0; a < 2; ++a)
#pragma unroll
            for (int b = 0; b < 2; ++b)
#pragma unroll
                for (int m = 0; m < 4; ++m)
#pragma unroll
                    for (int n = 0; n < 2; ++n) acc[a][b][m][n] = (f32x4){0.f, 0.f, 0.f, 0.f};
        cur = nxt; cA = nA; cB = nB; ++ui;
        if constexpr (ALIGN_EPI) { if (wr == 1) PG8_BAR; }
    }
    PG8_WAIT_V(0);
    if constexpr (!ALIGN_EPI) { if (wr == 0) PG8_BAR; }
    PG8_BAR;
    if constexpr (Epi::AFTER_DRAIN) { E.fused(acc, cur, wr, wc, fr, fq, lds, wid, lane); S.done(cur); }
#undef PG8_SA
#undef PG8_SB
#undef PG8_STAGE
#undef PG8_LDA
#undef PG8_LDB
#undef PG8_MMA
#undef PG8_WAIT_V
#undef PG8_WAIT_L
#undef PG8_BAR
#undef PG8_SCHED
}
}
#define GAS __attribute__((address_space(1)))
#define LAS __attribute__((address_space(3)))
typedef unsigned short bf16;
typedef unsigned v4u __attribute__((ext_vector_type(4)));
typedef float f32x4 __attribute__((ext_vector_type(4)));
typedef short bf16x8 __attribute__((ext_vector_type(8)));
typedef GAS unsigned gu32;
typedef GAS unsigned long long gu64;
#define RLX_AGENT __ATOMIC_RELAXED, __HIP_MEMORY_SCOPE_AGENT
#define LDS_WAIT() asm volatile("s_waitcnt lgkmcnt(0)" ::: "memory")
#define VM_WAIT() asm volatile("s_waitcnt vmcnt(0)" ::: "memory")
__device__ __forceinline__ unsigned long long rt() { return __builtin_amdgcn_s_memrealtime(); }
__device__ __forceinline__ unsigned f2bf(float f) { unsigned u = __builtin_bit_cast(unsigned, f); return (u + 0x7fffu + ((u >> 16) & 1u)) >> 16; }
__device__ __forceinline__ unsigned pk2(float lo, float hi) { return f2bf(lo) | (f2bf(hi) << 16); }

#define XB_TMO      128
#define XB_XCNT(j)  (256  + 64 * (j))
#define XB_XSUB(j)  (1280 + 64 * (j))
#define XB_XGEN(j)  (2304 + 64 * (j))
#define XB_TOP      3328
#define XB_TOPGEN   3392
#define XCD_BAR_WORDS 3456
#define XB_SPIN_CAP (1u << 18)

__device__ __forceinline__ unsigned xb_ld(unsigned* p)              { return __hip_atomic_load(p, __ATOMIC_RELAXED, __HIP_MEMORY_SCOPE_AGENT); }
__device__ __forceinline__ unsigned xb_add(unsigned* p, unsigned v) { return __hip_atomic_fetch_add(p, v, __ATOMIC_RELAXED, __HIP_MEMORY_SCOPE_AGENT); }
__device__ __forceinline__ unsigned xb_xcc_id() { return (unsigned)__builtin_amdgcn_s_getreg((3 << 11) | 20) & 0xFu; }
#define XB_SPIN(cond, bar) do { unsigned _sp = 0; while (cond) { __builtin_amdgcn_s_sleep(1); \
    if ((++_sp & 255u) == 0u) { if (xb_ld(&(bar)[XB_TMO])) break; if (_sp > XB_SPIN_CAP) { atomicAdd(&(bar)[XB_TMO], 1u); break; } } } } while (0)

struct XcdBarrier {
    unsigned* bar; unsigned x;
    volatile LAS unsigned* st;
};

__device__ __forceinline__ XcdBarrier xcd_barrier_post(unsigned* bar, volatile LAS unsigned* st) {
    XcdBarrier b; b.bar = bar; b.x = xb_xcc_id(); b.st = st;
    if (threadIdx.x == 0) (void)xb_add(&bar[XB_XCNT(b.x)], 1u);
    return b;
}
__device__ __forceinline__ void xcd_barrier_complete(unsigned* bar, unsigned x, unsigned& nloc, unsigned& nx) {
    const unsigned G = gridDim.x * gridDim.y * gridDim.z;
    unsigned sum, cnt, mine, sp = 0u;
    for (;;) {
        sum = 0u; cnt = 0u; mine = 0u;
#pragma unroll
        for (unsigned j = 0; j < 16; ++j) { const unsigned c = xb_ld(&bar[XB_XCNT(j)]); sum += c; cnt += (c > 0u) ? 1u : 0u; mine = (j == x) ? c : mine; }
        if (sum == G) break;
        __builtin_amdgcn_s_sleep(1);
        if ((++sp & 255u) == 0u) { if (xb_ld(&bar[XB_TMO])) break; if (sp > XB_SPIN_CAP) { atomicAdd(&bar[XB_TMO], 1u); break; } }
    }
    nloc = mine > 0u ? mine : 1u; nx = cnt > 0u ? cnt : 1u;
}

__device__ __forceinline__ void xcd_barrier(const XcdBarrier& b) {
    asm volatile("s_waitcnt vmcnt(0)" ::: "memory");
    __syncthreads();
    int tid0_ = threadIdx.x; asm volatile("" : "+v"(tid0_));
    if (tid0_ == 0) {
        unsigned* bar = b.bar;
        __builtin_amdgcn_s_waitcnt(0);
        unsigned nloc = b.st[0], nx = b.st[1];
        if (nloc == 0u) { xcd_barrier_complete(bar, b.x, nloc, nx); b.st[0] = nloc; b.st[1] = nx; }
        const unsigned old = xb_add(&bar[XB_XSUB(b.x)], 1u);
        const unsigned gen = old / nloc;
        if (old + 1u == (gen + 1u) * nloc) {
            __builtin_amdgcn_fence(__ATOMIC_RELEASE, "agent");
            asm volatile("s_waitcnt vmcnt(0)" ::: "memory");
            const unsigned og = xb_add(&bar[XB_TOP], 1u);
            const unsigned tg = og / nx;
            if (og + 1u == (tg + 1u) * nx) xb_add(&bar[XB_TOPGEN], 1u);
            else XB_SPIN(xb_ld(&bar[XB_TOPGEN]) == tg, bar);
            __builtin_amdgcn_fence(__ATOMIC_ACQUIRE, "agent");
            xb_add(&bar[XB_XGEN(b.x)], 1u);
            asm volatile("s_waitcnt vmcnt(0)" ::: "memory");
        } else {
            XB_SPIN(xb_ld(&bar[XB_XGEN(b.x)]) == gen, bar);
            __builtin_amdgcn_fence(__ATOMIC_ACQUIRE, "agent");
            asm volatile("s_waitcnt vmcnt(0)" ::: "memory");
        }
    }
    __syncthreads();
}

constexpr int NWAVES = 8, NTHR = 512;
#ifndef WGM_GU
#define WGM_GU 4
#endif
#ifndef WGM_IN
#define WGM_IN 4
#endif
#ifndef WGM_R
#define WGM_R 8
#endif
constexpr int D = 1024, FF = 2816, NPJ = 3462, NPP = 3584;
constexpr int TP = 16384, TS = 128, TOK = TP + TS, MP = 16640;
constexpr int DEPTH = 4;
constexpr int C_Q = 1024, C_K = 1408, C_V = 1792, C_Z = 2176, C_XBC = 2560, C_DT = 3456;
constexpr float NORM_EPS = 1e-6f, GN_EPS = 64e-5f, NEG_INF = -1e30f;
constexpr size_t O_YP = 0, O_YS = 16777216, O_PK = 16908288, O_PV = 42074112, O_PSH = 67239936, O_PR = 67272704, O_PC = 67796992, O_PS = 67883008,
                 O_SK = 69455872, O_SV = 69652480, O_SSH = 69849088, O_SR = 69980160, O_SC = 72077312, O_SS = 72421376, O_END = 78712832;
constexpr size_t MiB = 1u << 20;
constexpr size_t WS_CTL = 0, CTL_ZERO_BYTES = 1 * MiB;
constexpr size_t SZ_WGU = (size_t)2 * FF * D * 2, SZ_WD = (size_t)D * FF * 2, SZ_WIN = (size_t)NPP * D * 2, SZ_WOUT = (size_t)D * D * 2;
constexpr size_t WL_GU1 = 0, WL_D1 = WL_GU1 + SZ_WGU, WL_IN = WL_D1 + SZ_WD, WL_OUT = WL_IN + SZ_WIN, WL_GU2 = WL_OUT + SZ_WOUT, WL_D2 = WL_GU2 + SZ_WGU, WL_SIZE = WL_D2 + SZ_WD;
static_assert(WL_SIZE == 44040192, "per-layer bf16 weight bytes");
constexpr size_t WS_REC = 488 * MiB; constexpr int REC_BYTES = 13312, REC_N = 10240, REC_T = 11776, REC_G = 12288;
constexpr size_t WS_LW = 1 * MiB, LW_SIZE = 131072;
constexpr size_t WS_W = 2 * MiB;
constexpr size_t WS_X = 176 * MiB, WS_XB = 242 * MiB, WS_SSQ = 276 * MiB, WS_H = 280 * MiB, WS_P = 372 * MiB, WS_OPS = 488 * MiB, WS_G = 586 * MiB, WS_SC = 603 * MiB,
                 WS_YS = 604 * MiB, WS_XC = 622 * MiB, WS_DT = 651 * MiB, WS_YC = 652 * MiB, WS_AP = 678 * MiB, WS_AM = 752 * MiB, WS_AL = 754 * MiB, WS_YM = 756 * MiB, WS_END = 790 * MiB;
static_assert(WS_W + 4 * WL_SIZE <= WS_X && WS_X + (size_t)MP * D * 4 <= WS_XB && WS_XB + (size_t)MP * D * 2 <= WS_SSQ && WS_SSQ + (size_t)MP * 64 <= WS_H && WS_H + (size_t)MP * FF * 2 <= WS_P &&
              WS_P + (size_t)MP * NPP * 2 <= WS_OPS && WS_OPS + (size_t)TOK * 4 * 384 * 4 <= WS_G && WS_G + (size_t)TOK * 256 * 4 <= WS_SC && WS_SC + (size_t)TOK * 32 <= WS_YS &&
              WS_YS + (size_t)TOK * 256 * 4 <= WS_XC && WS_XC + (size_t)TOK * 896 * 2 <= WS_DT && WS_DT + (size_t)TOK * 32 <= WS_YC && WS_YC + (size_t)TOK * 384 * 4 <= WS_AP &&
              WS_AP + (size_t)3 * TOK * 384 * 4 <= WS_AM && WS_AM + (size_t)3 * TOK * 32 <= WS_AL && WS_AL + (size_t)3 * TOK * 32 <= WS_YM && WS_YM + (size_t)MP * D * 2 <= WS_END, "d_ws map");
constexpr int CW_BAR = 4096;
constexpr int CW_Q = 16384;
constexpr int RING_BYTES = 131072, LDSCTL_OFF = RING_BYTES, MISC_OFF = LDSCTL_OFF + 320, LDS_BYTES = 147456;

typedef unsigned v2u __attribute__((ext_vector_type(2)));

#ifndef PHASE_FN
#define PHASE_FN __attribute__((noinline)) static
#endif
struct KArgs { const float* in[38]; float* out; unsigned char* ws; };
#define CAS __attribute__((address_space(4)))
struct KA {
    const CAS unsigned char* kp;
    __device__ __forceinline__ const float* in(int k) const { return *(const float* const CAS*)(kp + 8 * k); }
    __device__ __forceinline__ float* out() const { return *(float* const CAS*)(kp + 304); }
    __device__ __forceinline__ unsigned char* ws() const { return *(unsigned char* const CAS*)(kp + 312); }
};
__device__ __forceinline__ KA make_ka() { KA k; k.kp = (const CAS unsigned char*)__builtin_amdgcn_kernarg_segment_ptr(); asm volatile("" : "+s"(k.kp)); return k; }
__device__ __forceinline__ int fresh_tid() { int t = threadIdx.x; asm volatile("" : "+v"(t)); return t; }

__device__ __forceinline__ float bf2f(bf16 u) { return __uint_as_float((unsigned)u << 16); }
__device__ __forceinline__ float bflo(unsigned u) { return __uint_as_float(u << 16); }
__device__ __forceinline__ float bfhi(unsigned u) { return __uint_as_float(u & 0xffff0000u); }
__device__ __forceinline__ bf16 f2bf_s(float f) { unsigned u = __float_as_uint(f); return (bf16)((u + 0x7fffu + ((u >> 16) & 1u)) >> 16); }
template <int CTRL> __device__ __forceinline__ float dppf(float v) { return __builtin_bit_cast(float, __builtin_amdgcn_update_dpp(0, __builtin_bit_cast(int, v), CTRL, 0xF, 0xF, true)); }
template <int N> __device__ __forceinline__ float dpp_shr(float v, float fill) { return __builtin_bit_cast(float, __builtin_amdgcn_update_dpp(__builtin_bit_cast(int, fill), __builtin_bit_cast(int, v), 0x110 + N, 0xF, 0xF, false)); }
__device__ __forceinline__ float red8(float v) { v += dppf<0xB1>(v); v += dppf<0x4E>(v); v += dppf<0x141>(v); return v; }
__device__ __forceinline__ float wave_sum(float v) { v += dppf<0xB1>(v); v += dppf<0x4E>(v); v += dppf<0x141>(v); v += dppf<0x140>(v); v = pg8::xsum16(v); return pg8::xsum32(v); }
__device__ __forceinline__ float wave_max(float v) { v = fmaxf(v, dppf<0xB1>(v)); v = fmaxf(v, dppf<0x4E>(v)); v = fmaxf(v, dppf<0x141>(v)); v = fmaxf(v, dppf<0x140>(v)); v = pg8::xmax16(v); return pg8::xmax32(v); }
__device__ __forceinline__ float sigmoidf_(float x) { return __builtin_amdgcn_rcpf(1.0f + __builtin_amdgcn_exp2f(-1.4426950408889634f * x)); }
__device__ __forceinline__ float tanhf_(float x) { return 2.0f * sigmoidf_(2.0f * x) - 1.0f; }
__device__ __forceinline__ float softplusf_(float x) { return fmaxf(x, 0.f) + 0.6931471805599453f * __builtin_amdgcn_logf(1.0f + __builtin_amdgcn_exp2f(-1.4426950408889634f * fabsf(x))); }
template <int K> __device__ __forceinline__ f32x4 tile_mma(f32x4 acc, const LAS bf16* A, int lda, const LAS bf16* B, int ldb, int lane) {
    const LAS bf16* ap = A + (lane & 15) * lda + 8 * (lane >> 4); const LAS bf16* bp = B + (lane & 15) * ldb + 8 * (lane >> 4);
#pragma unroll
    for (int k = 0; k < K; k += 32) acc = __builtin_amdgcn_mfma_f32_16x16x32_bf16(*(const LAS bf16x8*)(ap + k), *(const LAS bf16x8*)(bp + k), acc, 0, 0, 0);
    return acc;
}

template <int MODE, int VW> __device__ __forceinline__ void tr_item(const float* W, int K, int N, const float* gain, bf16* WT, LAS float* scr, int kb, int nb, int lane) {
    const int k0 = 64 * kb, n0 = 32 * nb;
    constexpr int LPR = 32 / VW, RPI = 64 / LPR, NI = 64 / RPI;
    const int rr = lane / LPR, cc = (lane % LPR) * VW;
    float v[NI][VW];
#pragma unroll
    for (int i = 0; i < NI; ++i) { const int kk = RPI * i + rr; const float* p = W + (size_t)(k0 + kk) * N + n0 + cc;
        if (n0 + 32 <= N) { if (VW == 4) { const f32x4 t = *(const f32x4*)p; v[i][0] = t[0]; v[i][1] = t[1]; v[i][VW - 2] = t[2]; v[i][VW - 1] = t[3]; } else { const pg8::f32x2 t = *(const pg8::f32x2*)p; v[i][0] = t[0]; v[i][1] = t[1]; } }
        else {
#pragma unroll
            for (int e = 0; e < VW; ++e) v[i][e] = (n0 + cc + e < N) ? p[e] : 0.f; } }
#pragma unroll
    for (int i = 0; i < NI; ++i) { const int kk = RPI * i + rr; const float g = gain ? gain[k0 + kk] : 1.0f;
#pragma unroll
        for (int e = 0; e < VW; ++e) scr[kk * 33 + cc + e] = v[i][e] * g; }
    asm volatile("s_waitcnt lgkmcnt(0)" ::: "memory");
    const int c = lane & 7;
#pragma unroll
    for (int j = 0; j < 4; ++j) { const int nl = (lane >> 3) + 8 * j, n = n0 + nl; const LAS float* sp = scr + (8 * c) * 33 + nl;
        v4u o; o.x = pg8::cvt_pk_bf16(sp[0 * 33], sp[1 * 33]); o.y = pg8::cvt_pk_bf16(sp[2 * 33], sp[3 * 33]); o.z = pg8::cvt_pk_bf16(sp[4 * 33], sp[5 * 33]); o.w = pg8::cvt_pk_bf16(sp[6 * 33], sp[7 * 33]);
        const int drow = (MODE == 0) ? n : 8 * (n >> 2) + 4 * (MODE - 1) + (n & 3);
        *(v4u*)(WT + (size_t)drow * K + k0 + 8 * c) = o; }
    asm volatile("s_waitcnt lgkmcnt(0)" ::: "memory");
}
constexpr int I_G = 16 * 88, I_D = 44 * 32, I_IN = 16 * 112, I_OUT = 16 * 32, I_LAYER = 6 * 1408 + I_IN + I_OUT;
static_assert(I_G == 1408 && I_D == 1408 && I_LAYER % 8 == 0, "items");
__device__ __forceinline__ void wconv_item(const KA a, int l, int r, LAS float* scr, int lane) {
    bf16* wl = (bf16*)(a.ws() + WS_W + (size_t)l * WL_SIZE);
    if (r < I_G) { tr_item<1, 4>(a.in(9) + (size_t)l * D * FF, D, FF, a.in(8) + l * D, (bf16*)((unsigned char*)wl + WL_GU1), scr, r / 88, r % 88, lane); return; } r -= I_G;
    if (r < I_G) { tr_item<2, 4>(a.in(10) + (size_t)l * D * FF, D, FF, a.in(8) + l * D, (bf16*)((unsigned char*)wl + WL_GU1), scr, r / 88, r % 88, lane); return; } r -= I_G;
    if (r < I_D) { tr_item<0, 4>(a.in(11) + (size_t)l * D * FF, FF, D, nullptr, (bf16*)((unsigned char*)wl + WL_D1), scr, r / 32, r % 32, lane); return; } r -= I_D;
    if (r < I_IN) { tr_item<0, 2>(a.in(13) + (size_t)l * D * NPJ, D, NPJ, a.in(12) + l * D, (bf16*)((unsigned char*)wl + WL_IN), scr, r / 112, r % 112, lane); return; } r -= I_IN;
    if (r < I_OUT) { tr_item<0, 4>(a.in(32) + (size_t)l * D * D, D, D, nullptr, (bf16*)((unsigned char*)wl + WL_OUT), scr, r / 32, r % 32, lane); return; } r -= I_OUT;
    if (r < I_G) { tr_item<1, 4>(a.in(34) + (size_t)l * D * FF, D, FF, a.in(33) + l * D, (bf16*)((unsigned char*)wl + WL_GU2), scr, r / 88, r % 88, lane); return; } r -= I_G;
    if (r < I_G) { tr_item<2, 4>(a.in(35) + (size_t)l * D * FF, D, FF, a.in(33) + l * D, (bf16*)((unsigned char*)wl + WL_GU2), scr, r / 88, r % 88, lane); return; } r -= I_G;
    tr_item<0, 4>(a.in(36) + (size_t)l * D * FF, FF, D, nullptr, (bf16*)((unsigned char*)wl + WL_D2), scr, r / 32, r % 32, lane);
}
__device__ __forceinline__ void p0_prologue(const KA a, LAS unsigned char* lds, int tid) {
    const int lane = tid & 63, wave = __builtin_amdgcn_readfirstlane(tid >> 6), gw = blockIdx.x * NWAVES + wave; int NGW = gridDim.x * NWAVES; asm volatile("" : "+s"(NGW));
    LAS float* scr = (LAS float*)(lds + wave * 16384);
    for (int it = gw; it < DEPTH * 32; it += NGW) {
        const int l = it >> 5, r = it & 31; bf16* lw = (bf16*)(a.ws() + WS_LW + (size_t)l * LW_SIZE);
        if (r < 8) tr_item<0, 4>(a.in(16) + (size_t)l * 64 * 256, 64, 256, nullptr, lw, scr, 0, r, lane);
        else if (r < 16) tr_item<0, 4>(a.in(18) + (size_t)l * 64 * 256, 64, 256, nullptr, lw + 256 * 64, scr, 0, r - 8, lane);
        else tr_item<0, 4>(a.in(19) + (size_t)l * 128 * 256, 128, 256, nullptr, lw + 2 * 256 * 64, scr, (r - 16) >> 3, (r - 16) & 7, lane);
    }
    for (int it = gw; it < I_LAYER; it += NGW) wconv_item(a, 0, it, scr, lane);
}
__device__ __forceinline__ void wconv_unit(const KA a, int l, int u, LAS unsigned char* lds, int tid) {
    const int lane = tid & 63, wave = __builtin_amdgcn_readfirstlane(tid >> 6);
    wconv_item(a, l, u * 8 + wave, (LAS float*)(lds + wave * 16384), lane);
}
constexpr int WTAIL_K = 3, WT_C0 = 150, WT_C1 = 142, WT_N0 = (256 - WT_C0) * 8 * WTAIL_K, WT_N1 = (256 - WT_C1) * 8 * WTAIL_K, WT_ITEMS = 2 * WT_N0 + WT_N1;
static_assert(WT_ITEMS % 8 == 0 && WT_ITEMS <= I_LAYER, "tail items");
__device__ __forceinline__ void wconv_tail(const KA a, int l, int slot, LAS unsigned char* lds, int tid) {
    if (gridDim.x != 256) return;
    const int c0 = (slot == 1) ? WT_C1 : WT_C0, base = (slot == 0) ? 0 : (slot == 1 ? WT_N0 : WT_N0 + WT_N1), nw = (256 - c0) * 8;
    if ((int)blockIdx.x < c0) return;
    const int lane = tid & 63, wave = __builtin_amdgcn_readfirstlane(tid >> 6), widx = ((int)blockIdx.x - c0) * 8 + wave;
    __syncthreads();
#pragma unroll 1
    for (int k = 0; k < WTAIL_K; ++k) wconv_item(a, l, base + k * nw + widx, (LAS float*)(lds + wave * 16384), lane);
}
PHASE_FN __device__ void p0_xinit(const KA a, int tid) {
    const int lane = tid & 63, wave = __builtin_amdgcn_readfirstlane(tid >> 6), gw = blockIdx.x * NWAVES + wave; int NGW = gridDim.x * NWAVES; asm volatile("" : "+s"(NGW));
    float* X = (float*)(a.ws() + WS_X); bf16* XB = (bf16*)(a.ws() + WS_XB); float* SSQ = (float*)(a.ws() + WS_SSQ); bf16* YM = (bf16*)(a.ws() + WS_YM);
    for (int m = gw; m < MP; m += NGW) {
        const float* src = (m < TP) ? a.in(0) + (size_t)m * D : a.in(1) + (size_t)(m - TP) * D;
        f32x4 v[4]; float s = 0.f;
#pragma unroll
        for (int j = 0; j < 4; ++j) { v[j] = (m < TOK) ? ((const f32x4*)src)[lane + 64 * j] : (f32x4){0.f, 0.f, 0.f, 0.f}; s += (v[j][0] * v[j][0] + v[j][1] * v[j][1]) + (v[j][2] * v[j][2] + v[j][3] * v[j][3]); }
        s = wave_sum(s);
#pragma unroll
        for (int j = 0; j < 4; ++j) {
            v2u w; w.x = pg8::cvt_pk_bf16(v[j][0], v[j][1]); w.y = pg8::cvt_pk_bf16(v[j][2], v[j][3]); ((v2u*)(XB + (size_t)m * D))[lane + 64 * j] = w;
            if (m >= TOK) ((v2u*)(YM + (size_t)m * D))[lane + 64 * j] = (v2u){0u, 0u}; }
        if (m < TP) { if (lane < 16) SSQ[(size_t)m * 16 + lane] = (lane == 0) ? s : 0.f; }
        else SSQ[pg8::SSQS_OFF + (size_t)(m - TP) * 64 + lane] = (lane == 0) ? s : 0.f;
    }
}

__device__ __forceinline__ v2u pk4(f32x4 v) { v2u w; w.x = pg8::cvt_pk_bf16(v[0], v[1]); w.y = pg8::cvt_pk_bf16(v[2], v[3]); return w; }
__device__ __forceinline__ f32x4 up4(v2u w) { return (f32x4){bflo(w.x), bfhi(w.x), bflo(w.y), bfhi(w.y)}; }
__device__ __forceinline__ void ld8(float (&d)[8], const bf16* p) { const v4u w = *(const v4u*)p; d[0] = bflo(w.x); d[1] = bfhi(w.x); d[2] = bflo(w.y); d[3] = bfhi(w.y); d[4] = bflo(w.z); d[5] = bfhi(w.z); d[6] = bflo(w.w); d[7] = bfhi(w.w); }
__device__ __forceinline__ void ld4(float (&d)[4], const bf16* p) { const v2u w = *(const v2u*)p; d[0] = bflo(w.x); d[1] = bfhi(w.x); d[2] = bflo(w.y); d[3] = bfhi(w.y); }
__device__ __forceinline__ void rwkv_prep(const KA a, int l, LAS unsigned char* lds, int tid) {
    const int lane = tid & 63, wave = __builtin_amdgcn_readfirstlane(tid >> 6);
    int ngrp = gridDim.x >> 2; asm volatile("" : "+s"(ngrp));
    const int h = blockIdx.x & 3, wv = (blockIdx.x >> 2) * NWAVES + wave, NW = ngrp * NWAVES;
    if ((int)(blockIdx.x >> 2) >= ngrp) return;
    const int fr = lane & 15, fq = lane >> 4;
    const bf16* P = (const bf16*)(a.ws() + WS_P);
    const bf16* w2t = (const bf16*)(a.ws() + WS_LW + (size_t)l * LW_SIZE); const bf16* a2t = w2t + 256 * 64; const bf16* g2t = a2t + 256 * 64;
    LAS bf16* W2 = (LAS bf16*)lds; LAS bf16* A2 = W2 + 64 * 72; LAS bf16* G2 = A2 + 64 * 72;
    { const int r = tid >> 3, c = tid & 7;
      *(LAS v4u*)(W2 + r * 72 + c * 8) = *(const v4u*)(w2t + (size_t)(64 * h + r) * 64 + c * 8); *(LAS v4u*)(A2 + r * 72 + c * 8) = *(const v4u*)(a2t + (size_t)(64 * h + r) * 64 + c * 8);
#pragma unroll
      for (int q = 0; q < 2; ++q) { const int idx = tid + NTHR * q, rr = idx >> 4, cc = idx & 15; *(LAS v4u*)(G2 + rr * 136 + cc * 8) = *(const v4u*)(g2t + (size_t)(64 * h + rr) * 128 + cc * 8); } }
    __syncthreads();
    const float* mu = a.in(14) + l * 1024;
    float* G = (float*)(a.ws() + WS_G); float* SC = (float*)(a.ws() + WS_SC);
    for (int tile = wv; tile < TOK / 16; tile += NW) {
        const int row = tile * 16 + fr;
        bool first; const float* sh = nullptr;
        if (row < TP) first = (row & 2047) == 0; else { const int r = row - TP; first = (r & 3) == 0; sh = a.in(4) + (size_t)(l * 32 + (r >> 2)) * 1024; }
        const bf16* pc = P + (size_t)row * NPP; const bf16* pq = first ? pc : pc - NPP;
        bf16x8 fw[2], fa[2], fg[4];
#pragma unroll
        for (int ks = 0; ks < 8; ++ks) { const int col = 768 + 32 * ks + 8 * fq;
            float c[8], p[8]; ld8(c, pc + col); ld8(p, pq + col);
            const f32x4 m0 = *(const f32x4*)(mu + col), m1 = *(const f32x4*)(mu + col + 4);
            if (first) { if (sh) { const f32x4 s0 = *(const f32x4*)(sh + col), s1 = *(const f32x4*)(sh + col + 4);
#pragma unroll
                    for (int e = 0; e < 4; ++e) { p[e] = s0[e]; p[4 + e] = s1[e]; } } else {
#pragma unroll
                    for (int e = 0; e < 8; ++e) p[e] = 0.f; } }
            float x[8];
#pragma unroll
            for (int e = 0; e < 8; ++e) { const float m = (e < 4) ? m0[e & 3] : m1[e & 3]; const float ps = c[e] + m * (p[e] - c[e]); x[e] = (ks < 2) ? tanhf_(ps) : (ks < 4 ? ps : sigmoidf_(ps)); }
            union { bf16x8 v; unsigned u[4]; } f; f.u[0] = pg8::cvt_pk_bf16(x[0], x[1]); f.u[1] = pg8::cvt_pk_bf16(x[2], x[3]); f.u[2] = pg8::cvt_pk_bf16(x[4], x[5]); f.u[3] = pg8::cvt_pk_bf16(x[6], x[7]);
            if (ks < 2) fw[ks] = f.v; else if (ks < 4) fa[ks - 2] = f.v; else fg[ks - 4] = f.v;
            if (ks & 1) { } }
        {
            f32x4 aw[4], aa[4], ag[4];
#pragma unroll
            for (int t = 0; t < 4; ++t) { const int n = 16 * t + fr;
                const LAS bf16* wp = W2 + n * 72 + 8 * fq; const LAS bf16* ap = A2 + n * 72 + 8 * fq; const LAS bf16* gp = G2 + n * 136 + 8 * fq;
                f32x4 z = (f32x4){0.f, 0.f, 0.f, 0.f};
                aw[t] = __builtin_amdgcn_mfma_f32_16x16x32_bf16(*(const LAS bf16x8*)wp, fw[0], z, 0, 0, 0); aw[t] = __builtin_amdgcn_mfma_f32_16x16x32_bf16(*(const LAS bf16x8*)(wp + 32), fw[1], aw[t], 0, 0, 0);
                aa[t] = __builtin_amdgcn_mfma_f32_16x16x32_bf16(*(const LAS bf16x8*)ap, fa[0], z, 0, 0, 0); aa[t] = __builtin_amdgcn_mfma_f32_16x16x32_bf16(*(const LAS bf16x8*)(ap + 32), fa[1], aa[t], 0, 0, 0);
                ag[t] = __builtin_amdgcn_mfma_f32_16x16x32_bf16(*(const LAS bf16x8*)gp, fg[0], z, 0, 0, 0); ag[t] = __builtin_amdgcn_mfma_f32_16x16x32_bf16(*(const LAS bf16x8*)(gp + 32), fg[1], ag[t], 0, 0, 0);
                ag[t] = __builtin_amdgcn_mfma_f32_16x16x32_bf16(*(const LAS bf16x8*)(gp + 64), fg[2], ag[t], 0, 0, 0); ag[t] = __builtin_amdgcn_mfma_f32_16x16x32_bf16(*(const LAS bf16x8*)(gp + 96), fg[3], ag[t], 0, 0, 0);
                *(f32x4*)(G + (size_t)row * 256 + 64 * h + 16 * t + 4 * fq) = ag[t]; }
            float r[4][4], k[4][4];
#pragma unroll
            for (int t = 0; t < 4; ++t) { const int c = 64 * h + 16 * t + 4 * fq;
#pragma unroll
                for (int part = 0; part < 2; ++part) { const int col = 256 * part + c; float cc[4], pp[4]; ld4(cc, pc + col); ld4(pp, pq + col);
                    const f32x4 m = *(const f32x4*)(mu + col);
                    if (first) { if (sh) { const f32x4 s0 = *(const f32x4*)(sh + col);
#pragma unroll
                            for (int e = 0; e < 4; ++e) pp[e] = s0[e]; } else {
#pragma unroll
                            for (int e = 0; e < 4; ++e) pp[e] = 0.f; } }
#pragma unroll
                    for (int e = 0; e < 4; ++e) { const float ps = cc[e] + m[e] * (pp[e] - cc[e]); if (part == 0) r[t][e] = ps; else k[t][e] = ps; } } }
            float n2 = 0.f;
#pragma unroll
            for (int t = 0; t < 4; ++t) { const int c = l * 256 + 64 * h + 16 * t + 4 * fq;
                const f32x4 w0 = *(const f32x4*)(a.in(15) + c), a0 = *(const f32x4*)(a.in(17) + c), kkw = *(const f32x4*)(a.in(20) + c);
#pragma unroll
                for (int e = 0; e < 4; ++e) { const float wlog = -softplusf_(-(w0[e] + aw[t][e])) - 0.5f; aw[t][e] = __expf(-__expf(wlog)); aa[t][e] = sigmoidf_(a0[e] + aa[t][e]); const float kk = k[t][e] * kkw[e]; n2 += kk * kk; } }
            n2 = pg8::xsum16(n2); n2 = pg8::xsum32(n2);
            const float inv = 1.0f / fmaxf(sqrtf(n2), 1e-12f);
            float br = 0.f, kr = 0.f, bon = 0.f;
#pragma unroll
            for (int t = 0; t < 4; ++t) { const int c = l * 256 + 64 * h + 16 * t + 4 * fq;
                const f32x4 kkw = *(const f32x4*)(a.in(20) + c), kaw = *(const f32x4*)(a.in(21) + c), rkw = *(const f32x4*)(a.in(22) + c);
#pragma unroll
                for (int e = 0; e < 4; ++e) { const float kk = k[t][e] * kkw[e] * inv, av = aa[t][e], kt = k[t][e] * (1.f + (av - 1.f) * kaw[e]);
                    br += kk * av * r[t][e]; kr += kt * r[t][e]; bon += r[t][e] * kt * rkw[e]; } }
            br = pg8::xsum16(br); br = pg8::xsum32(br); kr = pg8::xsum16(kr); kr = pg8::xsum32(kr); bon = pg8::xsum16(bon); bon = pg8::xsum32(bon);
            unsigned char* rec = a.ws() + WS_REC + (size_t)(tile * 4 + h) * REC_BYTES;
            const bool samp = tile >= TP / 16;
            const bool c1 = !samp || (fr & 3) >= 1, c2 = !samp || (fr & 3) >= 2;
            f32x4 At4[4], Rt4[4], Bt4[4], Kt4[4];
#pragma unroll
            for (int t = 0; t < 4; ++t) { const int c = l * 256 + 64 * h + 16 * t + 4 * fq;
                const f32x4 kkw = *(const f32x4*)(a.in(20) + c), kaw = *(const f32x4*)(a.in(21) + c);
                f32x4 vv;
                { const int col = 512 + 64 * h + 16 * t + 4 * fq; float cc[4], pp[4]; ld4(cc, pc + col); ld4(pp, pq + col); const f32x4 m = *(const f32x4*)(mu + col);
                  if (first) { if (sh) { const f32x4 q0 = *(const f32x4*)(sh + col);
#pragma unroll
                          for (int e = 0; e < 4; ++e) pp[e] = q0[e]; } else {
#pragma unroll
                          for (int e = 0; e < 4; ++e) pp[e] = 0.f; } }
#pragma unroll
                  for (int e = 0; e < 4; ++e) vv[e] = cc[e] + m[e] * (pp[e] - cc[e]); }
                f32x4 gend;
#pragma unroll
                for (int e = 0; e < 4; ++e) { const float kk = k[t][e] * kkw[e] * inv, av = aa[t][e], w = aw[t][e], kt = k[t][e] * (1.f + (av - 1.f) * kaw[e]);
                    float g = w, x;
                    x = dpp_shr<1>(g, 1.0f); g *= c1 ? x : 1.0f;
                    x = dpp_shr<2>(g, 1.0f); g *= c2 ? x : 1.0f;
                    x = dpp_shr<4>(g, 1.0f); g *= samp ? 1.0f : x;
                    x = dpp_shr<8>(g, 1.0f); g *= samp ? 1.0f : x;
                    x = dpp_shr<1>(g, 1.0f); const float gm = c1 ? x : 1.0f;
                    const float ig = __builtin_amdgcn_rcpf(g);
                    At4[t][e] = -gm * kk; Rt4[t][e] = gm * (w * r[t][e] - kk * br); Bt4[t][e] = kk * av * ig; Kt4[t][e] = kt * ig; gend[e] = g; }
                const size_t eo = ((size_t)fr * 64 + 16 * t + 4 * fq) * 2;
                *(v2u*)(rec + eo) = pk4(At4[t]); *(v2u*)(rec + 2048 + eo) = pk4(Rt4[t]); *(v2u*)(rec + 4096 + eo) = pk4(Bt4[t]); *(v2u*)(rec + 6144 + eo) = pk4(Kt4[t]); *(v2u*)(rec + 8192 + eo) = pk4(vv);
                if (samp ? ((fr & 3) == 3) : (fr == 15)) *(f32x4*)(rec + REC_G + ((samp ? (fr >> 2) : 0) * 64 + 16 * t + 4 * fq) * 4) = gend; }
            { union FR { bf16x8 v; unsigned u[4]; } fA[2], fR[2], fB[2], fK[2];
#pragma unroll
              for (int ks = 0; ks < 2; ++ks) { const v2u a0 = pk4(At4[2 * ks]), a1 = pk4(At4[2 * ks + 1]), r0 = pk4(Rt4[2 * ks]), r1 = pk4(Rt4[2 * ks + 1]), b0 = pk4(Bt4[2 * ks]), b1 = pk4(Bt4[2 * ks + 1]), k0 = pk4(Kt4[2 * ks]), k1 = pk4(Kt4[2 * ks + 1]);
                  fA[ks].u[0] = a0.x; fA[ks].u[1] = a0.y; fA[ks].u[2] = a1.x; fA[ks].u[3] = a1.y; fR[ks].u[0] = r0.x; fR[ks].u[1] = r0.y; fR[ks].u[2] = r1.x; fR[ks].u[3] = r1.y;
                  fB[ks].u[0] = b0.x; fB[ks].u[1] = b0.y; fB[ks].u[2] = b1.x; fB[ks].u[3] = b1.y; fK[ks].u[0] = k0.x; fK[ks].u[1] = k0.y; fK[ks].u[2] = k1.x; fK[ks].u[3] = k1.y; }
              const f32x4 z4 = (f32x4){0.f, 0.f, 0.f, 0.f};
              f32x4 nba = __builtin_amdgcn_mfma_f32_16x16x32_bf16(fB[0].v, fA[0].v, z4, 0, 0, 0); nba = __builtin_amdgcn_mfma_f32_16x16x32_bf16(fB[1].v, fA[1].v, nba, 0, 0, 0);
              f32x4 nka = __builtin_amdgcn_mfma_f32_16x16x32_bf16(fK[0].v, fA[0].v, z4, 0, 0, 0); nka = __builtin_amdgcn_mfma_f32_16x16x32_bf16(fK[1].v, fA[1].v, nka, 0, 0, 0);
              f32x4 nbr = __builtin_amdgcn_mfma_f32_16x16x32_bf16(fB[0].v, fR[0].v, z4, 0, 0, 0); nbr = __builtin_amdgcn_mfma_f32_16x16x32_bf16(fB[1].v, fR[1].v, nbr, 0, 0, 0);
              f32x4 nkr = __builtin_amdgcn_mfma_f32_16x16x32_bf16(fK[0].v, fR[0].v, z4, 0, 0, 0); nkr = __builtin_amdgcn_mfma_f32_16x16x32_bf16(fK[1].v, fR[1].v, nkr, 0, 0, 0);
              LAS float* Nb = (LAS float*)(lds + 36864) + wave * 288;
#pragma unroll
              for (int e = 0; e < 4; ++e) { const int sN = 4 * fq + e, tN = fr; const bool keep = (sN < tN) && (!samp || (sN >> 2) == (tN >> 2));
                  nba[e] = keep ? nba[e] : 0.f; nka[e] = keep ? nka[e] : 0.f; nbr[e] = keep ? nbr[e] : 0.f; nkr[e] = keep ? nkr[e] : 0.f;
                  Nb[sN * 17 + tN] = nba[e];
                  bf16* np = (bf16*)(rec + REC_N) + sN * 16 + tN; np[0] = f2bf_s(nka[e]); np[256] = f2bf_s(nbr[e]); np[512] = f2bf_s(nkr[e]); }
              asm volatile("s_waitcnt lgkmcnt(0)" ::: "memory");
              float Tr[16];
#pragma unroll
              for (int t = 0; t < 16; ++t) { float acc = (fr == t) ? 1.f : 0.f;
#pragma unroll
                  for (int sN = 0; sN < t; ++sN) acc += Tr[sN] * Nb[sN * 17 + t];
                  Tr[t] = acc; }
              if (fq == 0) { v4u o0, o1; o0.x = pg8::cvt_pk_bf16(Tr[0], Tr[1]); o0.y = pg8::cvt_pk_bf16(Tr[2], Tr[3]); o0.z = pg8::cvt_pk_bf16(Tr[4], Tr[5]); o0.w = pg8::cvt_pk_bf16(Tr[6], Tr[7]);
                  o1.x = pg8::cvt_pk_bf16(Tr[8], Tr[9]); o1.y = pg8::cvt_pk_bf16(Tr[10], Tr[11]); o1.z = pg8::cvt_pk_bf16(Tr[12], Tr[13]); o1.w = pg8::cvt_pk_bf16(Tr[14], Tr[15]);
                  *(v4u*)(rec + REC_T + fr * 32) = o0; *(v4u*)(rec + REC_T + fr * 32 + 16) = o1; }
              asm volatile("s_waitcnt lgkmcnt(0)" ::: "memory"); }
            if (fq == 0) { SC[(size_t)(row * 4 + h) * 2] = kr; SC[(size_t)(row * 4 + h) * 2 + 1] = bon; }
        }
    }
}

PHASE_FN __device__ void prep_elementwise(const KA a, int l, int tid) {
    int skipb = (gridDim.x > 8) ? 4 : 0; asm volatile("" : "+s"(skipb));
    if ((int)blockIdx.x < skipb) return;
    const int gtid = ((int)blockIdx.x - skipb) * NTHR + tid; int GT = ((int)gridDim.x - skipb) * NTHR; asm volatile("" : "+s"(GT));
    const bf16* P = (const bf16*)(a.ws() + WS_P); bf16* XC = (bf16*)(a.ws() + WS_XC); float* DT = (float*)(a.ws() + WS_DT); float* out = a.out();
    const float* cw = a.in(26) + (size_t)l * 4 * 896; const float* cb = a.in(27) + l * 896;
    for (int idx = gtid; idx < (TOK / 4) * 112; idx += GT) {
        const int grp = idx / 112, c8 = idx - grp * 112, col = c8 * 8, row0 = grp * 4;
        int t0, b = 0; if (row0 < TP) t0 = row0 & 2047; else { b = (row0 - TP) >> 2; t0 = 0; }
        float x[7][8];
#pragma unroll
        for (int i = 0; i < 7; ++i) { const int tt = t0 - 3 + i;
            if (tt >= 0) ld8(x[i], P + (size_t)(row0 - 3 + i) * NPP + C_XBC + col);
            else if (row0 < TP) {
#pragma unroll
                for (int e = 0; e < 8; ++e) x[i][e] = 0.f; }
            else { const float* s = a.in(6) + ((size_t)(l * 32 + b) * 3 + i) * 896 + col; const f32x4 s0 = *(const f32x4*)s, s1 = *(const f32x4*)(s + 4);
#pragma unroll
                for (int e = 0; e < 4; ++e) { x[i][e] = s0[e]; x[i][4 + e] = s1[e]; } } }
        float wv[4][8], bv[8];
#pragma unroll
        for (int i = 0; i < 4; ++i) { const f32x4 w0 = *(const f32x4*)(cw + i * 896 + col), w1 = *(const f32x4*)(cw + i * 896 + col + 4);
#pragma unroll
            for (int e = 0; e < 4; ++e) { wv[i][e] = w0[e]; wv[i][4 + e] = w1[e]; } }
        { const f32x4 b0 = *(const f32x4*)(cb + col), b1 = *(const f32x4*)(cb + col + 4);
#pragma unroll
          for (int e = 0; e < 4; ++e) { bv[e] = b0[e]; bv[4 + e] = b1[e]; } }
#pragma unroll
        for (int j = 0; j < 4; ++j) { float y[8];
#pragma unroll
            for (int e = 0; e < 8; ++e) { float acc = bv[e];
#pragma unroll
                for (int i = 0; i < 4; ++i) acc += wv[i][e] * x[j + i][e];
                y[e] = acc * sigmoidf_(acc); }
            v4u o; o.x = pg8::cvt_pk_bf16(y[0], y[1]); o.y = pg8::cvt_pk_bf16(y[2], y[3]); o.z = pg8::cvt_pk_bf16(y[4], y[5]); o.w = pg8::cvt_pk_bf16(y[6], y[7]);
            *(v4u*)(XC + (size_t)(row0 + j) * 896 + col) = o; }
    }
    for (int idx = gtid; idx < TOK * 6; idx += GT) { const int row = idx / 6, h = idx - row * 6;
        DT[(size_t)row * 8 + h] = softplusf_(bf2f(P[(size_t)row * NPP + C_DT + h]) + a.in(28)[l * 6 + h]); }
    for (int idx0 = gtid; idx0 < TOK * 96; idx0 += 4 * GT) {
        v4u w[4];
#pragma unroll
        for (int j = 0; j < 4; ++j) { const int idx = idx0 + j * GT; if (idx < TOK * 96) { const int row = idx / 96, c8 = idx - row * 96; w[j] = *(const v4u*)(P + (size_t)row * NPP + C_K + c8 * 8); } }
#pragma unroll
        for (int j = 0; j < 4; ++j) { const int idx = idx0 + j * GT; if (idx < TOK * 96) { const int row = idx / 96, c8 = idx - row * 96, which = c8 / 48, cc = (c8 - which * 48) * 8;
            float* dst = (row < TP) ? out + (which ? O_PV : O_PK) + ((size_t)l * TP + row) * 384 + cc : out + (which ? O_SV : O_SK) + ((size_t)l * TS + (row - TP)) * 384 + cc;
            *(f32x4*)dst = (f32x4){bflo(w[j].x), bfhi(w[j].x), bflo(w[j].y), bfhi(w[j].y)}; *(f32x4*)(dst + 4) = (f32x4){bflo(w[j].z), bfhi(w[j].z), bflo(w[j].w), bfhi(w[j].w)}; } }
    }
    for (int idx = gtid; idx < 40 * 1024; idx += GT) { const int s = idx >> 10, col = idx & 1023;
        const int row = (s < 8) ? s * 2048 + 2047 : TP + (s - 8) * 4 + 3;
        float* dst = (s < 8) ? out + O_PSH + (size_t)(l * 8 + s) * 1024 + col : out + O_SSH + (size_t)(l * 32 + s - 8) * 1024 + col;
        *dst = bf2f(P[(size_t)row * NPP + col]); }
    for (int idx = gtid; idx < 40 * 2688; idx += GT) { const int s = idx / 2688, rem = idx - s * 2688, i = rem / 896, col = rem - i * 896;
        const int row = (s < 8) ? s * 2048 + 2045 + i : TP + (s - 8) * 4 + 1 + i;
        float* dst = (s < 8) ? out + O_PC + ((size_t)(l * 8 + s) * 3 + i) * 896 + col : out + O_SC + ((size_t)(l * 32 + s - 8) * 3 + i) * 896 + col;
        *dst = bf2f(P[(size_t)row * NPP + C_XBC + col]); }
}

#define LBAR() asm volatile("s_waitcnt lgkmcnt(0)\n\ts_barrier" ::: "memory")
typedef short v4i16_t __attribute__((ext_vector_type(4)));
constexpr int CB_BYTES = 15872;
__device__ __forceinline__ v4i16_t tr4(const LAS bf16* T, int pitch, int col0, int lane) {
    return __builtin_amdgcn_ds_read_tr16_b64_v4i16((LAS v4i16_t*)(T + (4 * (lane >> 4) + ((lane & 15) >> 2)) * pitch + col0 + 4 * (lane & 3)));
}
typedef __bf16 bf2_t __attribute__((ext_vector_type(2))); typedef float f2v_t __attribute__((ext_vector_type(2)));
__device__ __forceinline__ unsigned cvt_pk_c(float lo, float hi) { const f2v_t v = {lo, hi}; return __builtin_bit_cast(unsigned, __builtin_convertvector(v, bf2_t)); }
__device__ __forceinline__ v4i16_t pack4(f32x4 x) { union { v4i16_t v; unsigned u[2]; } p; p.u[0] = cvt_pk_c(x[0], x[1]); p.u[1] = cvt_pk_c(x[2], x[3]); return p.v; }
PHASE_FN __device__ void rwkv_scan_unit(const KA a, int l, int unit, LAS unsigned char* lds, int tid) {
    int b, h, tile0, nch, seg, row_base; const float* s0; float* sout;
    if (unit < 32) { b = unit >> 2; h = unit & 3; tile0 = b * 128; nch = 128; seg = -1; row_base = b * 2048; s0 = nullptr; sout = a.out() + O_PR + (size_t)((l * 8 + b) * 4 + h) * 4096; }
    else { const int u = unit - 32; b = u >> 2; h = u & 3; tile0 = TP / 16 + (b >> 2); nch = 1; seg = b & 3; row_base = TP + b * 4; s0 = a.in(5) + (size_t)((l * 32 + b) * 4 + h) * 4096; sout = a.out() + O_SR + (size_t)((l * 32 + b) * 4 + h) * 4096; }
    const int lane = tid & 63, wave = __builtin_amdgcn_readfirstlane(tid >> 6), c16 = lane & 15, g = lane >> 4;
    const unsigned char* REC = a.ws() + WS_REC; float* YS = (float*)(a.ws() + WS_YS);
    LAS unsigned char* cbuf = lds;
    LAS bf16* SbAll = (LAS bf16*)(lds + 2 * CB_BYTES);
    if (wave >= 4) {
        const int ht = tid - 256;
        v4u ra[4], rb[4];
#define SC_FETCH(R, cc) do { const unsigned char* src_ = REC + (size_t)((tile0 + (cc)) * 4 + h) * REC_BYTES; \
            _Pragma("unroll") for (int q = 0; q < 4; ++q) { const int ci = ht + 256 * q; R[q] = *(const v4u*)(src_ + (ci < 832 ? ci : 831) * 16); } } while (0)
#define SC_PUT(R, cc) do { LAS unsigned char* dst_ = cbuf + ((cc) & 1) * CB_BYTES; \
            _Pragma("unroll") for (int q = 0; q < 4; ++q) { const int ci = ht + 256 * q; \
                if (ci < 640) { const int m_ = ci >> 7, r_ = (ci & 127) >> 3, k_ = ci & 7; *(LAS v4u*)(dst_ + m_ * 2560 + r_ * 160 + k_ * 16) = R[q]; } \
                else if (ci < 832) *(LAS v4u*)(dst_ + 12800 + (ci - 640) * 16) = R[q]; } } while (0)
#define SC_HELP(c, RL, RW) do { if ((c) + 2 < nch) SC_FETCH(RL, (c) + 2); if ((c) + 1 < nch) SC_PUT(RW, (c) + 1); LBAR(); } while (0)
        SC_FETCH(ra, 0); SC_PUT(ra, 0);
        if (1 < nch) SC_FETCH(rb, 1);
        LBAR();
        for (int c = 0; c < nch; c += 2) {
            SC_HELP(c, ra, rb);
            if (c + 1 < nch) SC_HELP(c + 1, rb, ra);
        }
#undef SC_HELP
#undef SC_PUT
#undef SC_FETCH
    } else {
        const int it = wave;
        LAS bf16* Sb = SbAll + it * (16 * 72);
        f32x4 S[4];
#pragma unroll
        for (int jt = 0; jt < 4; ++jt)
#pragma unroll
            for (int e = 0; e < 4; ++e) S[jt][e] = s0 ? s0[(size_t)(16 * it + 4 * g + e) * 64 + 16 * jt + c16] : 0.f;
        const bool mine = (seg < 0) || (g == seg);
        const v4i16_t zf = (v4i16_t){0, 0, 0, 0};
        LBAR();
        for (int c = 0; c < nch; ++c) {
            const LAS unsigned char* cb = cbuf + (c & 1) * CB_BYTES;
            const LAS bf16* At = (const LAS bf16*)cb; const LAS bf16* Rt = At + 1280; const LAS bf16* Bt = At + 2560; const LAS bf16* Kt = At + 3840; const LAS bf16* Vt = At + 5120;
            const LAS bf16* Nka = (const LAS bf16*)(cb + 12800); const LAS bf16* Nbr = Nka + 256; const LAS bf16* Nkr = Nka + 512; const LAS bf16* Tm = Nka + 768;
            const LAS float* Gam = (const LAS float*)(cb + 14848) + (seg < 0 ? 0 : seg) * 64;
#pragma unroll
            for (int jt = 0; jt < 4; ++jt)
#pragma unroll
                for (int e = 0; e < 4; ++e) Sb[(4 * g + e) * 72 + 16 * jt + c16] = f2bf_s(S[jt][e]);
            asm volatile("s_waitcnt lgkmcnt(0)" ::: "memory");
            const bf16x8 sb0 = *(const LAS bf16x8*)(Sb + c16 * 72 + 8 * g), sb1 = *(const LAS bf16x8*)(Sb + c16 * 72 + 32 + 8 * g);
            v4i16_t fV = tr4(Vt, 80, 16 * it, lane); if (!mine) fV = zf;
            f32x4 a0 = __builtin_amdgcn_mfma_f32_16x16x32_bf16(*(const LAS bf16x8*)(At + c16 * 80 + 8 * g), sb0, (f32x4){0.f, 0.f, 0.f, 0.f}, 0, 0, 0);
            a0 = __builtin_amdgcn_mfma_f32_16x16x32_bf16(*(const LAS bf16x8*)(At + c16 * 80 + 32 + 8 * g), sb1, a0, 0, 0, 0);
            a0 = __builtin_amdgcn_mfma_f32_16x16x16bf16_1k(tr4(Nka, 16, 0, lane), fV, a0, 0, 0, 0);
            const f32x4 ut = __builtin_amdgcn_mfma_f32_16x16x16bf16_1k(tr4(Tm, 16, 0, lane), pack4(a0), (f32x4){0.f, 0.f, 0.f, 0.f}, 0, 0, 0);
            v4i16_t utp = pack4(ut); if (!mine) utp = zf;
            f32x4 z = __builtin_amdgcn_mfma_f32_16x16x32_bf16(*(const LAS bf16x8*)(Rt + c16 * 80 + 8 * g), sb0, (f32x4){0.f, 0.f, 0.f, 0.f}, 0, 0, 0);
            z = __builtin_amdgcn_mfma_f32_16x16x32_bf16(*(const LAS bf16x8*)(Rt + c16 * 80 + 32 + 8 * g), sb1, z, 0, 0, 0);
            z = __builtin_amdgcn_mfma_f32_16x16x16bf16_1k(tr4(Nbr, 16, 0, lane), utp, z, 0, 0, 0);
            z = __builtin_amdgcn_mfma_f32_16x16x16bf16_1k(tr4(Nkr, 16, 0, lane), fV, z, 0, 0, 0);
#pragma unroll
            for (int e = 0; e < 4; ++e) { const int t = 4 * g + e; const int row = (seg < 0) ? row_base + 16 * c + t : row_base + (t & 3);
                if (mine) YS[(size_t)row * 256 + h * 64 + 16 * it + c16] = z[e]; }
#pragma unroll
            for (int jt = 0; jt < 4; ++jt) { f32x4 acc = __builtin_amdgcn_mfma_f32_16x16x16bf16_1k(utp, tr4(Bt, 80, 16 * jt, lane), S[jt], 0, 0, 0);
                acc = __builtin_amdgcn_mfma_f32_16x16x16bf16_1k(fV, tr4(Kt, 80, 16 * jt, lane), acc, 0, 0, 0);
                S[jt] = acc * Gam[16 * jt + c16]; }
            LBAR();
        }
#pragma unroll
        for (int jt = 0; jt < 4; ++jt)
#pragma unroll
            for (int e = 0; e < 4; ++e) sout[(size_t)(16 * it + 4 * g + e) * 64 + 16 * jt + c16] = S[jt][e];
    }
}

constexpr int SD_PC = 144, SD_PX = 80;
__device__ __forceinline__ bf16x8 tr_frag(const LAS bf16* T, int pitch, int k0, int col0, int lane) {
    const int g = lane >> 4, q = (lane & 15) >> 2, p = lane & 3;
    const LAS bf16* a0 = T + (k0 + 8 * g + q) * pitch + col0 + 4 * p;
    union { bf16x8 v; v4i16_t h[2]; } f;
    f.h[0] = __builtin_amdgcn_ds_read_tr16_b64_v4i16((LAS v4i16_t*)a0); f.h[1] = __builtin_amdgcn_ds_read_tr16_b64_v4i16((LAS v4i16_t*)(a0 + 4 * pitch));
    return f.v;
}
PHASE_FN __device__ void ssd_unit(const KA a, int l, int unit, LAS unsigned char* lds, int tid) {
    int b, h, row_base, T; const float* h0; float* hout;
    if (unit < 48) { b = unit / 6; h = unit - b * 6; row_base = b * 2048; T = 2048; h0 = nullptr; hout = a.out() + O_PS + (size_t)((l * 8 + b) * 6 + h) * 8192; }
    else { const int u = unit - 48; b = u / 6; h = u - b * 6; row_base = TP + b * 4; T = 4; h0 = a.in(7) + (size_t)((l * 32 + b) * 6 + h) * 8192; hout = a.out() + O_SS + (size_t)((l * 32 + b) * 6 + h) * 8192; }
    const int g = h / 3, lane = tid & 63, wave = __builtin_amdgcn_readfirstlane(tid >> 6), fr = lane & 15, fq = lane >> 4;
    LAS bf16* Cs = (LAS bf16*)lds;
    LAS bf16* Bs = Cs + 64 * SD_PC;
    LAS bf16* hb = Bs + 64 * SD_PC;
    LAS bf16* xs = hb + 64 * SD_PC;
    LAS bf16* xw = xs + 64 * SD_PX;
    LAS bf16* Sc = xw + 64 * SD_PX;
    LAS float* dt_all = (LAS float*)(Sc + 64 * SD_PX);
    LAS float* ac_all = dt_all + 2048;
    LAS float* a_tmp = ac_all + 2048;
    const bf16* XC = (const bf16*)(a.ws() + WS_XC); const float* DT = (const float*)(a.ws() + WS_DT); bf16* YC = (bf16*)(a.ws() + WS_YC);
    const float A = -__expf(a.in(29)[l * 6 + h]), Dh = a.in(30)[l * 6 + h];
    const int nch = (T + 63) >> 6, TPAD = nch * 64;
    { f32x4 d = (f32x4){0.f, 0.f, 0.f, 0.f};
      if (4 * tid < TPAD) {
#pragma unroll
          for (int e = 0; e < 4; ++e) d[e] = (4 * tid + e < T) ? DT[(size_t)(row_base + 4 * tid + e) * 8 + h] : 0.f;
          *(LAS f32x4*)(dt_all + 4 * tid) = d; *(LAS f32x4*)(a_tmp + 4 * tid) = d * A; }
      __syncthreads();
      if (4 * tid < TPAD) { const int c0 = (4 * tid) & ~63; float s = 0.f;
          for (int k = c0; k < 4 * tid; k += 4) { const f32x4 v = *(const LAS f32x4*)(a_tmp + k); s += (v[0] + v[1]) + (v[2] + v[3]); }
          f32x4 o; o[0] = s + d[0] * A; o[1] = o[0] + d[1] * A; o[2] = o[1] + d[2] * A; o[3] = o[2] + d[3] * A;
          *(LAS f32x4*)(ac_all + 4 * tid) = o; } }
    const int pt = wave >> 1, nt0 = (wave & 1) * 4;
    f32x4 hs[4];
#pragma unroll
    for (int q = 0; q < 4; ++q)
#pragma unroll
        for (int e = 0; e < 4; ++e) hs[q][e] = h0 ? h0[(size_t)(16 * pt + 4 * fq + e) * 128 + 16 * (nt0 + q) + fr] : 0.f;
    v4u pC[2], pB[2], pX;
    const v4u z4 = (v4u){0u, 0u, 0u, 0u};
#pragma unroll
    for (int q = 0; q < 2; ++q) { const int idx = tid + NTHR * q, r = idx >> 4, pc = idx & 15;
        pC[q] = (r < T) ? *(const v4u*)(XC + (size_t)(row_base + r) * 896 + 640 + g * 128 + pc * 8) : z4; pB[q] = (r < T) ? *(const v4u*)(XC + (size_t)(row_base + r) * 896 + 384 + g * 128 + pc * 8) : z4; }
    pX = ((tid >> 3) < T) ? *(const v4u*)(XC + (size_t)(row_base + (tid >> 3)) * 896 + h * 64 + (tid & 7) * 8) : z4;
    LBAR();
    for (int c = 0; c < nch; ++c) {
        const int r0 = row_base + c * 64, nv = (T - c * 64) < 64 ? (T - c * 64) : 64;
        const LAS float* acum = ac_all + c * 64; const LAS float* dtv = dt_all + c * 64;
        const float alast = acum[63];
#pragma unroll
        for (int q = 0; q < 4; ++q)
#pragma unroll
            for (int e = 0; e < 4; ++e) hb[(16 * pt + 4 * fq + e) * SD_PC + 16 * (nt0 + q) + fr] = f2bf_s(hs[q][e]);
#pragma unroll
        for (int q = 0; q < 2; ++q) { const int idx = tid + NTHR * q, r = idx >> 4, pc = idx & 15;
            *(LAS v4u*)(Cs + r * SD_PC + pc * 8) = pC[q]; *(LAS v4u*)(Bs + r * SD_PC + pc * 8) = pB[q]; }
        { const int r = tid >> 3, pc = tid & 7; const float te = __expf(alast - acum[r]) * dtv[r];
          *(LAS v4u*)(xs + r * SD_PX + pc * 8) = pX;
          v4u w; w.x = pg8::cvt_pk_bf16(bflo(pX.x) * te, bfhi(pX.x) * te); w.y = pg8::cvt_pk_bf16(bflo(pX.y) * te, bfhi(pX.y) * te); w.z = pg8::cvt_pk_bf16(bflo(pX.z) * te, bfhi(pX.z) * te); w.w = pg8::cvt_pk_bf16(bflo(pX.w) * te, bfhi(pX.w) * te);
          *(LAS v4u*)(xw + r * SD_PX + pc * 8) = w; }
        if (c + 1 < nch) { const int rn = r0 + 64, nvn = (T - (c + 1) * 64) < 64 ? (T - (c + 1) * 64) : 64;
#pragma unroll
            for (int q = 0; q < 2; ++q) { const int idx = tid + NTHR * q, r = idx >> 4, pc = idx & 15;
                pC[q] = (r < nvn) ? *(const v4u*)(XC + (size_t)(rn + r) * 896 + 640 + g * 128 + pc * 8) : z4; pB[q] = (r < nvn) ? *(const v4u*)(XC + (size_t)(rn + r) * 896 + 384 + g * 128 + pc * 8) : z4; }
            pX = ((tid >> 3) < nvn) ? *(const v4u*)(XC + (size_t)(rn + (tid >> 3)) * 896 + h * 64 + (tid & 7) * 8) : z4; }
        LBAR();
        const int lt = wave >> 1;
#pragma unroll 1
        for (int q = 0; q < 2; ++q) { const int st = (wave & 1) * 2 + q;
            f32x4 gacc = tile_mma<128>((f32x4){0.f, 0.f, 0.f, 0.f}, Cs + lt * 16 * SD_PC, SD_PC, Bs + st * 16 * SD_PC, SD_PC, lane);
            const int s = 16 * st + fr; const float as = acum[s], ds = dtv[s];
#pragma unroll
            for (int e = 0; e < 4; ++e) { const int ll = 16 * lt + 4 * fq + e; const float v = (s <= ll) ? gacc[e] * __expf(acum[ll] - as) * ds : 0.f; Sc[ll * SD_PX + s] = f2bf_s(v); } }
        LBAR();
#pragma unroll 1
        for (int q = 0; q < 2; ++q) { const int ptl = (wave & 1) * 2 + q;
            f32x4 yi = (f32x4){0.f, 0.f, 0.f, 0.f};
#pragma unroll
            for (int ks = 0; ks < 2; ++ks) yi = __builtin_amdgcn_mfma_f32_16x16x32_bf16(*(const LAS bf16x8*)(Sc + (lt * 16 + fr) * SD_PX + 32 * ks + 8 * fq), tr_frag(xs, SD_PX, 32 * ks, 16 * ptl, lane), yi, 0, 0, 0);
            const f32x4 yo = tile_mma<128>((f32x4){0.f, 0.f, 0.f, 0.f}, Cs + lt * 16 * SD_PC, SD_PC, hb + ptl * 16 * SD_PC, SD_PC, lane);
            const int p = 16 * ptl + fr;
#pragma unroll
            for (int e = 0; e < 4; ++e) { const int ll = 16 * lt + 4 * fq + e;
                if (ll < nv) YC[(size_t)(r0 + ll) * 384 + h * 64 + p] = f2bf_s(yi[e] + __expf(acum[ll]) * yo[e] + Dh * bf2f(xs[ll * SD_PX + p])); } }
        { const float cd = __expf(alast);
#pragma unroll
          for (int q = 0; q < 4; ++q) hs[q] = hs[q] * cd;
#pragma unroll
          for (int ks = 0; ks < 2; ++ks) { const bf16x8 af = tr_frag(xw, SD_PX, 32 * ks, 16 * pt, lane);
#pragma unroll
              for (int q = 0; q < 4; ++q) hs[q] = __builtin_amdgcn_mfma_f32_16x16x32_bf16(af, tr_frag(Bs, SD_PC, 32 * ks, 16 * (nt0 + q), lane), hs[q], 0, 0, 0); } }
        LBAR();
    }
#pragma unroll
    for (int q = 0; q < 4; ++q)
#pragma unroll
        for (int e = 0; e < 4; ++e) hout[(size_t)(16 * pt + 4 * fq + e) * 128 + 16 * (nt0 + q) + fr] = hs[q][e];
}

constexpr int AT_PV = 264, AT_PK = 72;
__device__ __forceinline__ void attn_prompt_unit(const KA a, int l, int su, LAS unsigned char* lds, int tid) {
    const int quarter = su & 3, bhbr = su >> 2, br = bhbr % 3, bh = bhbr / 3, b = bh / 6, h = bh - b * 6;
    const int dil = (br == 0) ? 1 : (br == 1 ? 4 : 16), nblk = 16 / dil;
    const int lane = tid & 63, wave = __builtin_amdgcn_readfirstlane(tid >> 6), fr = lane & 15, fq = lane >> 4;
    const bf16* P = (const bf16*)(a.ws() + WS_P);
    LAS bf16* VT = (LAS bf16*)lds;
    LAS bf16* KL = VT + 64 * AT_PV;
    const size_t rowb = (size_t)b * 2048;
    const int kj_s = tid >> 1, hf = tid & 1, qi = 16 * wave + fr;
    const float slope = exp2f(-8.0f * (float)(h + 1) / 6.0f) * (float)dil;
    bf16* AP = (bf16*)(a.ws() + WS_AP) + (size_t)br * TOK * 384; float* AM = (float*)(a.ws() + WS_AM) + (size_t)br * TOK * 8; float* AL = (float*)(a.ws() + WS_AL) + (size_t)br * TOK * 8;
    v4u pv[4], pk[4]; bf16x8 q0, q1;
#define AT_LOAD(cn_) do { const int cls_ = (cn_) / nblk, n_ = (cn_) - cls_ * nblk; int ks_ = (n_ - 1) * 128 + kj_s; if (ks_ < 0) ks_ = 0; \
        const bf16* src_ = P + (rowb + (size_t)ks_ * dil + cls_) * NPP + h * 64 + hf * 32; \
        _Pragma("unroll") for (int q_ = 0; q_ < 4; ++q_) { pv[q_] = *(const v4u*)(src_ + C_V + q_ * 8); pk[q_] = *(const v4u*)(src_ + C_K + q_ * 8); } \
        const bf16* qp_ = P + (rowb + (size_t)(n_ * 128 + qi) * dil + cls_) * NPP + C_Q + h * 64 + 8 * fq; q0 = *(const bf16x8*)qp_; q1 = *(const bf16x8*)(qp_ + 32); } while (0)
    AT_LOAD(quarter * 4);
#pragma unroll 1
    for (int j = 0; j < 4; ++j) {
        const int cn = quarter * 4 + j, cls = cn / nblk, n = cn - cls * nblk;
#pragma unroll
        for (int q = 0; q < 4; ++q) { *(LAS v4u*)(KL + kj_s * AT_PK + hf * 32 + q * 8) = pk[q]; const unsigned wv[4] = {pv[q].x, pv[q].y, pv[q].z, pv[q].w};
#pragma unroll
            for (int e = 0; e < 4; ++e) { VT[(hf * 32 + q * 8 + 2 * e) * AT_PV + kj_s] = (bf16)(wv[e] & 0xffffu); VT[(hf * 32 + q * 8 + 2 * e + 1) * AT_PV + kj_s] = (bf16)(wv[e] >> 16); } }
        const bf16x8 cq0 = q0, cq1 = q1;
        if (j < 3) AT_LOAD(cn + 1);
        LBAR();
        const int ktlo = (n == 0 && wave < 8) ? (8 > wave ? 8 : wave) : wave, kthi = wave + 8;
        const float sl4[4] = {0.f, slope, 2.f * slope, 3.f * slope};
#define AT_SCORE(acc_, kt_) do { const LAS bf16* kp_ = KL + (16 * (kt_) + fr) * AT_PK + 8 * fq; \
            acc_ = __builtin_amdgcn_mfma_f32_16x16x32_bf16(*(const LAS bf16x8*)kp_, cq0, (f32x4){0.f, 0.f, 0.f, 0.f}, 0, 0, 0); \
            acc_ = __builtin_amdgcn_mfma_f32_16x16x32_bf16(*(const LAS bf16x8*)(kp_ + 32), cq1, acc_, 0, 0, 0); \
            const int d0_ = 128 + qi - 16 * (kt_) - 4 * fq; const float b0_ = -slope * (float)d0_; \
            _Pragma("unroll") for (int e_ = 0; e_ < 4; ++e_) acc_[e_] = acc_[e_] * 0.125f + (b0_ + sl4[e_]); \
            if ((kt_) == wave || (kt_) == wave + 8) { _Pragma("unroll") for (int e_ = 0; e_ < 4; ++e_) { const int dl_ = d0_ - e_; if (dl_ < 0 || dl_ > 128) acc_[e_] = NEG_INF; } } } while (0)
        float m = NEG_INF;
#pragma unroll
        for (int rel = 0; rel < 9; ++rel) { const int kt = wave + rel;
            if (kt >= ktlo) { f32x4 acc; AT_SCORE(acc, kt); m = fmaxf(fmaxf(m, fmaxf(acc[0], acc[1])), fmaxf(acc[2], acc[3])); }
            if (rel & 1) asm volatile("" ::: "memory"); }
        m = pg8::xmax16(m); m = pg8::xmax32(m);
        float lsum = 0.f;
        f32x4 o[4];
#pragma unroll
        for (int dt = 0; dt < 4; ++dt) o[dt] = (f32x4){0.f, 0.f, 0.f, 0.f};
#pragma unroll
        for (int rel = 0; rel < 9; ++rel) { const int kt = wave + rel;
            if (kt >= ktlo) { f32x4 sc; AT_SCORE(sc, kt);
#pragma unroll
                for (int e = 0; e < 4; ++e) { sc[e] = __expf(sc[e] - m); lsum += sc[e]; }
                const v4i16_t pa = pack4(sc);
#pragma unroll
                for (int dt = 0; dt < 4; ++dt) { const v4i16_t vb = *(const LAS v4i16_t*)(VT + (16 * dt + fr) * AT_PV + 16 * kt + 4 * fq);
                    o[dt] = __builtin_amdgcn_mfma_f32_16x16x16bf16_1k(pa, vb, o[dt], 0, 0, 0); } }
            if (rel & 1) asm volatile("" ::: "memory"); }
#undef AT_SCORE
        lsum = pg8::xsum16(lsum); lsum = pg8::xsum32(lsum);
#pragma unroll
        for (int e = 0; e < 4; ++e) { const int qq = 16 * wave + 4 * fq + e; const size_t row = rowb + (size_t)(n * 128 + qq) * dil + cls;
#pragma unroll
            for (int dt = 0; dt < 4; ++dt) AP[row * 384 + h * 64 + 16 * dt + fr] = f2bf_s(o[dt][e]); }
        if (fq == 0) { const size_t row = rowb + (size_t)(n * 128 + qi) * dil + cls; AM[row * 8 + h] = m; AL[row * 8 + h] = lsum; }
        LBAR();
    }
#undef AT_LOAD
}

PHASE_FN __device__ void attn_sample_task(const KA a, int l, int task0, LAS unsigned char* lds, int tid) {
    const int lane = tid & 63, wave = __builtin_amdgcn_readfirstlane(tid >> 6), task = task0 + wave;
    const int t = task & 3, bh = task >> 2, b = bh / 6, h = bh - b * 6;
    const bf16* P = (const bf16*)(a.ws() + WS_P);
    const float* ck = a.in(2) + ((size_t)(l * 32 + b) * 2048) * 384 + h * 64; const float* cv = a.in(3) + ((size_t)(l * 32 + b) * 2048) * 384 + h * 64;
    const int row = TP + b * 4 + t;
    LAS float* pl = (LAS float*)lds + wave * 512;
    LAS float* q = pl + 448;
    q[lane] = bf2f(P[(size_t)row * NPP + C_Q + h * 64 + lane]) * 0.125f;
    asm volatile("s_waitcnt lgkmcnt(0)" ::: "memory");
    const float slope = exp2f(-8.0f * (float)(h + 1) / 6.0f);
    float m = NEG_INF;
#pragma unroll 1
    for (int ps = 0; ps < 7; ++ps) {
        const int e = ps * 64 + lane; float v = NEG_INF;
        if (e < 387) { const int br = e / 129, st = e - br * 129, dil = (br == 0) ? 1 : (br == 1 ? 4 : 16), idx = 2048 + t - dil * st;
            float dot = 0.f;
            if (idx >= 2048) { const bf16* kp = P + (size_t)(TP + b * 4 + (idx - 2048)) * NPP + C_K + h * 64;
#pragma unroll
                for (int i = 0; i < 8; ++i) { const v4u w = *(const v4u*)(kp + i * 8); const f32x4 qa = *(const LAS f32x4*)(q + 8 * i), qb = *(const LAS f32x4*)(q + 8 * i + 4); dot += qa[0] * bflo(w.x) + qa[1] * bfhi(w.x) + qa[2] * bflo(w.y) + qa[3] * bfhi(w.y) + qb[0] * bflo(w.z) + qb[1] * bfhi(w.z) + qb[2] * bflo(w.w) + qb[3] * bfhi(w.w); } }
            else { const float* kp = ck + (size_t)idx * 384;
#pragma unroll
                for (int i = 0; i < 8; ++i) { const f32x4 w = *(const f32x4*)(kp + 4 * i); const f32x4 qa = *(const LAS f32x4*)(q + 4 * i); dot += qa[0] * w[0] + qa[1] * w[1] + qa[2] * w[2] + qa[3] * w[3]; }
#pragma unroll
                for (int i = 8; i < 16; ++i) { const f32x4 w = *(const f32x4*)(kp + 4 * i); const f32x4 qa = *(const LAS f32x4*)(q + 4 * i); dot += qa[0] * w[0] + qa[1] * w[1] + qa[2] * w[2] + qa[3] * w[3]; } }
            v = dot - slope * (float)(dil * st); }
        pl[e] = v; m = fmaxf(m, v);
    }
    m = wave_max(m);
    float ls = 0.f;
#pragma unroll
    for (int ps = 0; ps < 7; ++ps) { const float p = __expf(pl[ps * 64 + lane] - m); ls += p; pl[ps * 64 + lane] = p; }
    ls = wave_sum(ls);
    asm volatile("s_waitcnt lgkmcnt(0)" ::: "memory");
    float acc = 0.f;
    const bf16* pvn = P + (size_t)(TP + b * 4) * NPP + C_V + h * 64 + lane;
#pragma unroll 1
    for (int br = 0; br < 3; ++br) { const int dil = (br == 0) ? 1 : (br == 1 ? 4 : 16); const LAS float* pb = pl + br * 129;
#pragma unroll 1
        for (int s0 = 0; s0 < 128; s0 += 32) { float vv[32];
#pragma unroll
            for (int j = 0; j < 32; ++j) { const int idx = 2048 + t - dil * (s0 + j);
                vv[j] = (idx >= 2048) ? bf2f(pvn[(size_t)(idx - 2048) * NPP]) : cv[(size_t)idx * 384 + lane]; }
#pragma unroll
            for (int j = 0; j < 32; ++j) acc += pb[s0 + j] * vv[j]; }
        { const int idx = 2048 + t - dil * 128; acc += pb[128] * cv[(size_t)idx * 384 + lane]; } }
    bf16* AP = (bf16*)(a.ws() + WS_AP); float* AM = (float*)(a.ws() + WS_AM); float* AL = (float*)(a.ws() + WS_AL);
    AP[(size_t)row * 384 + h * 64 + lane] = f2bf_s(acc); AP[((size_t)TOK + row) * 384 + h * 64 + lane] = 0; AP[((size_t)2 * TOK + row) * 384 + h * 64 + lane] = 0;
    if (lane == 0) { AM[(size_t)row * 8 + h] = m; AL[(size_t)row * 8 + h] = ls; AM[((size_t)TOK + row) * 8 + h] = NEG_INF; AL[((size_t)TOK + row) * 8 + h] = 0.f; AM[((size_t)2 * TOK + row) * 8 + h] = NEG_INF; AL[((size_t)2 * TOK + row) * 8 + h] = 0.f; }
}

PHASE_FN __device__ void post_rwkv(const KA a, int l, int tid) {
    const int lane = tid & 63, gw = blockIdx.x * NWAVES + __builtin_amdgcn_readfirstlane(tid >> 6); int NGW = gridDim.x * NWAVES; asm volatile("" : "+s"(NGW));
    const float* YS = (const float*)(a.ws() + WS_YS); const unsigned char* REC = a.ws() + WS_REC; const float* SC = (const float*)(a.ws() + WS_SC); const float* G = (const float*)(a.ws() + WS_G);
    bf16* YM = (bf16*)(a.ws() + WS_YM);
    float lw[4], lb[4];
#pragma unroll
    for (int hh = 0; hh < 4; ++hh) { lw[hh] = a.in(23)[l * 256 + hh * 64 + lane]; lb[hh] = a.in(24)[l * 256 + hh * 64 + lane]; }
    for (int row0 = gw * 2; row0 < TOK; row0 += 2 * NGW) {
        float v[2][4], ys[2][4], g[2][4], kr[2][4], bon[2][4];
#pragma unroll
        for (int r = 0; r < 2; ++r)
#pragma unroll
            for (int hh = 0; hh < 4; ++hh) { const int row = row0 + r, c = hh * 64 + lane;
                v[r][hh] = bf2f(*(const bf16*)(REC + (size_t)((row >> 4) * 4 + hh) * REC_BYTES + 8192 + ((row & 15) * 64 + lane) * 2)); ys[r][hh] = YS[(size_t)row * 256 + c]; g[r][hh] = G[(size_t)row * 256 + c];
                kr[r][hh] = SC[(size_t)(row * 4 + hh) * 2]; bon[r][hh] = SC[(size_t)(row * 4 + hh) * 2 + 1]; }
#pragma unroll
        for (int r = 0; r < 2; ++r)
#pragma unroll
            for (int hh = 0; hh < 4; ++hh) { const float y = ys[r][hh] + v[r][hh] * kr[r][hh];
                const float mu = wave_sum(y) * (1.f / 64.f), d = y - mu, var = wave_sum(d * d) * (1.f / 64.f);
                const float yn = d * rsqrtf(var + GN_EPS) * lw[hh] + lb[hh];
                YM[(size_t)(row0 + r) * D + hh * 64 + lane] = f2bf_s((yn + bon[r][hh] * v[r][hh]) * g[r][hh]); }
    }
}
PHASE_FN __device__ void post_att(const KA a, int l, int tid) {
    const int lane = tid & 63, gw = blockIdx.x * NWAVES + __builtin_amdgcn_readfirstlane(tid >> 6); int NGW = gridDim.x * NWAVES; asm volatile("" : "+s"(NGW));
    const bf16* AP = (const bf16*)(a.ws() + WS_AP); const float* AM = (const float*)(a.ws() + WS_AM); const float* AL = (const float*)(a.ws() + WS_AL); bf16* YM = (bf16*)(a.ws() + WS_YM);
    float nw[6];
#pragma unroll
    for (int hd = 0; hd < 6; ++hd) nw[hd] = a.in(25)[l * 384 + hd * 64 + lane];
    for (int row0 = gw * 2; row0 < TOK; row0 += 2 * NGW) {
        float ap[2][3][6], am[2][3], al[2][3];
#pragma unroll
        for (int r = 0; r < 2; ++r)
#pragma unroll
            for (int br = 0; br < 3; ++br) { const size_t rb = (size_t)br * TOK + row0 + r;
                am[r][br] = AM[rb * 8 + (lane & 7)]; al[r][br] = AL[rb * 8 + (lane & 7)];
#pragma unroll
                for (int hd = 0; hd < 6; ++hd) ap[r][br][hd] = bf2f(AP[rb * 384 + hd * 64 + lane]); }
#pragma unroll
        for (int r = 0; r < 2; ++r) {
            const float M = fmaxf(am[r][0], fmaxf(am[r][1], am[r][2]));
            const float e0 = __expf(am[r][0] - M), e1 = __expf(am[r][1] - M), e2 = __expf(am[r][2] - M);
            const float inv = 1.0f / (e0 * al[r][0] + e1 * al[r][1] + e2 * al[r][2]);
            float ob[6], ss = 0.f;
#pragma unroll
            for (int hd = 0; hd < 6; ++hd) { const float w0 = __uint_as_float(__builtin_amdgcn_readlane(__float_as_uint(e0 * inv), hd));
                const float w1 = __uint_as_float(__builtin_amdgcn_readlane(__float_as_uint(e1 * inv), hd)), w2 = __uint_as_float(__builtin_amdgcn_readlane(__float_as_uint(e2 * inv), hd));
                ob[hd] = w0 * ap[r][0][hd] + w1 * ap[r][1][hd] + w2 * ap[r][2][hd]; ss += ob[hd] * ob[hd]; }
            ss = wave_sum(ss); const float rs = rsqrtf(ss * (1.f / 384.f) + NORM_EPS);
#pragma unroll
            for (int hd = 0; hd < 6; ++hd) YM[(size_t)(row0 + r) * D + 256 + hd * 64 + lane] = f2bf_s(ob[hd] * rs * nw[hd]);
        }
    }
}
PHASE_FN __device__ void post_ssd(const KA a, int l, int tid) {
    const int lane = tid & 63, gw = blockIdx.x * NWAVES + __builtin_amdgcn_readfirstlane(tid >> 6); int NGW = gridDim.x * NWAVES; asm volatile("" : "+s"(NGW));
    const bf16* YC = (const bf16*)(a.ws() + WS_YC); const bf16* P = (const bf16*)(a.ws() + WS_P); bf16* YM = (bf16*)(a.ws() + WS_YM);
    float nw[6];
#pragma unroll
    for (int hd = 0; hd < 6; ++hd) nw[hd] = a.in(31)[l * 384 + hd * 64 + lane];
    for (int row0 = gw * 2; row0 < TOK; row0 += 2 * NGW) {
        float yc[2][6], z[2][6];
#pragma unroll
        for (int r = 0; r < 2; ++r)
#pragma unroll
            for (int hd = 0; hd < 6; ++hd) { yc[r][hd] = bf2f(YC[(size_t)(row0 + r) * 384 + hd * 64 + lane]); z[r][hd] = bf2f(P[(size_t)(row0 + r) * NPP + C_Z + hd * 64 + lane]); }
#pragma unroll
        for (int r = 0; r < 2; ++r) { float ob[6], ss = 0.f;
#pragma unroll
            for (int hd = 0; hd < 6; ++hd) { ob[hd] = yc[r][hd] * (z[r][hd] * sigmoidf_(z[r][hd])); ss += ob[hd] * ob[hd]; }
            ss = wave_sum(ss); const float rs = rsqrtf(ss * (1.f / 384.f) + NORM_EPS);
#pragma unroll
            for (int hd = 0; hd < 6; ++hd) YM[(size_t)(row0 + r) * D + 640 + hd * 64 + lane] = f2bf_s(ob[hd] * rs * nw[hd]); }
    }
}
PHASE_FN __device__ void final_rows(const KA a, int tid) {
    const int lane = tid & 63, gw = blockIdx.x * NWAVES + __builtin_amdgcn_readfirstlane(tid >> 6); int NGW = gridDim.x * NWAVES; asm volatile("" : "+s"(NGW));
    const float* X = (const float*)(a.ws() + WS_X); const float* SSQ = (const float*)(a.ws() + WS_SSQ);
    for (int row = gw; row < TOK; row += NGW) {
        const float rs = pg8::row_rstd(SSQ, row);
        float* dst = (row < TP) ? a.out() + O_YP + (size_t)row * D : a.out() + O_YS + (size_t)(row - TP) * D;
#pragma unroll
        for (int j = 0; j < 4; ++j) { const f32x4 v = ((const f32x4*)(X + (size_t)row * D))[lane + 64 * j], w = ((const f32x4*)a.in(37))[lane + 64 * j]; ((f32x4*)dst)[lane + 64 * j] = v * rs * w; }
    }
}

constexpr int Q_SCAN = 32, Q_SSD = Q_SCAN + 48, Q_ATS = Q_SSD + 96, Q_ATT = Q_ATS + 576, Q_SCS = Q_ATT + 128, NU_MIX = Q_SCS + 192;
#ifndef REP_MIX
#define REP_MIX 1
#endif
#ifndef REP_PP
#define REP_PP 1
#endif
#ifndef REP_G
#define REP_G 1
#endif
#ifndef DUP_MASK
#define DUP_MASK 0
#endif
#ifndef REP_PRO
#define REP_PRO 1
#endif
#ifndef REP_R
#define REP_R 1
#endif

template <int KSTEPS> PHASE_FN __device__ void skinny_res(const KA a, size_t a_off, size_t b_off, float scale, int write_f32, LAS unsigned char* lds, int tid) {
    constexpr int K = KSTEPS * 32 * 4;
    const int lane = tid & 63, wave = __builtin_amdgcn_readfirstlane(tid >> 6), fr = lane & 15, fq = lane >> 4, ct = wave & 1, kq = wave >> 1;
    const bf16* A = (const bf16*)(a.ws() + a_off); const bf16* Bt = (const bf16*)(a.ws() + b_off);
    float* X = (float*)(a.ws() + WS_X); bf16* XB = (bf16*)(a.ws() + WS_XB); float* SSQ = (float*)(a.ws() + WS_SSQ);
    LAS f32x4* red = (LAS f32x4*)lds;
    for (int piece = blockIdx.x; piece < 256; piece += gridDim.x) {
        const int rt = piece >> 5, cg = piece & 31;
        const bf16* ap = A + (size_t)(TP + rt * 16 + fr) * K + kq * (K / 4) + 8 * fq; const bf16* wp = Bt + (size_t)(cg * 32 + ct * 16 + fr) * K + kq * (K / 4) + 8 * fq;
        f32x4 acc = (f32x4){0.f, 0.f, 0.f, 0.f};
#pragma unroll
        for (int ks = 0; ks < KSTEPS; ++ks) acc = __builtin_amdgcn_mfma_f32_16x16x32_bf16(*(const bf16x8*)(wp + 32 * ks), *(const bf16x8*)(ap + 32 * ks), acc, 0, 0, 0);
        red[wave * 64 + lane] = acc;
        __syncthreads();
        if (kq == 0) {
            acc = (red[ct * 64 + lane] + red[(ct + 2) * 64 + lane]) + (red[(ct + 4) * 64 + lane] + red[(ct + 6) * 64 + lane]);
            const int rl = rt * 16 + fr, row = TP + rl, c0 = cg * 32 + ct * 16 + 4 * fq;
            const f32x4 x = up4(*(const v2u*)(XB + (size_t)row * D + c0)) + acc * scale; if (write_f32) *(f32x4*)(X + (size_t)row * D + c0) = x;
            v2u w; w.x = pg8::cvt_pk_bf16(x[0], x[1]); w.y = pg8::cvt_pk_bf16(x[2], x[3]); *(v2u*)(XB + (size_t)row * D + c0) = w;
            float ss = (x[0] * x[0] + x[1] * x[1]) + (x[2] * x[2] + x[3] * x[3]); ss = pg8::xsum16(ss); ss = pg8::xsum32(ss);
            if (fq == 0) SSQ[pg8::SSQS_OFF + (size_t)rl * 64 + cg * 2 + ct] = ss;
        }
        __syncthreads();
    }
}
#define WT_REM0 ((gridDim.x == 256) ? WT_ITEMS : 0)
#define MIX_PHASE(QREP) \
        for (;;) { \
            { WSL(w); if (fresh_tid() == 0) MISC[0] = __hip_atomic_fetch_add((unsigned*)((gu32*)(w + WS_CTL) + CW_Q + 64 * (l + 4 * (QREP))), 1u, __ATOMIC_RELAXED, __HIP_MEMORY_SCOPE_AGENT); } \
            __syncthreads(); \
            const int u = (int)MISC[0]; \
            __syncthreads(); \
            if (u >= NU_MIX + ((l < DEPTH - 1) ? (I_LAYER - WT_REM0) / 8 : 0)) break; \
            if (u < Q_SCAN) { rwkv_scan_unit(make_ka(), l, u, lds, fresh_tid()); if (DUP_MASK & 1) { __syncthreads(); rwkv_scan_unit(make_ka(), l, u, lds, fresh_tid()); } } \
            else if (u < Q_SSD) { ssd_unit(make_ka(), l, u - Q_SCAN, lds, fresh_tid()); if (DUP_MASK & 2) { __syncthreads(); ssd_unit(make_ka(), l, u - Q_SCAN, lds, fresh_tid()); } } \
            else if (u < Q_ATS) { attn_sample_task(make_ka(), l, (u - Q_SSD) * 8, lds, fresh_tid()); if (DUP_MASK & 4) { __syncthreads(); attn_sample_task(make_ka(), l, (u - Q_SSD) * 8, lds, fresh_tid()); } } \
            else if (u < Q_ATT) { attn_prompt_unit(make_ka(), l, u - Q_ATS, lds, fresh_tid()); if (DUP_MASK & 8) { __syncthreads(); attn_prompt_unit(make_ka(), l, u - Q_ATS, lds, fresh_tid()); } } \
            else if (u < Q_SCS) { rwkv_scan_unit(make_ka(), l, 32 + (u - Q_ATT), lds, fresh_tid()); if (DUP_MASK & 16) { __syncthreads(); rwkv_scan_unit(make_ka(), l, 32 + (u - Q_ATT), lds, fresh_tid()); } } \
            else if (u < NU_MIX) { ssd_unit(make_ka(), l, 48 + (u - Q_SCS), lds, fresh_tid()); if (DUP_MASK & 32) { __syncthreads(); ssd_unit(make_ka(), l, 48 + (u - Q_SCS), lds, fresh_tid()); } } \
            else wconv_unit(make_ka(), l + 1, u - NU_MIX + WT_REM0 / 8, lds, fresh_tid()); \
        } \
        GRID_BAR();
__global__ void __launch_bounds__(NTHR, 2) hymba_fwd(KArgs args) {
    extern __shared__ __attribute__((aligned(16))) unsigned char lds_raw[];
    LAS unsigned char* lds = (LAS unsigned char*)lds_raw;
    volatile LAS unsigned* MISC = (volatile LAS unsigned*)(lds + MISC_OFF);
    { const int tid = threadIdx.x; for (int u = tid; u < (LDS_BYTES - LDSCTL_OFF) / 4; u += NTHR) ((LAS unsigned*)(lds + LDSCTL_OFF))[u] = 0u; }
    __syncthreads();
    XcdBarrier bar = xcd_barrier_post((unsigned*)((gu32*)(args.ws + WS_CTL) + CW_BAR), MISC + 8);
#define GRID_BAR() do { XcdBarrier b_ = bar; asm volatile("" : "+s"(b_.bar), "+s"(b_.x)); xcd_barrier(b_); } while (0)
#define WSL(name) unsigned char* name = make_ka().ws()
#define GL(name) int name = gridDim.x; asm volatile("" : "+s"(name)); int bx_ = blockIdx.x; asm volatile("" : "+s"(bx_))

#ifndef NO_PRO
    p0_prologue(make_ka(), lds, fresh_tid()); p0_xinit(make_ka(), fresh_tid());
#endif
    GRID_BAR();
#if REP_PRO > 1
    p0_prologue(make_ka(), lds, fresh_tid()); p0_xinit(make_ka(), fresh_tid());
    GRID_BAR();
#endif
    for (int l = 0; l < DEPTH; ++l) {
        { WSL(w); GL(G); pg8::Gemm g{(const bf16*)(w + WS_XB), (const bf16*)(w + WS_W + (size_t)l * WL_SIZE + WL_GU1), MP, 2 * FF, D}; pg8::StaticOrder S; S.init(MP, 2 * FF, G, bx_, WGM_GU); pg8::EpiGU E{(bf16*)(w + WS_H), (const float*)(w + WS_SSQ)};
          pg8::gemm_phase<pg8::EpiGU, pg8::StaticOrder, true, true>(lds, g, S, E); }
        if (l < DEPTH - 1) wconv_tail(make_ka(), l + 1, 0, lds, fresh_tid());
        GRID_BAR();
#if REP_G > 1
        { WSL(w); GL(G); pg8::Gemm g{(const bf16*)(w + WS_XB), (const bf16*)(w + WS_W + (size_t)l * WL_SIZE + WL_GU1), MP, 2 * FF, D}; pg8::StaticOrder S; S.init(MP, 2 * FF, G, bx_, WGM_GU); pg8::EpiGU E{(bf16*)(w + WS_H), (const float*)(w + WS_SSQ)};
          pg8::gemm_phase<pg8::EpiGU, pg8::StaticOrder, true, true>(lds, g, S, E); }
        GRID_BAR();
#endif
        skinny_res<22>(make_ka(), WS_H, WS_W + (size_t)l * WL_SIZE + WL_D1, 0.5f, 0, lds, fresh_tid());
        { WSL(w); GL(G); pg8::Gemm g{(const bf16*)(w + WS_H), (const bf16*)(w + WS_W + (size_t)l * WL_SIZE + WL_D1), TP, D, FF}; pg8::StaticOrder S; S.init(TP, D, G, bx_, WGM_R); pg8::EpiRes E{(float*)nullptr, (bf16*)(w + WS_XB), (float*)(w + WS_SSQ), 0.5f};
          pg8::gemm_phase<pg8::EpiRes, pg8::StaticOrder, true, true>(lds, g, S, E); }
        GRID_BAR();
#if REP_R > 1
        skinny_res<22>(make_ka(), WS_H, WS_W + (size_t)l * WL_SIZE + WL_D1, 0.0f, 0, lds, fresh_tid());
        { WSL(w); GL(G); pg8::Gemm g{(const bf16*)(w + WS_H), (const bf16*)(w + WS_W + (size_t)l * WL_SIZE + WL_D1), TP, D, FF}; pg8::StaticOrder S; S.init(TP, D, G, bx_, WGM_R); pg8::EpiRes E{(float*)nullptr, (bf16*)(w + WS_XB), (float*)(w + WS_SSQ), 0.0f};
          pg8::gemm_phase<pg8::EpiRes, pg8::StaticOrder, true, true>(lds, g, S, E); }
        GRID_BAR();
#endif
        { WSL(w); GL(G); pg8::Gemm g{(const bf16*)(w + WS_XB), (const bf16*)(w + WS_W + (size_t)l * WL_SIZE + WL_IN), MP, NPP, D}; pg8::StaticOrder S; S.init(MP, NPP, G, bx_, WGM_IN); pg8::EpiIn E{(bf16*)(w + WS_P), (const float*)(w + WS_SSQ)};
          pg8::gemm_phase<pg8::EpiIn, pg8::StaticOrder, true, true>(lds, g, S, E); }
        if (l < DEPTH - 1) wconv_tail(make_ka(), l + 1, 1, lds, fresh_tid());
        GRID_BAR();
#if REP_G > 1
        { WSL(w); GL(G); pg8::Gemm g{(const bf16*)(w + WS_XB), (const bf16*)(w + WS_W + (size_t)l * WL_SIZE + WL_IN), MP, NPP, D}; pg8::StaticOrder S; S.init(MP, NPP, G, bx_, WGM_IN); pg8::EpiIn E{(bf16*)(w + WS_P), (const float*)(w + WS_SSQ)};
          pg8::gemm_phase<pg8::EpiIn, pg8::StaticOrder, true, true>(lds, g, S, E); }
        GRID_BAR();
#endif
#ifndef NO_PREP
        rwkv_prep(make_ka(), l, lds, fresh_tid());
#endif
#ifndef NO_PREPE
        prep_elementwise(make_ka(), l, fresh_tid());
#endif
        GRID_BAR();
#if REP_PP > 1
        rwkv_prep(make_ka(), l, lds, fresh_tid());
        prep_elementwise(make_ka(), l, fresh_tid());
        GRID_BAR();
#endif
        MIX_PHASE(0)
#if REP_MIX > 1
        MIX_PHASE(1)
#endif
#ifndef NO_POST
        post_rwkv(make_ka(), l, fresh_tid()); post_att(make_ka(), l, fresh_tid()); post_ssd(make_ka(), l, fresh_tid());
#endif
        GRID_BAR();
#if REP_PP > 1
        post_rwkv(make_ka(), l, fresh_tid()); post_att(make_ka(), l, fresh_tid()); post_ssd(make_ka(), l, fresh_tid());
        GRID_BAR();
#endif
        skinny_res<8>(make_ka(), WS_YM, WS_W + (size_t)l * WL_SIZE + WL_OUT, 1.0f, 0, lds, fresh_tid());
        { WSL(w); GL(G); pg8::Gemm g{(const bf16*)(w + WS_YM), (const bf16*)(w + WS_W + (size_t)l * WL_SIZE + WL_OUT), TP, D, D}; pg8::StaticOrder S; S.init(TP, D, G, bx_, WGM_R); pg8::EpiRes E{(float*)nullptr, (bf16*)(w + WS_XB), (float*)(w + WS_SSQ), 1.0f};
          pg8::gemm_phase<pg8::EpiRes, pg8::StaticOrder, true, true>(lds, g, S, E); }
        GRID_BAR();
#if REP_R > 1
        skinny_res<8>(make_ka(), WS_YM, WS_W + (size_t)l * WL_SIZE + WL_OUT, 0.0f, 0, lds, fresh_tid());
        { WSL(w); GL(G); pg8::Gemm g{(const bf16*)(w + WS_YM), (const bf16*)(w + WS_W + (size_t)l * WL_SIZE + WL_OUT), TP, D, D}; pg8::StaticOrder S; S.init(TP, D, G, bx_, WGM_R); pg8::EpiRes E{(float*)nullptr, (bf16*)(w + WS_XB), (float*)(w + WS_SSQ), 0.0f};
          pg8::gemm_phase<pg8::EpiRes, pg8::StaticOrder, true, true>(lds, g, S, E); }
        GRID_BAR();
#endif
        { WSL(w); GL(G); pg8::Gemm g{(const bf16*)(w + WS_XB), (const bf16*)(w + WS_W + (size_t)l * WL_SIZE + WL_GU2), MP, 2 * FF, D}; pg8::StaticOrder S; S.init(MP, 2 * FF, G, bx_, WGM_GU); pg8::EpiGU E{(bf16*)(w + WS_H), (const float*)(w + WS_SSQ)};
          pg8::gemm_phase<pg8::EpiGU, pg8::StaticOrder, true, true>(lds, g, S, E); }
        if (l < DEPTH - 1) wconv_tail(make_ka(), l + 1, 2, lds, fresh_tid());
        GRID_BAR();
#if REP_G > 1
        { WSL(w); GL(G); pg8::Gemm g{(const bf16*)(w + WS_XB), (const bf16*)(w + WS_W + (size_t)l * WL_SIZE + WL_GU2), MP, 2 * FF, D}; pg8::StaticOrder S; S.init(MP, 2 * FF, G, bx_, WGM_GU); pg8::EpiGU E{(bf16*)(w + WS_H), (const float*)(w + WS_SSQ)};
          pg8::gemm_phase<pg8::EpiGU, pg8::StaticOrder, true, true>(lds, g, S, E); }
        GRID_BAR();
#endif
        skinny_res<22>(make_ka(), WS_H, WS_W + (size_t)l * WL_SIZE + WL_D2, 0.5f, (l == DEPTH - 1) ? 1 : 0, lds, fresh_tid());
        { WSL(w); GL(G); pg8::Gemm g{(const bf16*)(w + WS_H), (const bf16*)(w + WS_W + (size_t)l * WL_SIZE + WL_D2), TP, D, FF}; pg8::StaticOrder S; S.init(TP, D, G, bx_, WGM_R); pg8::EpiRes E{((l == DEPTH - 1) ? (float*)(w + WS_X) : (float*)nullptr), (bf16*)(w + WS_XB), (float*)(w + WS_SSQ), 0.5f};
          pg8::gemm_phase<pg8::EpiRes, pg8::StaticOrder, true, true>(lds, g, S, E); }
        GRID_BAR();
#if REP_R > 1
        skinny_res<22>(make_ka(), WS_H, WS_W + (size_t)l * WL_SIZE + WL_D2, 0.0f, (l == DEPTH - 1) ? 1 : 0, lds, fresh_tid());
        { WSL(w); GL(G); pg8::Gemm g{(const bf16*)(w + WS_H), (const bf16*)(w + WS_W + (size_t)l * WL_SIZE + WL_D2), TP, D, FF}; pg8::StaticOrder S; S.init(TP, D, G, bx_, WGM_R); pg8::EpiRes E{((l == DEPTH - 1) ? (float*)(w + WS_X) : (float*)nullptr), (bf16*)(w + WS_XB), (float*)(w + WS_SSQ), 0.0f};
          pg8::gemm_phase<pg8::EpiRes, pg8::StaticOrder, true, true>(lds, g, S, E); }
        GRID_BAR();
#endif
    }
    final_rows(make_ka(), fresh_tid());
}

extern "C" void kernel_launch(void* const* d_in, const int* in_sizes, int n_in, void* d_out, int out_size, void* d_ws, size_t ws_size, hipStream_t stream) {
    static int grid = 0;
    if (grid == 0) {
        if (n_in != 38 || (size_t)out_size != O_END || ws_size < WS_END) { fprintf(stderr, "kernel_launch: unexpected shapes: n_in %d out %d ws %zu\n", n_in, out_size, ws_size); grid = -1; return; }
        int dev = 0, cus = 0, per_cu = 0;
        if (hipGetDevice(&dev) != hipSuccess || hipDeviceGetAttribute(&cus, hipDeviceAttributeMultiprocessorCount, dev) != hipSuccess) { grid = -1; return; }
        if (hipFuncSetAttribute((const void*)hymba_fwd, hipFuncAttributeMaxDynamicSharedMemorySize, LDS_BYTES) != hipSuccess) { fprintf(stderr, "kernel_launch: hipFuncSetAttribute failed\n"); grid = -1; return; }
        if (hipOccupancyMaxActiveBlocksPerMultiprocessor(&per_cu, (const void*)hymba_fwd, NTHR, LDS_BYTES) != hipSuccess || per_cu < 1) { fprintf(stderr, "kernel_launch: occupancy query says %d\n", per_cu); }
        (void)hipGetLastError();
        grid = cus;
    }
    if (grid < 0) return;
    if (hipMemsetAsync((char*)d_ws + WS_CTL, 0, CTL_ZERO_BYTES, stream) != hipSuccess) return;
    KArgs a{};
    for (int i = 0; i < 38; ++i) a.in[i] = (const float*)d_in[i];
    a.out = (float*)d_out; a.ws = (unsigned char*)d_ws;
    hipLaunchKernelGGL(hymba_fwd, dim3(grid), dim3(NTHR), LDS_BYTES, stream, a);
}
```

```cpp
#include <hip/hip_runtime.h>
#include <cstdio>
#include <cstdint>
namespace pg8 {
#define PG8_LAS __attribute__((address_space(3)))
typedef unsigned short bf16_t;
typedef short bf16x8 __attribute__((ext_vector_type(8)));
typedef float f32x4 __attribute__((ext_vector_type(4)));
typedef unsigned u32x4 __attribute__((ext_vector_type(4)));
constexpr int BM = 256, BK = 64, HALF = 128, HTB = HALF * BK * 2  , STAGE_BYTES = 8 * HTB, NXCD = 8, WGM = 4;

__host__ __device__ __forceinline__ int lds_byte(int r, int c) { const int st = (r >> 4) * 2 + (c >> 5), rr = r & 15, cc = c & 31, ob = rr * 64 + cc * 2; return st * 1024 + (ob ^ (((ob >> 9) & 1) << 5)); }
__host__ __device__ __forceinline__ void stage_rc(int b, int& R, int& C) { const int st = b / 1024, sb = b % 1024, swz = sb ^ (((sb >> 9) & 1) << 5); R = (st >> 1) * 16 + swz / 64; C = (st & 1) * 32 + (swz % 64) / 2; }
__host__ __device__ __forceinline__ int perm32(int rho) { const int n = rho >> 4, i = rho & 15; return 8 * (i >> 2) + 4 * n + (i & 3); }

struct Unit { int pm, pn; };
struct Gemm { const bf16_t* A; const bf16_t* Bt; int M, N, K; };

struct StaticOrder {
    int nM, nN, nwg, G, c, wgm;
    __host__ __device__ void init(int M, int N, int G_, int c_, int wgm_ = WGM) { nM = M / BM; nN = N / BM; nwg = nM * nN; G = G_; c = c_; wgm = wgm_; }
    __host__ __device__ bool next(int i, Unit& u) const {
        const long L = (long)i * G + c; if (L >= nwg) return false;
        int wgid = (int)L; { const int q = nwg / NXCD, r = nwg % NXCD, xcd = wgid % NXCD, off = wgid / NXCD; wgid = (xcd < r ? xcd * (q + 1) : r * (q + 1) + (xcd - r) * q) + off; }
        const int nig = wgm * nN, gid = wgid / nig, fm = gid * wgm, gsz = (nM - fm) < wgm ? (nM - fm) : wgm;
        u.pm = fm + ((wgid % nig) % gsz); u.pn = (wgid % nig) / gsz; return true;
    }
    __device__ __forceinline__ void a_ready(const Unit&) const {}
    __device__ __forceinline__ void done(const Unit&) const {}
};

typedef __bf16 bf2c_t __attribute__((ext_vector_type(2))); typedef float f2c_t __attribute__((ext_vector_type(2)));
__device__ __forceinline__ unsigned cvt_pk_bf16(float lo, float hi) { const f2c_t v = {lo, hi}; return __builtin_bit_cast(unsigned, __builtin_convertvector(v, bf2c_t)); }
typedef float f32x2 __attribute__((ext_vector_type(2)));

typedef unsigned u32x2 __attribute__((ext_vector_type(2)));
__device__ __forceinline__ float xsum16(float v) { const auto r = __builtin_amdgcn_permlane16_swap(__float_as_uint(v), __float_as_uint(v), false, false); return __uint_as_float(r[0]) + __uint_as_float(r[1]); }
__device__ __forceinline__ float xsum32(float v) { const auto r = __builtin_amdgcn_permlane32_swap(__float_as_uint(v), __float_as_uint(v), false, false); return __uint_as_float(r[0]) + __uint_as_float(r[1]); }
__device__ __forceinline__ float xmax16(float v) { const auto r = __builtin_amdgcn_permlane16_swap(__float_as_uint(v), __float_as_uint(v), false, false); return fmaxf(__uint_as_float(r[0]), __uint_as_float(r[1])); }
__device__ __forceinline__ float xmax32(float v) { const auto r = __builtin_amdgcn_permlane32_swap(__float_as_uint(v), __float_as_uint(v), false, false); return fmaxf(__uint_as_float(r[0]), __uint_as_float(r[1])); }
constexpr int E_FF = 2816, E_NPP = 3584, E_D = 1024;
constexpr int SSQS_OFF = 524288;
__device__ __forceinline__ float row_rstd(const float* ssq, int row) {
    float t;
    if (row < 16384) { const f32x4* sp = (const f32x4*)(ssq + (size_t)row * 16); const f32x4 s = (sp[0] + sp[1]) + (sp[2] + sp[3]); t = (s[0] + s[1]) + (s[2] + s[3]); }
    else { const f32x4* sp = (const f32x4*)(ssq + SSQS_OFF + (size_t)(row - 16384) * 64); f32x4 s = sp[0];
#pragma unroll
        for (int i = 1; i < 16; ++i) s += sp[i];
        t = (s[0] + s[1]) + (s[2] + s[3]); }
    return __builtin_amdgcn_rsqf(t * (1.0f / 1024.0f) + 1e-6f);
}
__device__ __forceinline__ float silu_f(float g) { return g * __builtin_amdgcn_rcpf(1.0f + __builtin_amdgcn_exp2f(-1.4426950408889634f * g)); }
__device__ __forceinline__ float row_rstd_coop(const float* ssq, int row, int fq) {
    float t;
    if (row < 16384) { const f32x4 s = ((const f32x4*)(ssq + (size_t)row * 16))[fq]; t = (s[0] + s[1]) + (s[2] + s[3]); }
    else { const f32x4* sp = (const f32x4*)(ssq + SSQS_OFF + (size_t)(row - 16384) * 64) + 4 * fq; const f32x4 s = (sp[0] + sp[1]) + (sp[2] + sp[3]); t = (s[0] + s[1]) + (s[2] + s[3]); }
    t = xsum16(t); t = xsum32(t);
    return __builtin_amdgcn_rsqf(t * (1.0f / 1024.0f) + 1e-6f);
}
struct EpiGU {
    static constexpr bool PERM = true, AFTER_DRAIN = false;
    bf16_t* H; const float* ssq;
    __device__ __forceinline__ void operator()(const f32x4 (&acc)[2][2][4][2], const Unit& u, int wr, int wc, int fr, int fq) const {
        const int row0 = u.pm * BM + wr * 64 + fr, hc0 = u.pn * 128 + wc * 16 + 4 * fq;
#pragma unroll
        for (int ai = 0; ai < 2; ++ai)
#pragma unroll
            for (int m = 0; m < 4; ++m) { const int row = row0 + ai * HALF + m * 16; const float rs = row_rstd_coop(ssq, row, fq);
#pragma unroll
                for (int bj = 0; bj < 2; ++bj) { const f32x4 g = acc[ai][bj][m][0] * rs, up = acc[ai][bj][m][1] * rs;
                    u32x2 w; w.x = cvt_pk_bf16(silu_f(g[0]) * up[0], silu_f(g[1]) * up[1]); w.y = cvt_pk_bf16(silu_f(g[2]) * up[2], silu_f(g[3]) * up[3]);
                    *(u32x2*)(H + (size_t)row * E_FF + hc0 + bj * 64) = w; } asm volatile("" ::: "memory"); }
    }
};
struct EpiIn {
    static constexpr bool PERM = true, AFTER_DRAIN = false;
    bf16_t* P; const float* ssq; float* out; int l;
    __device__ __forceinline__ void operator()(const f32x4 (&acc)[2][2][4][2], const Unit& u, int wr, int wc, int fr, int fq) const {
        const int row0 = u.pm * BM + wr * 64 + fr, col0 = u.pn * BM + wc * 32 + 8 * fq;
#pragma unroll
        for (int ai = 0; ai < 2; ++ai)
#pragma unroll
            for (int m = 0; m < 4; ++m) { const int row = row0 + ai * HALF + m * 16; const float rs = row_rstd_coop(ssq, row, fq);
#pragma unroll
                for (int bj = 0; bj < 2; ++bj) { const f32x4 v0 = acc[ai][bj][m][0] * rs, v1 = acc[ai][bj][m][1] * rs;
                    u32x4 w; w.x = cvt_pk_bf16(v0[0], v0[1]); w.y = cvt_pk_bf16(v0[2], v0[3]); w.z = cvt_pk_bf16(v1[0], v1[1]); w.w = cvt_pk_bf16(v1[2], v1[3]);
                    *(u32x4*)(P + (size_t)row * E_NPP + col0 + bj * HALF) = w;
                    const int cb = u.pn * BM + bj * HALF;
                    if (cb >= 1408 && cb < 2176 && row < 16512) { const bool isv = cb >= 1792; const int cc = col0 + bj * HALF - (isv ? 1792 : 1408);
                        const size_t off = (row < 16384) ? (isv ? (size_t)42074112 : (size_t)16908288) + ((size_t)l * 16384 + row) * 384 : (isv ? (size_t)69652480 : (size_t)69455872) + ((size_t)l * 128 + (row - 16384)) * 384;
                        float* dst = out + off + cc;
                        *(f32x4*)dst = v0; *(f32x4*)(dst + 4) = v1; } } asm volatile("" ::: "memory"); }
    }
};
struct EpiRes {
    static constexpr bool PERM = true, AFTER_DRAIN = false;
    float* Xf; bf16_t* XB; float* ssq; float scale;
    __device__ __forceinline__ void operator()(const f32x4 (&acc)[2][2][4][2], const Unit& u, int wr, int wc, int fr, int fq) const {
        const int row0 = u.pm * BM + wr * 64 + fr, col0 = u.pn * BM + wc * 32 + 8 * fq;
#pragma unroll
        for (int ai = 0; ai < 2; ++ai)
#pragma unroll
            for (int m = 0; m < 4; ++m) { const int row = row0 + ai * HALF + m * 16; float ss = 0.f;
#pragma unroll
                for (int bj = 0; bj < 2; ++bj) { bf16_t* xp = XB + (size_t)row * E_D + col0 + bj * HALF; const u32x4 o = *(const u32x4*)xp;
                    f32x4 x0, x1;
                    x0[0] = __uint_as_float(o.x << 16); x0[1] = __uint_as_float(o.x & 0xffff0000u); x0[2] = __uint_as_float(o.y << 16); x0[3] = __uint_as_float(o.y & 0xffff0000u);
                    x1[0] = __uint_as_float(o.z << 16); x1[1] = __uint_as_float(o.z & 0xffff0000u); x1[2] = __uint_as_float(o.w << 16); x1[3] = __uint_as_float(o.w & 0xffff0000u);
                    x0 += acc[ai][bj][m][0] * scale; x1 += acc[ai][bj][m][1] * scale;
                    if (Xf) { float* fp = Xf + (size_t)row * E_D + col0 + bj * HALF; *(f32x4*)fp = x0; *(f32x4*)(fp + 4) = x1; }
                    ss += (x0[0] * x0[0] + x0[1] * x0[1]) + (x0[2] * x0[2] + x0[3] * x0[3]) + (x1[0] * x1[0] + x1[1] * x1[1]) + (x1[2] * x1[2] + x1[3] * x1[3]);
                    u32x4 w; w.x = cvt_pk_bf16(x0[0], x0[1]); w.y = cvt_pk_bf16(x0[2], x0[3]); w.z = cvt_pk_bf16(x1[0], x1[1]); w.w = cvt_pk_bf16(x1[2], x1[3]);
                    *(u32x4*)xp = w; }
                ss = xsum16(ss); ss = xsum32(ss);
                if (fq == 0) ssq[(size_t)row * 16 + u.pn * 4 + wc] = ss; if (m & 1) asm volatile("" ::: "memory"); }
    }
};
template <class Epi, class Sched, bool ALIGN_EPI = false, bool SP2 = false>
__device__ __forceinline__ void gemm_phase(PG8_LAS unsigned char* lds, const Gemm g, const Sched& S, const Epi& E) {
    int tid = threadIdx.x; asm volatile("" : "+v"(tid)); const int wid = __builtin_amdgcn_readfirstlane(tid >> 6), lane = tid & 63, wr = wid >> 2, wc = wid & 3, fr = lane & 15, fq = lane >> 4;
    const int K = g.K, nt = K / BK;
    unsigned voffA[2], voffB[2];
#pragma unroll
    for (int i = 0; i < 2; ++i) { int R, C; stage_rc(tid * 16 + i * 8192, R, C); const int Rb = Epi::PERM ? ((R & ~31) + perm32(R & 31)) : R;
        voffA[i] = (unsigned)(R * K + C) * 2u; voffB[i] = (unsigned)(Rb * K + C) * 2u; }
    const size_t kstep = (size_t)(BK * 2);
    const size_t hstep = (size_t)HALF * K * 2;
    const size_t tstep = 2 * hstep;
    const unsigned ldsw = (unsigned)wid * 1024u;
    const int aoff = lds_byte(wr * 64 + fr, fq * 8), boff = lds_byte(wc * 32 + fr, fq * 8);
#define PG8_SA(b, h) (((b) * 2 + (h)) * HTB)
#define PG8_SB(b, h) ((4 + (b) * 2 + (h)) * HTB)
#define PG8_STAGE(bufoff, gbase, voff) do { _Pragma("unroll") for (int _i = 0; _i < 2; ++_i) \
        __builtin_amdgcn_global_load_lds((const unsigned*)((const char*)(gbase) + (voff)[_i]), (PG8_LAS unsigned*)(lds + (bufoff) + ldsw + _i * 8192), 16, 0, 0); } while (0)
#define PG8_LDA(dst, b, h) do { _Pragma("unroll") for (int m = 0; m < 4; ++m) _Pragma("unroll") for (int k = 0; k < 2; ++k) dst[m][k] = *(const PG8_LAS bf16x8*)(lds + PG8_SA(b, h) + aoff + m * 2048 + k * 1024); } while (0)
#define PG8_LDB(dst, b, h) do { _Pragma("unroll") for (int n = 0; n < 2; ++n) _Pragma("unroll") for (int k = 0; k < 2; ++k) dst[n][k] = *(const PG8_LAS bf16x8*)(lds + PG8_SB(b, h) + boff + n * 2048 + k * 1024); } while (0)
#define PG8_MMA(ai, bj, At, Bt) do { __builtin_amdgcn_s_setprio(1); _Pragma("unroll") for (int m = 0; m < 4; ++m) _Pragma("unroll") for (int n = 0; n < 2; ++n) _Pragma("unroll") for (int k = 0; k < 2; ++k) \
        acc[ai][bj][m][n] = __builtin_amdgcn_mfma_f32_16x16x32_bf16(Bt[n][k], At[m][k], acc[ai][bj][m][n], 0, 0, 0); __builtin_amdgcn_s_setprio(0); } while (0)
#define PG8_WAIT_V(n) asm volatile("s_waitcnt vmcnt(" #n ")" ::: "memory")
#define PG8_WAIT_L(n) asm volatile("s_waitcnt lgkmcnt(" #n ")" ::: "memory")
#define PG8_BAR __builtin_amdgcn_s_barrier()
#define PG8_SCHED __builtin_amdgcn_sched_barrier(0)
    Unit cur, nxt; int ui = 0;
    if (!S.next(0, cur)) return;
    f32x4 acc[2][2][4][2];
#pragma unroll
    for (int a = 0; a < 2; ++a)
#pragma unroll
        for (int b = 0; b < 2; ++b)
#pragma unroll
            for (int m = 0; m < 4; ++m)
#pragma unroll
                for (int n = 0; n < 2; ++n) acc[a][b][m][n] = (f32x4){0.f, 0.f, 0.f, 0.f};
    bf16x8 At[4][2], B0[2][2], B1[2][2];
    const char* cA = (const char*)g.A + (size_t)cur.pm * tstep; const char* cB = (const char*)g.Bt + (size_t)cur.pn * tstep;
    S.a_ready(cur);
    if constexpr (SP2) {
        PG8_STAGE(PG8_SB(0, 0), cB, voffB); PG8_STAGE(PG8_SB(0, 1), cB + hstep, voffB); PG8_STAGE(PG8_SA(0, 0), cA, voffA); PG8_STAGE(PG8_SA(0, 1), cA + hstep, voffA);
        if (wr == 1) PG8_BAR;
        PG8_WAIT_V(2); PG8_BAR;
        PG8_STAGE(PG8_SB(1, 0), cB + kstep, voffB); PG8_STAGE(PG8_SA(1, 0), cA + kstep, voffA); PG8_STAGE(PG8_SB(1, 1), cB + hstep + kstep, voffB);
        PG8_WAIT_V(6); PG8_BAR;
    } else {
        PG8_STAGE(PG8_SB(0, 0), cB, voffB); PG8_STAGE(PG8_SA(0, 0), cA, voffA); PG8_STAGE(PG8_SB(0, 1), cB + hstep, voffB); PG8_STAGE(PG8_SA(0, 1), cA + hstep, voffA);
        if (wr == 1) PG8_BAR;
        PG8_WAIT_V(4); PG8_BAR;
        PG8_STAGE(PG8_SB(1, 0), cB + kstep, voffB); PG8_STAGE(PG8_SA(1, 0), cA + kstep, voffA); PG8_STAGE(PG8_SB(1, 1), cB + hstep + kstep, voffB);
        PG8_WAIT_V(6); PG8_BAR;
    }
    for (;;) {
        const bool has_next = S.next(ui + 1, nxt);
        const char* nA = has_next ? (const char*)g.A + (size_t)nxt.pm * tstep : cA; const char* nB = has_next ? (const char*)g.Bt + (size_t)nxt.pn * tstep : cB;
        for (int t = 0; t < nt; t += 2) {
            const bool last = (t == nt - 2);
            const char* a1 = cA + (size_t)(t + 1) * kstep;
            const char* a2 = last ? nA : cA + (size_t)(t + 2) * kstep; const char* b2 = last ? nB : cB + (size_t)(t + 2) * kstep;
            const char* a3 = a2 + kstep; const char* b3 = b2 + kstep;
            if (last && has_next) S.a_ready(nxt);
            if constexpr (SP2) {
            PG8_LDB(B0, 0, 0); PG8_LDB(B1, 0, 1); PG8_SCHED; PG8_LDA(At, 0, 0); PG8_STAGE(PG8_SA(1, 1), a1 + hstep, voffA);
            PG8_WAIT_V(8); PG8_WAIT_L(0); PG8_BAR; PG8_MMA(0, 0, At, B0); PG8_MMA(0, 1, At, B1); PG8_BAR; PG8_SCHED;
            PG8_LDA(At, 0, 1); PG8_STAGE(PG8_SB(0, 0), b2, voffB); PG8_STAGE(PG8_SB(0, 1), b2 + hstep, voffB); PG8_STAGE(PG8_SA(0, 0), a2, voffA);
            PG8_WAIT_V(8); PG8_WAIT_L(0); PG8_BAR; PG8_MMA(1, 0, At, B0); PG8_MMA(1, 1, At, B1); PG8_BAR; PG8_SCHED;
            PG8_LDB(B0, 1, 0); PG8_LDB(B1, 1, 1); PG8_SCHED; PG8_LDA(At, 1, 0); PG8_STAGE(PG8_SA(0, 1), a2 + hstep, voffA);
            PG8_WAIT_V(8); PG8_WAIT_L(0); PG8_BAR; PG8_MMA(0, 0, At, B0); PG8_MMA(0, 1, At, B1); PG8_BAR; PG8_SCHED;
            PG8_LDA(At, 1, 1); PG8_STAGE(PG8_SB(1, 0), b3, voffB); PG8_STAGE(PG8_SB(1, 1), b3 + hstep, voffB); PG8_STAGE(PG8_SA(1, 0), a3, voffA);
            PG8_WAIT_V(8); PG8_WAIT_L(0); PG8_BAR; PG8_MMA(1, 0, At, B0); PG8_MMA(1, 1, At, B1); PG8_BAR; PG8_SCHED;
            } else {
            PG8_LDB(B0, 0, 0); PG8_SCHED; PG8_LDA(At, 0, 0); PG8_STAGE(PG8_SA(1, 1), a1 + hstep, voffA);
            PG8_WAIT_L(8); PG8_BAR; PG8_WAIT_L(0); PG8_MMA(0, 0, At, B0); PG8_BAR; PG8_SCHED;
            PG8_LDB(B1, 0, 1); PG8_STAGE(PG8_SB(0, 0), b2, voffB);
            PG8_BAR; PG8_WAIT_L(0); PG8_MMA(0, 1, At, B1); PG8_BAR;
            PG8_LDA(At, 0, 1); PG8_STAGE(PG8_SA(0, 0), a2, voffA);
            PG8_BAR; PG8_WAIT_L(0); PG8_MMA(1, 0, At, B0); PG8_BAR; PG8_SCHED;
            PG8_STAGE(PG8_SB(0, 1), b2 + hstep, voffB);
            PG8_WAIT_V(6); PG8_BAR; PG8_MMA(1, 1, At, B1); PG8_BAR;
            PG8_LDB(B0, 1, 0); PG8_SCHED; PG8_LDA(At, 1, 0); PG8_STAGE(PG8_SA(0, 1), a2 + hstep, voffA);
            PG8_WAIT_L(8); PG8_BAR; PG8_WAIT_L(0); PG8_MMA(0, 0, At, B0); PG8_BAR; PG8_SCHED;
            PG8_LDB(B1, 1, 1); PG8_STAGE(PG8_SB(1, 0), b3, voffB);
            PG8_BAR; PG8_WAIT_L(0); PG8_MMA(0, 1, At, B1); PG8_BAR;
            PG8_LDA(At, 1, 1); PG8_STAGE(PG8_SA(1, 0), a3, voffA);
            PG8_BAR; PG8_WAIT_L(0); PG8_MMA(1, 0, At, B0); PG8_BAR; PG8_SCHED;
            PG8_STAGE(PG8_SB(1, 1), b3 + hstep, voffB);
            PG8_WAIT_V(6); PG8_BAR; PG8_MMA(1, 1, At, B1); PG8_BAR;
            }
        }
        if constexpr (ALIGN_EPI) { if (wr == 0) PG8_BAR; }
        if constexpr (!Epi::AFTER_DRAIN) { E(acc, cur, wr, wc, fr, fq); S.done(cur); }
        if (!has_next) break;
#pragma unroll
        for (int a = 0; a < 2; ++a)
#pragma unroll
            for (int b = 0; b < 2; ++b)
#pragma unroll
                for (int m = 0; m < 4; ++m)
#pragma unroll
                    for (int n = 0; n < 2; ++n) acc[a][b][m][n] = (f32x4){0.f, 0.f, 0.f, 0.f};
        cur = nxt; cA = nA; cB = nB; ++ui;
        if constexpr (ALIGN_EPI) { if (wr == 1) PG8_BAR; }
    }
    PG8_WAIT_V(0);
    if constexpr (!ALIGN_EPI) { if (wr == 0) PG8_BAR; }
    PG8_BAR;
    if constexpr (Epi::AFTER_DRAIN) { E.fused(acc, cur, wr, wc, fr, fq, lds, wid, lane); S.done(cur); }
#undef PG8_SA
#undef PG8_SB
#undef PG8_STAGE
#undef PG8_LDA
#undef PG8_LDB
#undef PG8_MMA
#undef PG8_WAIT_V
#undef PG8_WAIT_L
#undef PG8_BAR
#undef PG8_SCHED
}
}
#define GAS __attribute__((address_space(1)))
#define LAS __attribute__((address_space(3)))
typedef unsigned short bf16;
typedef unsigned v4u __attribute__((ext_vector_type(4)));
typedef float f32x4 __attribute__((ext_vector_type(4)));
typedef short bf16x8 __attribute__((ext_vector_type(8)));
typedef GAS unsigned gu32;
typedef GAS unsigned long long gu64;
#define RLX_AGENT __ATOMIC_RELAXED, __HIP_MEMORY_SCOPE_AGENT
#define LDS_WAIT() asm volatile("s_waitcnt lgkmcnt(0)" ::: "memory")
#define VM_WAIT() asm volatile("s_waitcnt vmcnt(0)" ::: "memory")
__device__ __forceinline__ unsigned long long rt() { return __builtin_amdgcn_s_memrealtime(); }
__device__ __forceinline__ unsigned f2bf(float f) { unsigned u = __builtin_bit_cast(unsigned, f); return (u + 0x7fffu + ((u >> 16) & 1u)) >> 16; }
__device__ __forceinline__ unsigned pk2(float lo, float hi) { return f2bf(lo) | (f2bf(hi) << 16); }

#define XB_TMO      128
#define XB_XCNT(j)  (256  + 64 * (j))
#define XB_XSUB(j)  (1280 + 64 * (j))
#define XB_XGEN(j)  (2304 + 64 * (j))
#define XB_TOP      3328
#define XB_TOPGEN   3392
#define XCD_BAR_WORDS 3456
#define XB_SPIN_CAP (1u << 18)

__device__ __forceinline__ unsigned xb_ld(unsigned* p)              { return __hip_atomic_load(p, __ATOMIC_RELAXED, __HIP_MEMORY_SCOPE_AGENT); }
__device__ __forceinline__ unsigned xb_add(unsigned* p, unsigned v) { return __hip_atomic_fetch_add(p, v, __ATOMIC_RELAXED, __HIP_MEMORY_SCOPE_AGENT); }
__device__ __forceinline__ unsigned xb_xcc_id() { return (unsigned)__builtin_amdgcn_s_getreg((3 << 11) | 20) & 0xFu; }
#define XB_SPIN(cond, bar) do { unsigned _sp = 0; while (cond) { __builtin_amdgcn_s_sleep(1); \
    if ((++_sp & 255u) == 0u) { if (xb_ld(&(bar)[XB_TMO])) break; if (_sp > XB_SPIN_CAP) { atomicAdd(&(bar)[XB_TMO], 1u); break; } } } } while (0)

struct XcdBarrier {
    unsigned* bar; unsigned x;
    volatile LAS unsigned* st;
};

__device__ __forceinline__ XcdBarrier xcd_barrier_post(unsigned* bar, volatile LAS unsigned* st) {
    XcdBarrier b; b.bar = bar; b.x = xb_xcc_id(); b.st = st;
    if (threadIdx.x == 0) (void)xb_add(&bar[XB_XCNT(b.x)], 1u);
    return b;
}
__device__ __forceinline__ void xcd_barrier_complete(unsigned* bar, unsigned x, unsigned& nloc, unsigned& nx) {
    const unsigned G = gridDim.x * gridDim.y * gridDim.z;
    unsigned sum, cnt, mine, sp = 0u;
    for (;;) {
        sum = 0u; cnt = 0u; mine = 0u;
#pragma unroll
        for (unsigned j = 0; j < 16; ++j) { const unsigned c = xb_ld(&bar[XB_XCNT(j)]); sum += c; cnt += (c > 0u) ? 1u : 0u; mine = (j == x) ? c : mine; }
        if (sum == G) break;
        __builtin_amdgcn_s_sleep(1);
        if ((++sp & 255u) == 0u) { if (xb_ld(&bar[XB_TMO])) break; if (sp > XB_SPIN_CAP) { atomicAdd(&bar[XB_TMO], 1u); break; } }
    }
    nloc = mine > 0u ? mine : 1u; nx = cnt > 0u ? cnt : 1u;
}

__device__ __forceinline__ void xcd_barrier(const XcdBarrier& b) {
    asm volatile("s_waitcnt vmcnt(0)" ::: "memory");
    __syncthreads();
    int tid0_ = threadIdx.x; asm volatile("" : "+v"(tid0_));
    if (tid0_ == 0) {
        unsigned* bar = b.bar;
        __builtin_amdgcn_s_waitcnt(0);
        unsigned nloc = b.st[0], nx = b.st[1];
        if (nloc == 0u) { xcd_barrier_complete(bar, b.x, nloc, nx); b.st[0] = nloc; b.st[1] = nx; }
        const unsigned old = xb_add(&bar[XB_XSUB(b.x)], 1u);
        const unsigned gen = old / nloc;
        if (old + 1u == (gen + 1u) * nloc) {
            __builtin_amdgcn_fence(__ATOMIC_RELEASE, "agent");
            asm volatile("s_waitcnt vmcnt(0)" ::: "memory");
            const unsigned og = xb_add(&bar[XB_TOP], 1u);
            const unsigned tg = og / nx;
            if (og + 1u == (tg + 1u) * nx) xb_add(&bar[XB_TOPGEN], 1u);
            else XB_SPIN(xb_ld(&bar[XB_TOPGEN]) == tg, bar);
            __builtin_amdgcn_fence(__ATOMIC_ACQUIRE, "agent");
            xb_add(&bar[XB_XGEN(b.x)], 1u);
            asm volatile("s_waitcnt vmcnt(0)" ::: "memory");
        } else {
            XB_SPIN(xb_ld(&bar[XB_XGEN(b.x)]) == gen, bar);
            __builtin_amdgcn_fence(__ATOMIC_ACQUIRE, "agent");
            asm volatile("s_waitcnt vmcnt(0)" ::: "memory");
        }
    }
    __syncthreads();
}

constexpr int NWAVES = 8, NTHR = 512;
#ifndef WGM_GU
#define WGM_GU 4
#endif
#ifndef WGM_IN
#define WGM_IN 4
#endif
#ifndef WGM_R
#define WGM_R 8
#endif
constexpr int D = 1024, FF = 2816, NPJ = 3462, NPP = 3584;
constexpr int TP = 16384, TS = 128, TOK = TP + TS, MP = 16640;
constexpr int DEPTH = 4;
constexpr int C_Q = 1024, C_K = 1408, C_V = 1792, C_Z = 2176, C_XBC = 2560, C_DT = 3456;
constexpr float NORM_EPS = 1e-6f, GN_EPS = 64e-5f, NEG_INF = -1e30f;
constexpr size_t O_YP = 0, O_YS = 16777216, O_PK = 16908288, O_PV = 42074112, O_PSH = 67239936, O_PR = 67272704, O_PC = 67796992, O_PS = 67883008,
                 O_SK = 69455872, O_SV = 69652480, O_SSH = 69849088, O_SR = 69980160, O_SC = 72077312, O_SS = 72421376, O_END = 78712832;
static_assert(O_PK == 16908288 && O_PV == 42074112 && O_SK == 69455872 && O_SV == 69652480 && TP == 16384 && TS == 128, "the input-projection epilogue (EpiIn) hard-codes these output offsets");
constexpr size_t MiB = 1u << 20;
constexpr size_t WS_CTL = 0, CTL_ZERO_BYTES = 1 * MiB;
constexpr size_t SZ_WGU = (size_t)2 * FF * D * 2, SZ_WD = (size_t)D * FF * 2, SZ_WIN = (size_t)NPP * D * 2, SZ_WOUT = (size_t)D * D * 2;
constexpr size_t WL_GU1 = 0, WL_D1 = WL_GU1 + SZ_WGU, WL_IN = WL_D1 + SZ_WD, WL_OUT = WL_IN + SZ_WIN, WL_GU2 = WL_OUT + SZ_WOUT, WL_D2 = WL_GU2 + SZ_WGU, WL_SIZE = WL_D2 + SZ_WD;
static_assert(WL_SIZE == 44040192, "per-layer bf16 weight bytes");
constexpr size_t WS_REC = 488 * MiB; constexpr int REC_BYTES = 13312, REC_N = 10240, REC_T = 11776, REC_G = 12288;
constexpr size_t WS_LW = 1 * MiB, LW_SIZE = 131072;
constexpr size_t WS_W = 2 * MiB;
constexpr size_t WS_X = 176 * MiB, WS_XB = 242 * MiB, WS_SSQ = 276 * MiB, WS_H = 280 * MiB, WS_P = 372 * MiB, WS_OPS = 488 * MiB, WS_G = 586 * MiB, WS_SC = 603 * MiB,
                 WS_YS = 604 * MiB, WS_XC = 622 * MiB, WS_DT = 651 * MiB, WS_YC = 652 * MiB, WS_AP = 678 * MiB, WS_AM = 752 * MiB, WS_AL = 754 * MiB, WS_YM = 756 * MiB, WS_END = 790 * MiB;
static_assert(WS_W + 4 * WL_SIZE <= WS_X && WS_X + (size_t)MP * D * 4 <= WS_XB && WS_XB + (size_t)MP * D * 2 <= WS_SSQ && WS_SSQ + (size_t)MP * 64 <= WS_H && WS_H + (size_t)MP * FF * 2 <= WS_P &&
              WS_P + (size_t)MP * NPP * 2 <= WS_OPS && WS_OPS + (size_t)TOK * 4 * 384 * 4 <= WS_G && WS_G + (size_t)TOK * 256 * 4 <= WS_SC && WS_SC + (size_t)TOK * 32 <= WS_YS &&
              WS_YS + (size_t)TOK * 256 * 4 <= WS_XC && WS_XC + (size_t)TOK * 896 * 2 <= WS_DT && WS_DT + (size_t)TOK * 32 <= WS_YC && WS_YC + (size_t)TOK * 384 * 4 <= WS_AP &&
              WS_AP + (size_t)3 * TOK * 384 * 4 <= WS_AM && WS_AM + (size_t)3 * TOK * 32 <= WS_AL && WS_AL + (size_t)3 * TOK * 32 <= WS_YM && WS_YM + (size_t)MP * D * 2 <= WS_END, "d_ws map");
constexpr int CW_BAR = 4096;
constexpr int CW_Q = 16384;
constexpr int RING_BYTES = 131072, LDSCTL_OFF = RING_BYTES, MISC_OFF = LDSCTL_OFF + 320, LDS_BYTES = 147456;

typedef unsigned v2u __attribute__((ext_vector_type(2)));

#ifndef PHASE_FN
#define PHASE_FN __attribute__((noinline)) static
#endif
struct KArgs { const float* in[38]; float* out; unsigned char* ws; };
#define CAS __attribute__((address_space(4)))
struct KA {
    const CAS unsigned char* kp;
    __device__ __forceinline__ const float* in(int k) const { return *(const float* const CAS*)(kp + 8 * k); }
    __device__ __forceinline__ float* out() const { return *(float* const CAS*)(kp + 304); }
    __device__ __forceinline__ unsigned char* ws() const { return *(unsigned char* const CAS*)(kp + 312); }
};
__device__ __forceinline__ KA make_ka() { KA k; k.kp = (const CAS unsigned char*)__builtin_amdgcn_kernarg_segment_ptr(); asm volatile("" : "+s"(k.kp)); return k; }
__device__ __forceinline__ int fresh_tid() { int t = threadIdx.x; asm volatile("" : "+v"(t)); return t; }

__device__ __forceinline__ float bf2f(bf16 u) { return __uint_as_float((unsigned)u << 16); }
__device__ __forceinline__ float bflo(unsigned u) { return __uint_as_float(u << 16); }
__device__ __forceinline__ float bfhi(unsigned u) { return __uint_as_float(u & 0xffff0000u); }
__device__ __forceinline__ bf16 f2bf_s(float f) { unsigned u = __float_as_uint(f); return (bf16)((u + 0x7fffu + ((u >> 16) & 1u)) >> 16); }
template <int CTRL> __device__ __forceinline__ float dppf(float v) { return __builtin_bit_cast(float, __builtin_amdgcn_update_dpp(0, __builtin_bit_cast(int, v), CTRL, 0xF, 0xF, true)); }
template <int N> __device__ __forceinline__ float dpp_shr(float v, float fill) { return __builtin_bit_cast(float, __builtin_amdgcn_update_dpp(__builtin_bit_cast(int, fill), __builtin_bit_cast(int, v), 0x110 + N, 0xF, 0xF, false)); }
__device__ __forceinline__ float red8(float v) { v += dppf<0xB1>(v); v += dppf<0x4E>(v); v += dppf<0x141>(v); return v; }
__device__ __forceinline__ float wave_sum(float v) { v += dppf<0xB1>(v); v += dppf<0x4E>(v); v += dppf<0x141>(v); v += dppf<0x140>(v); v = pg8::xsum16(v); return pg8::xsum32(v); }
__device__ __forceinline__ float wave_max(float v) { v = fmaxf(v, dppf<0xB1>(v)); v = fmaxf(v, dppf<0x4E>(v)); v = fmaxf(v, dppf<0x141>(v)); v = fmaxf(v, dppf<0x140>(v)); v = pg8::xmax16(v); return pg8::xmax32(v); }
__device__ __forceinline__ float sigmoidf_(float x) { return __builtin_amdgcn_rcpf(1.0f + __builtin_amdgcn_exp2f(-1.4426950408889634f * x)); }
__device__ __forceinline__ float tanhf_(float x) { return 2.0f * sigmoidf_(2.0f * x) - 1.0f; }
__device__ __forceinline__ float softplusf_(float x) { return fmaxf(x, 0.f) + 0.6931471805599453f * __builtin_amdgcn_logf(1.0f + __builtin_amdgcn_exp2f(-1.4426950408889634f * fabsf(x))); }
template <int K> __device__ __forceinline__ f32x4 tile_mma(f32x4 acc, const LAS bf16* A, int lda, const LAS bf16* B, int ldb, int lane) {
    const LAS bf16* ap = A + (lane & 15) * lda + 8 * (lane >> 4); const LAS bf16* bp = B + (lane & 15) * ldb + 8 * (lane >> 4);
#pragma unroll
    for (int k = 0; k < K; k += 32) acc = __builtin_amdgcn_mfma_f32_16x16x32_bf16(*(const LAS bf16x8*)(ap + k), *(const LAS bf16x8*)(bp + k), acc, 0, 0, 0);
    return acc;
}

template <int MODE, int VW> __device__ __forceinline__ void tr_item(const float* W, int K, int N, const float* gain, bf16* WT, LAS float* scr, int kb, int nb, int lane) {
    const int k0 = 64 * kb, n0 = 32 * nb;
    constexpr int LPR = 32 / VW, RPI = 64 / LPR, NI = 64 / RPI;
    const int rr = lane / LPR, cc = (lane % LPR) * VW;
    float v[NI][VW];
#pragma unroll
    for (int i = 0; i < NI; ++i) { const int kk = RPI * i + rr; const float* p = W + (size_t)(k0 + kk) * N + n0 + cc;
        if (n0 + 32 <= N) { if (VW == 4) { const f32x4 t = *(const f32x4*)p; v[i][0] = t[0]; v[i][1] = t[1]; v[i][VW - 2] = t[2]; v[i][VW - 1] = t[3]; } else { const pg8::f32x2 t = *(const pg8::f32x2*)p; v[i][0] = t[0]; v[i][1] = t[1]; } }
        else {
#pragma unroll
            for (int e = 0; e < VW; ++e) v[i][e] = (n0 + cc + e < N) ? p[e] : 0.f; } }
#pragma unroll
    for (int i = 0; i < NI; ++i) { const int kk = RPI * i + rr; const float g = gain ? gain[k0 + kk] : 1.0f;
#pragma unroll
        for (int e = 0; e < VW; ++e) scr[kk * 33 + cc + e] = v[i][e] * g; }
    asm volatile("s_waitcnt lgkmcnt(0)" ::: "memory");
    const int c = lane & 7;
#pragma unroll
    for (int j = 0; j < 4; ++j) { const int nl = (lane >> 3) + 8 * j, n = n0 + nl; const LAS float* sp = scr + (8 * c) * 33 + nl;
        v4u o; o.x = pg8::cvt_pk_bf16(sp[0 * 33], sp[1 * 33]); o.y = pg8::cvt_pk_bf16(sp[2 * 33], sp[3 * 33]); o.z = pg8::cvt_pk_bf16(sp[4 * 33], sp[5 * 33]); o.w = pg8::cvt_pk_bf16(sp[6 * 33], sp[7 * 33]);
        const int drow = (MODE == 0) ? n : 8 * (n >> 2) + 4 * (MODE - 1) + (n & 3);
        *(v4u*)(WT + (size_t)drow * K + k0 + 8 * c) = o; }
    asm volatile("s_waitcnt lgkmcnt(0)" ::: "memory");
}
constexpr int I_G = 16 * 88, I_D = 44 * 32, I_IN = 16 * 112, I_OUT = 16 * 32, I_LAYER = 6 * 1408 + I_IN + I_OUT;
static_assert(I_G == 1408 && I_D == 1408 && I_LAYER % 8 == 0, "items");
__device__ __forceinline__ void wconv_item(const KA a, int l, int r, LAS float* scr, int lane) {
    bf16* wl = (bf16*)(a.ws() + WS_W + (size_t)l * WL_SIZE);
    if (r < I_G) { tr_item<1, 4>(a.in(9) + (size_t)l * D * FF, D, FF, a.in(8) + l * D, (bf16*)((unsigned char*)wl + WL_GU1), scr, r / 88, r % 88, lane); return; } r -= I_G;
    if (r < I_G) { tr_item<2, 4>(a.in(10) + (size_t)l * D * FF, D, FF, a.in(8) + l * D, (bf16*)((unsigned char*)wl + WL_GU1), scr, r / 88, r % 88, lane); return; } r -= I_G;
    if (r < I_D) { tr_item<0, 4>(a.in(11) + (size_t)l * D * FF, FF, D, nullptr, (bf16*)((unsigned char*)wl + WL_D1), scr, r / 32, r % 32, lane); return; } r -= I_D;
    if (r < I_IN) { tr_item<0, 2>(a.in(13) + (size_t)l * D * NPJ, D, NPJ, a.in(12) + l * D, (bf16*)((unsigned char*)wl + WL_IN), scr, r / 112, r % 112, lane); return; } r -= I_IN;
    if (r < I_OUT) { tr_item<0, 4>(a.in(32) + (size_t)l * D * D, D, D, nullptr, (bf16*)((unsigned char*)wl + WL_OUT), scr, r / 32, r % 32, lane); return; } r -= I_OUT;
    if (r < I_G) { tr_item<1, 4>(a.in(34) + (size_t)l * D * FF, D, FF, a.in(33) + l * D, (bf16*)((unsigned char*)wl + WL_GU2), scr, r / 88, r % 88, lane); return; } r -= I_G;
    if (r < I_G) { tr_item<2, 4>(a.in(35) + (size_t)l * D * FF, D, FF, a.in(33) + l * D, (bf16*)((unsigned char*)wl + WL_GU2), scr, r / 88, r % 88, lane); return; } r -= I_G;
    tr_item<0, 4>(a.in(36) + (size_t)l * D * FF, FF, D, nullptr, (bf16*)((unsigned char*)wl + WL_D2), scr, r / 32, r % 32, lane);
}
__device__ __forceinline__ void p0_prologue(const KA a, LAS unsigned char* lds, int tid) {
    const int lane = tid & 63, wave = __builtin_amdgcn_readfirstlane(tid >> 6), gw = blockIdx.x * NWAVES + wave; int NGW = gridDim.x * NWAVES; asm volatile("" : "+s"(NGW));
    LAS float* scr = (LAS float*)(lds + wave * 16384);
    for (int it = gw; it < DEPTH * 32; it += NGW) {
        const int l = it >> 5, r = it & 31; bf16* lw = (bf16*)(a.ws() + WS_LW + (size_t)l * LW_SIZE);
        if (r < 8) tr_item<0, 4>(a.in(16) + (size_t)l * 64 * 256, 64, 256, nullptr, lw, scr, 0, r, lane);
        else if (r < 16) tr_item<0, 4>(a.in(18) + (size_t)l * 64 * 256, 64, 256, nullptr, lw + 256 * 64, scr, 0, r - 8, lane);
        else tr_item<0, 4>(a.in(19) + (size_t)l * 128 * 256, 128, 256, nullptr, lw + 2 * 256 * 64, scr, (r - 16) >> 3, (r - 16) & 7, lane);
    }
    for (int it = gw; it < I_LAYER; it += NGW) wconv_item(a, 0, it, scr, lane);
}
__device__ __forceinline__ void wconv_unit(const KA a, int l, int u, LAS unsigned char* lds, int tid) {
    const int lane = tid & 63, wave = __builtin_amdgcn_readfirstlane(tid >> 6);
    wconv_item(a, l, u * 8 + wave, (LAS float*)(lds + wave * 16384), lane);
}
constexpr int WTAIL_K = 3, WT_C0 = 150, WT_C1 = 142, WT_N0 = (256 - WT_C0) * 8 * WTAIL_K, WT_N1 = (256 - WT_C1) * 8 * WTAIL_K, WT_ITEMS = 2 * WT_N0 + WT_N1;
static_assert(WT_ITEMS % 8 == 0 && WT_ITEMS <= I_LAYER, "tail items");
__device__ __forceinline__ void wconv_tail(const KA a, int l, int slot, LAS unsigned char* lds, int tid) {
    if (gridDim.x != 256) return;
    const int c0 = (slot == 1) ? WT_C1 : WT_C0, base = (slot == 0) ? 0 : (slot == 1 ? WT_N0 : WT_N0 + WT_N1), nw = (256 - c0) * 8;
    if ((int)blockIdx.x < c0) return;
    const int lane = tid & 63, wave = __builtin_amdgcn_readfirstlane(tid >> 6), widx = ((int)blockIdx.x - c0) * 8 + wave;
    __syncthreads();
#pragma unroll 1
    for (int k = 0; k < WTAIL_K; ++k) wconv_item(a, l, base + k * nw + widx, (LAS float*)(lds + wave * 16384), lane);
}
PHASE_FN __device__ void p0_xinit(const KA a, int tid) {
    const int lane = tid & 63, wave = __builtin_amdgcn_readfirstlane(tid >> 6), gw = blockIdx.x * NWAVES + wave; int NGW = gridDim.x * NWAVES; asm volatile("" : "+s"(NGW));
    float* X = (float*)(a.ws() + WS_X); bf16* XB = (bf16*)(a.ws() + WS_XB); float* SSQ = (float*)(a.ws() + WS_SSQ); bf16* YM = (bf16*)(a.ws() + WS_YM);
    for (int m = gw; m < MP; m += NGW) {
        const float* src = (m < TP) ? a.in(0) + (size_t)m * D : a.in(1) + (size_t)(m - TP) * D;
        f32x4 v[4]; float s = 0.f;
#pragma unroll
        for (int j = 0; j < 4; ++j) { v[j] = (m < TOK) ? ((const f32x4*)src)[lane + 64 * j] : (f32x4){0.f, 0.f, 0.f, 0.f}; s += (v[j][0] * v[j][0] + v[j][1] * v[j][1]) + (v[j][2] * v[j][2] + v[j][3] * v[j][3]); }
        s = wave_sum(s);
#pragma unroll
        for (int j = 0; j < 4; ++j) {
            v2u w; w.x = pg8::cvt_pk_bf16(v[j][0], v[j][1]); w.y = pg8::cvt_pk_bf16(v[j][2], v[j][3]); ((v2u*)(XB + (size_t)m * D))[lane + 64 * j] = w;
            if (m >= TOK) ((v2u*)(YM + (size_t)m * D))[lane + 64 * j] = (v2u){0u, 0u}; }
        if (m < TP) { if (lane < 16) SSQ[(size_t)m * 16 + lane] = (lane == 0) ? s : 0.f; }
        else SSQ[pg8::SSQS_OFF + (size_t)(m - TP) * 64 + lane] = (lane == 0) ? s : 0.f;
    }
}

__device__ __forceinline__ v2u pk4(f32x4 v) { v2u w; w.x = pg8::cvt_pk_bf16(v[0], v[1]); w.y = pg8::cvt_pk_bf16(v[2], v[3]); return w; }
__device__ __forceinline__ f32x4 up4(v2u w) { return (f32x4){bflo(w.x), bfhi(w.x), bflo(w.y), bfhi(w.y)}; }
__device__ __forceinline__ void ld8(float (&d)[8], const bf16* p) { const v4u w = *(const v4u*)p; d[0] = bflo(w.x); d[1] = bfhi(w.x); d[2] = bflo(w.y); d[3] = bfhi(w.y); d[4] = bflo(w.z); d[5] = bfhi(w.z); d[6] = bflo(w.w); d[7] = bfhi(w.w); }
__device__ __forceinline__ void ld4(float (&d)[4], const bf16* p) { const v2u w = *(const v2u*)p; d[0] = bflo(w.x); d[1] = bfhi(w.x); d[2] = bflo(w.y); d[3] = bfhi(w.y); }
__device__ __forceinline__ void rwkv_prep(const KA a, int l, LAS unsigned char* lds, int tid) {
    const int lane = tid & 63, wave = __builtin_amdgcn_readfirstlane(tid >> 6);
    int ngrp = gridDim.x >> 2; asm volatile("" : "+s"(ngrp));
    const int h = blockIdx.x & 3, wv = (blockIdx.x >> 2) * NWAVES + wave, NW = ngrp * NWAVES;
    if ((int)(blockIdx.x >> 2) >= ngrp) return;
    const int fr = lane & 15, fq = lane >> 4;
    const bf16* P = (const bf16*)(a.ws() + WS_P);
    const bf16* w2t = (const bf16*)(a.ws() + WS_LW + (size_t)l * LW_SIZE); const bf16* a2t = w2t + 256 * 64; const bf16* g2t = a2t + 256 * 64;
    LAS bf16* W2 = (LAS bf16*)lds; LAS bf16* A2 = W2 + 64 * 72; LAS bf16* G2 = A2 + 64 * 72;
    { const int r = tid >> 3, c = tid & 7;
      *(LAS v4u*)(W2 + r * 72 + c * 8) = *(const v4u*)(w2t + (size_t)(64 * h + r) * 64 + c * 8); *(LAS v4u*)(A2 + r * 72 + c * 8) = *(const v4u*)(a2t + (size_t)(64 * h + r) * 64 + c * 8);
#pragma unroll
      for (int q = 0; q < 2; ++q) { const int idx = tid + NTHR * q, rr = idx >> 4, cc = idx & 15; *(LAS v4u*)(G2 + rr * 136 + cc * 8) = *(const v4u*)(g2t + (size_t)(64 * h + rr) * 128 + cc * 8); } }
    __syncthreads();
    const float* mu = a.in(14) + l * 1024;
    bf16* G = (bf16*)(a.ws() + WS_G); float* SC = (float*)(a.ws() + WS_SC);
    for (int tile = wv; tile < TOK / 16; tile += NW) {
        const int row = tile * 16 + fr;
        bool first; const float* sh = nullptr;
        if (row < TP) first = (row & 2047) == 0; else { const int r = row - TP; first = (r & 3) == 0; sh = a.in(4) + (size_t)(l * 32 + (r >> 2)) * 1024; }
        const bf16* pc = P + (size_t)row * NPP; const bf16* pq = first ? pc : pc - NPP;
        bf16x8 fw[2], fa[2], fg[4];
#pragma unroll
        for (int ks = 0; ks < 8; ++ks) { const int col = 768 + 32 * ks + 8 * fq;
            float c[8], p[8]; ld8(c, pc + col); ld8(p, pq + col);
            const f32x4 m0 = *(const f32x4*)(mu + col), m1 = *(const f32x4*)(mu + col + 4);
            if (first) { if (sh) { const f32x4 s0 = *(const f32x4*)(sh + col), s1 = *(const f32x4*)(sh + col + 4);
#pragma unroll
                    for (int e = 0; e < 4; ++e) { p[e] = s0[e]; p[4 + e] = s1[e]; } } else {
#pragma unroll
                    for (int e = 0; e < 8; ++e) p[e] = 0.f; } }
            float x[8];
#pragma unroll
            for (int e = 0; e < 8; ++e) { const float m = (e < 4) ? m0[e & 3] : m1[e & 3]; const float ps = c[e] + m * (p[e] - c[e]); x[e] = (ks < 2) ? tanhf_(ps) : (ks < 4 ? ps : sigmoidf_(ps)); }
            union { bf16x8 v; unsigned u[4]; } f; f.u[0] = pg8::cvt_pk_bf16(x[0], x[1]); f.u[1] = pg8::cvt_pk_bf16(x[2], x[3]); f.u[2] = pg8::cvt_pk_bf16(x[4], x[5]); f.u[3] = pg8::cvt_pk_bf16(x[6], x[7]);
            if (ks < 2) fw[ks] = f.v; else if (ks < 4) fa[ks - 2] = f.v; else fg[ks - 4] = f.v;
            if (ks & 1) { } }
        {
            f32x4 aw[4], aa[4], ag[4];
#pragma unroll
            for (int t = 0; t < 4; ++t) { const int n = 16 * t + fr;
                const LAS bf16* wp = W2 + n * 72 + 8 * fq; const LAS bf16* ap = A2 + n * 72 + 8 * fq; const LAS bf16* gp = G2 + n * 136 + 8 * fq;
                f32x4 z = (f32x4){0.f, 0.f, 0.f, 0.f};
                aw[t] = __builtin_amdgcn_mfma_f32_16x16x32_bf16(*(const LAS bf16x8*)wp, fw[0], z, 0, 0, 0); aw[t] = __builtin_amdgcn_mfma_f32_16x16x32_bf16(*(const LAS bf16x8*)(wp + 32), fw[1], aw[t], 0, 0, 0);
                aa[t] = __builtin_amdgcn_mfma_f32_16x16x32_bf16(*(const LAS bf16x8*)ap, fa[0], z, 0, 0, 0); aa[t] = __builtin_amdgcn_mfma_f32_16x16x32_bf16(*(const LAS bf16x8*)(ap + 32), fa[1], aa[t], 0, 0, 0);
                ag[t] = __builtin_amdgcn_mfma_f32_16x16x32_bf16(*(const LAS bf16x8*)gp, fg[0], z, 0, 0, 0); ag[t] = __builtin_amdgcn_mfma_f32_16x16x32_bf16(*(const LAS bf16x8*)(gp + 32), fg[1], ag[t], 0, 0, 0);
                ag[t] = __builtin_amdgcn_mfma_f32_16x16x32_bf16(*(const LAS bf16x8*)(gp + 64), fg[2], ag[t], 0, 0, 0); ag[t] = __builtin_amdgcn_mfma_f32_16x16x32_bf16(*(const LAS bf16x8*)(gp + 96), fg[3], ag[t], 0, 0, 0);
                *(v2u*)(G + (size_t)row * 256 + 64 * h + 16 * t + 4 * fq) = pk4(ag[t]); }
            float r[4][4], k[4][4];
#pragma unroll
            for (int t = 0; t < 4; ++t) { const int c = 64 * h + 16 * t + 4 * fq;
#pragma unroll
                for (int part = 0; part < 2; ++part) { const int col = 256 * part + c; float cc[4], pp[4]; ld4(cc, pc + col); ld4(pp, pq + col);
                    const f32x4 m = *(const f32x4*)(mu + col);
                    if (first) { if (sh) { const f32x4 s0 = *(const f32x4*)(sh + col);
#pragma unroll
                            for (int e = 0; e < 4; ++e) pp[e] = s0[e]; } else {
#pragma unroll
                            for (int e = 0; e < 4; ++e) pp[e] = 0.f; } }
#pragma unroll
                    for (int e = 0; e < 4; ++e) { const float ps = cc[e] + m[e] * (pp[e] - cc[e]); if (part == 0) r[t][e] = ps; else k[t][e] = ps; } } }
            float n2 = 0.f;
#pragma unroll
            for (int t = 0; t < 4; ++t) { const int c = l * 256 + 64 * h + 16 * t + 4 * fq;
                const f32x4 w0 = *(const f32x4*)(a.in(15) + c), a0 = *(const f32x4*)(a.in(17) + c), kkw = *(const f32x4*)(a.in(20) + c);
#pragma unroll
                for (int e = 0; e < 4; ++e) { const float wlog = -softplusf_(-(w0[e] + aw[t][e])) - 0.5f; aw[t][e] = __expf(-__expf(wlog)); aa[t][e] = sigmoidf_(a0[e] + aa[t][e]); const float kk = k[t][e] * kkw[e]; n2 += kk * kk; } }
            n2 = pg8::xsum16(n2); n2 = pg8::xsum32(n2);
            const float inv = 1.0f / fmaxf(sqrtf(n2), 1e-12f);
            float br = 0.f, kr = 0.f, bon = 0.f;
#pragma unroll
            for (int t = 0; t < 4; ++t) { const int c = l * 256 + 64 * h + 16 * t + 4 * fq;
                const f32x4 kkw = *(const f32x4*)(a.in(20) + c), kaw = *(const f32x4*)(a.in(21) + c), rkw = *(const f32x4*)(a.in(22) + c);
#pragma unroll
                for (int e = 0; e < 4; ++e) { const float kk = k[t][e] * kkw[e] * inv, av = aa[t][e], kt = k[t][e] * (1.f + (av - 1.f) * kaw[e]);
                    br += kk * av * r[t][e]; kr += kt * r[t][e]; bon += r[t][e] * kt * rkw[e]; } }
            br = pg8::xsum16(br); br = pg8::xsum32(br); kr = pg8::xsum16(kr); kr = pg8::xsum32(kr); bon = pg8::xsum16(bon); bon = pg8::xsum32(bon);
            unsigned char* rec = a.ws() + WS_REC + (size_t)(tile * 4 + h) * REC_BYTES;
            const bool samp = tile >= TP / 16;
            const bool c1 = !samp || (fr & 3) >= 1, c2 = !samp || (fr & 3) >= 2;
            f32x4 At4[4], Rt4[4], Bt4[4], Kt4[4];
#pragma unroll
            for (int t = 0; t < 4; ++t) { const int c = l * 256 + 64 * h + 16 * t + 4 * fq;
                const f32x4 kkw = *(const f32x4*)(a.in(20) + c), kaw = *(const f32x4*)(a.in(21) + c);
                f32x4 vv;
                { const int col = 512 + 64 * h + 16 * t + 4 * fq; float cc[4], pp[4]; ld4(cc, pc + col); ld4(pp, pq + col); const f32x4 m = *(const f32x4*)(mu + col);
                  if (first) { if (sh) { const f32x4 q0 = *(const f32x4*)(sh + col);
#pragma unroll
                          for (int e = 0; e < 4; ++e) pp[e] = q0[e]; } else {
#pragma unroll
                          for (int e = 0; e < 4; ++e) pp[e] = 0.f; } }
#pragma unroll
                  for (int e = 0; e < 4; ++e) vv[e] = cc[e] + m[e] * (pp[e] - cc[e]); }
                f32x4 gend;
#pragma unroll
                for (int e = 0; e < 4; ++e) { const float kk = k[t][e] * kkw[e] * inv, av = aa[t][e], w = aw[t][e], kt = k[t][e] * (1.f + (av - 1.f) * kaw[e]);
                    float g = w, x;
                    x = dpp_shr<1>(g, 1.0f); g *= c1 ? x : 1.0f;
                    x = dpp_shr<2>(g, 1.0f); g *= c2 ? x : 1.0f;
                    x = dpp_shr<4>(g, 1.0f); g *= samp ? 1.0f : x;
                    x = dpp_shr<8>(g, 1.0f); g *= samp ? 1.0f : x;
                    x = dpp_shr<1>(g, 1.0f); const float gm = c1 ? x : 1.0f;
                    const float ig = __builtin_amdgcn_rcpf(g);
                    At4[t][e] = -gm * kk; Rt4[t][e] = gm * (w * r[t][e] - kk * br); Bt4[t][e] = kk * av * ig; Kt4[t][e] = kt * ig; gend[e] = g; }
                const size_t eo = ((size_t)fr * 64 + 16 * t + 4 * fq) * 2;
                *(v2u*)(rec + eo) = pk4(At4[t]); *(v2u*)(rec + 2048 + eo) = pk4(Rt4[t]); *(v2u*)(rec + 4096 + eo) = pk4(Bt4[t]); *(v2u*)(rec + 6144 + eo) = pk4(Kt4[t]); *(v2u*)(rec + 8192 + eo) = pk4(vv);
                if (samp ? ((fr & 3) == 3) : (fr == 15)) *(f32x4*)(rec + REC_G + ((samp ? (fr >> 2) : 0) * 64 + 16 * t + 4 * fq) * 4) = gend; }
            { union FR { bf16x8 v; unsigned u[4]; } fA[2], fR[2], fB[2], fK[2];
#pragma unroll
              for (int ks = 0; ks < 2; ++ks) { const v2u a0 = pk4(At4[2 * ks]), a1 = pk4(At4[2 * ks + 1]), r0 = pk4(Rt4[2 * ks]), r1 = pk4(Rt4[2 * ks + 1]), b0 = pk4(Bt4[2 * ks]), b1 = pk4(Bt4[2 * ks + 1]), k0 = pk4(Kt4[2 * ks]), k1 = pk4(Kt4[2 * ks + 1]);
                  fA[ks].u[0] = a0.x; fA[ks].u[1] = a0.y; fA[ks].u[2] = a1.x; fA[ks].u[3] = a1.y; fR[ks].u[0] = r0.x; fR[ks].u[1] = r0.y; fR[ks].u[2] = r1.x; fR[ks].u[3] = r1.y;
                  fB[ks].u[0] = b0.x; fB[ks].u[1] = b0.y; fB[ks].u[2] = b1.x; fB[ks].u[3] = b1.y; fK[ks].u[0] = k0.x; fK[ks].u[1] = k0.y; fK[ks].u[2] = k1.x; fK[ks].u[3] = k1.y; }
              const f32x4 z4 = (f32x4){0.f, 0.f, 0.f, 0.f};
              f32x4 nba = __builtin_amdgcn_mfma_f32_16x16x32_bf16(fB[0].v, fA[0].v, z4, 0, 0, 0); nba = __builtin_amdgcn_mfma_f32_16x16x32_bf16(fB[1].v, fA[1].v, nba, 0, 0, 0);
              f32x4 nka = __builtin_amdgcn_mfma_f32_16x16x32_bf16(fK[0].v, fA[0].v, z4, 0, 0, 0); nka = __builtin_amdgcn_mfma_f32_16x16x32_bf16(fK[1].v, fA[1].v, nka, 0, 0, 0);
              f32x4 nbr = __builtin_amdgcn_mfma_f32_16x16x32_bf16(fB[0].v, fR[0].v, z4, 0, 0, 0); nbr = __builtin_amdgcn_mfma_f32_16x16x32_bf16(fB[1].v, fR[1].v, nbr, 0, 0, 0);
              f32x4 nkr = __builtin_amdgcn_mfma_f32_16x16x32_bf16(fK[0].v, fR[0].v, z4, 0, 0, 0); nkr = __builtin_amdgcn_mfma_f32_16x16x32_bf16(fK[1].v, fR[1].v, nkr, 0, 0, 0);
              LAS float* Nb = (LAS float*)(lds + 36864) + wave * 288;
#pragma unroll
              for (int e = 0; e < 4; ++e) { const int sN = 4 * fq + e, tN = fr; const bool keep = (sN < tN) && (!samp || (sN >> 2) == (tN >> 2));
                  nba[e] = keep ? nba[e] : 0.f; nka[e] = keep ? nka[e] : 0.f; nbr[e] = keep ? nbr[e] : 0.f; nkr[e] = keep ? nkr[e] : 0.f;
                  Nb[sN * 17 + tN] = nba[e];
                  bf16* np = (bf16*)(rec + REC_N) + sN * 16 + tN; np[0] = f2bf_s(nka[e]); np[256] = f2bf_s(nbr[e]); np[512] = f2bf_s(nkr[e]); }
              asm volatile("s_waitcnt lgkmcnt(0)" ::: "memory");
              float Tr[16];
#pragma unroll
              for (int t = 0; t < 16; ++t) { float acc = (fr == t) ? 1.f : 0.f;
#pragma unroll
                  for (int sN = 0; sN < t; ++sN) acc += Tr[sN] * Nb[sN * 17 + t];
                  Tr[t] = acc; }
              if (fq == 0) { v4u o0, o1; o0.x = pg8::cvt_pk_bf16(Tr[0], Tr[1]); o0.y = pg8::cvt_pk_bf16(Tr[2], Tr[3]); o0.z = pg8::cvt_pk_bf16(Tr[4], Tr[5]); o0.w = pg8::cvt_pk_bf16(Tr[6], Tr[7]);
                  o1.x = pg8::cvt_pk_bf16(Tr[8], Tr[9]); o1.y = pg8::cvt_pk_bf16(Tr[10], Tr[11]); o1.z = pg8::cvt_pk_bf16(Tr[12], Tr[13]); o1.w = pg8::cvt_pk_bf16(Tr[14], Tr[15]);
                  *(v4u*)(rec + REC_T + fr * 32) = o0; *(v4u*)(rec + REC_T + fr * 32 + 16) = o1; }
              asm volatile("s_waitcnt lgkmcnt(0)" ::: "memory"); }
            if (fq == 0) { SC[(size_t)(row * 4 + h) * 2] = kr; SC[(size_t)(row * 4 + h) * 2 + 1] = bon; }
        }
    }
}

PHASE_FN __device__ void prep_elementwise(const KA a, int l, int tid) {
    int skipb = (gridDim.x > 8) ? 4 : 0; asm volatile("" : "+s"(skipb));
    if ((int)blockIdx.x < skipb) return;
    const int gtid = ((int)blockIdx.x - skipb) * NTHR + tid; int GT = ((int)gridDim.x - skipb) * NTHR; asm volatile("" : "+s"(GT));
    const bf16* P = (const bf16*)(a.ws() + WS_P); bf16* XC = (bf16*)(a.ws() + WS_XC); float* DT = (float*)(a.ws() + WS_DT); float* out = a.out();
    const float* cw = a.in(26) + (size_t)l * 4 * 896; const float* cb = a.in(27) + l * 896;
    for (int idx = gtid; idx < (TOK / 4) * 112; idx += GT) {
        const int grp = idx / 112, c8 = idx - grp * 112, col = c8 * 8, row0 = grp * 4;
        int t0, b = 0; if (row0 < TP) t0 = row0 & 2047; else { b = (row0 - TP) >> 2; t0 = 0; }
        float x[7][8];
#pragma unroll
        for (int i = 0; i < 7; ++i) { const int tt = t0 - 3 + i;
            if (tt >= 0) ld8(x[i], P + (size_t)(row0 - 3 + i) * NPP + C_XBC + col);
            else if (row0 < TP) {
#pragma unroll
                for (int e = 0; e < 8; ++e) x[i][e] = 0.f; }
            else { const float* s = a.in(6) + ((size_t)(l * 32 + b) * 3 + i) * 896 + col; const f32x4 s0 = *(const f32x4*)s, s1 = *(const f32x4*)(s + 4);
#pragma unroll
                for (int e = 0; e < 4; ++e) { x[i][e] = s0[e]; x[i][4 + e] = s1[e]; } } }
        float wv[4][8], bv[8];
#pragma unroll
        for (int i = 0; i < 4; ++i) { const f32x4 w0 = *(const f32x4*)(cw + i * 896 + col), w1 = *(const f32x4*)(cw + i * 896 + col + 4);
#pragma unroll
            for (int e = 0; e < 4; ++e) { wv[i][e] = w0[e]; wv[i][4 + e] = w1[e]; } }
        { const f32x4 b0 = *(const f32x4*)(cb + col), b1 = *(const f32x4*)(cb + col + 4);
#pragma unroll
          for (int e = 0; e < 4; ++e) { bv[e] = b0[e]; bv[4 + e] = b1[e]; } }
#pragma unroll
        for (int j = 0; j < 4; ++j) { float y[8];
#pragma unroll
            for (int e = 0; e < 8; ++e) { float acc = bv[e];
#pragma unroll
                for (int i = 0; i < 4; ++i) acc += wv[i][e] * x[j + i][e];
                y[e] = acc * sigmoidf_(acc); }
            v4u o; o.x = pg8::cvt_pk_bf16(y[0], y[1]); o.y = pg8::cvt_pk_bf16(y[2], y[3]); o.z = pg8::cvt_pk_bf16(y[4], y[5]); o.w = pg8::cvt_pk_bf16(y[6], y[7]);
            *(v4u*)(XC + (size_t)(row0 + j) * 896 + col) = o; }
    }
    for (int idx = gtid; idx < TOK * 6; idx += GT) { const int row = idx / 6, h = idx - row * 6;
        DT[(size_t)row * 8 + h] = softplusf_(bf2f(P[(size_t)row * NPP + C_DT + h]) + a.in(28)[l * 6 + h]); }
    for (int idx = gtid; idx < 40 * 1024; idx += GT) { const int s = idx >> 10, col = idx & 1023;
        const int row = (s < 8) ? s * 2048 + 2047 : TP + (s - 8) * 4 + 3;
        float* dst = (s < 8) ? out + O_PSH + (size_t)(l * 8 + s) * 1024 + col : out + O_SSH + (size_t)(l * 32 + s - 8) * 1024 + col;
        *dst = bf2f(P[(size_t)row * NPP + col]); }
    for (int idx = gtid; idx < 40 * 2688; idx += GT) { const int s = idx / 2688, rem = idx - s * 2688, i = rem / 896, col = rem - i * 896;
        const int row = (s < 8) ? s * 2048 + 2045 + i : TP + (s - 8) * 4 + 1 + i;
        float* dst = (s < 8) ? out + O_PC + ((size_t)(l * 8 + s) * 3 + i) * 896 + col : out + O_SC + ((size_t)(l * 32 + s - 8) * 3 + i) * 896 + col;
        *dst = bf2f(P[(size_t)row * NPP + C_XBC + col]); }
}

#define LBAR() asm volatile("s_waitcnt lgkmcnt(0)\n\ts_barrier" ::: "memory")
typedef short v4i16_t __attribute__((ext_vector_type(4)));
constexpr int CB_BYTES = 15872;
__device__ __forceinline__ v4i16_t tr4(const LAS bf16* T, int pitch, int col0, int lane) {
    return __builtin_amdgcn_ds_read_tr16_b64_v4i16((LAS v4i16_t*)(T + (4 * (lane >> 4) + ((lane & 15) >> 2)) * pitch + col0 + 4 * (lane & 3)));
}
typedef __bf16 bf2_t __attribute__((ext_vector_type(2))); typedef float f2v_t __attribute__((ext_vector_type(2)));
__device__ __forceinline__ unsigned cvt_pk_c(float lo, float hi) { const f2v_t v = {lo, hi}; return __builtin_bit_cast(unsigned, __builtin_convertvector(v, bf2_t)); }
__device__ __forceinline__ v4i16_t pack4(f32x4 x) { union { v4i16_t v; unsigned u[2]; } p; p.u[0] = cvt_pk_c(x[0], x[1]); p.u[1] = cvt_pk_c(x[2], x[3]); return p.v; }
PHASE_FN __device__ void rwkv_scan_unit(const KA a, int l, int unit, LAS unsigned char* lds, int tid) {
    int b, h, tile0, nch, seg, row_base; const float* s0; float* sout;
    if (unit < 32) { b = unit >> 2; h = unit & 3; tile0 = b * 128; nch = 128; seg = -1; row_base = b * 2048; s0 = nullptr; sout = a.out() + O_PR + (size_t)((l * 8 + b) * 4 + h) * 4096; }
    else { const int u = unit - 32; b = u >> 2; h = u & 3; tile0 = TP / 16 + (b >> 2); nch = 1; seg = b & 3; row_base = TP + b * 4; s0 = a.in(5) + (size_t)((l * 32 + b) * 4 + h) * 4096; sout = a.out() + O_SR + (size_t)((l * 32 + b) * 4 + h) * 4096; }
    const int lane = tid & 63, wave = __builtin_amdgcn_readfirstlane(tid >> 6), c16 = lane & 15, g = lane >> 4;
    const unsigned char* REC = a.ws() + WS_REC; bf16* YS = (bf16*)(a.ws() + WS_YS);
    LAS unsigned char* cbuf = lds;
    LAS bf16* SbAll = (LAS bf16*)(lds + 2 * CB_BYTES);
    if (wave >= 4) {
        const int ht = tid - 256;
        v4u ra[4], rb[4];
#define SC_FETCH(R, cc) do { const unsigned char* src_ = REC + (size_t)((tile0 + (cc)) * 4 + h) * REC_BYTES; \
            _Pragma("unroll") for (int q = 0; q < 4; ++q) { const int ci = ht + 256 * q; R[q] = *(const v4u*)(src_ + (ci < 832 ? ci : 831) * 16); } } while (0)
#define SC_PUT(R, cc) do { LAS unsigned char* dst_ = cbuf + ((cc) & 1) * CB_BYTES; \
            _Pragma("unroll") for (int q = 0; q < 4; ++q) { const int ci = ht + 256 * q; \
                if (ci < 640) { const int m_ = ci >> 7, r_ = (ci & 127) >> 3, k_ = ci & 7; *(LAS v4u*)(dst_ + m_ * 2560 + r_ * 160 + k_ * 16) = R[q]; } \
                else if (ci < 832) *(LAS v4u*)(dst_ + 12800 + (ci - 640) * 16) = R[q]; } } while (0)
#define SC_HELP(c, RL, RW) do { if ((c) + 2 < nch) SC_FETCH(RL, (c) + 2); if ((c) + 1 < nch) SC_PUT(RW, (c) + 1); LBAR(); } while (0)
        SC_FETCH(ra, 0); SC_PUT(ra, 0);
        if (1 < nch) SC_FETCH(rb, 1);
        LBAR();
        for (int c = 0; c < nch; c += 2) {
            SC_HELP(c, ra, rb);
            if (c + 1 < nch) SC_HELP(c + 1, rb, ra);
        }
#undef SC_HELP
#undef SC_PUT
#undef SC_FETCH
    } else {
        const int it = wave;
        LAS bf16* Sb = SbAll + it * (16 * 72);
        f32x4 S[4];
#pragma unroll
        for (int jt = 0; jt < 4; ++jt)
#pragma unroll
            for (int e = 0; e < 4; ++e) S[jt][e] = s0 ? s0[(size_t)(16 * it + 4 * g + e) * 64 + 16 * jt + c16] : 0.f;
        const bool mine = (seg < 0) || (g == seg);
        const v4i16_t zf = (v4i16_t){0, 0, 0, 0};
        LBAR();
        for (int c = 0; c < nch; ++c) {
            const LAS unsigned char* cb = cbuf + (c & 1) * CB_BYTES;
            const LAS bf16* At = (const LAS bf16*)cb; const LAS bf16* Rt = At + 1280; const LAS bf16* Bt = At + 2560; const LAS bf16* Kt = At + 3840; const LAS bf16* Vt = At + 5120;
            const LAS bf16* Nka = (const LAS bf16*)(cb + 12800); const LAS bf16* Nbr = Nka + 256; const LAS bf16* Nkr = Nka + 512; const LAS bf16* Tm = Nka + 768;
            const LAS float* Gam = (const LAS float*)(cb + 14848) + (seg < 0 ? 0 : seg) * 64;
#pragma unroll
            for (int jt = 0; jt < 4; ++jt)
#pragma unroll
                for (int e = 0; e < 4; ++e) Sb[(4 * g + e) * 72 + 16 * jt + c16] = f2bf_s(S[jt][e]);
            asm volatile("s_waitcnt lgkmcnt(0)" ::: "memory");
            const bf16x8 sb0 = *(const LAS bf16x8*)(Sb + c16 * 72 + 8 * g), sb1 = *(const LAS bf16x8*)(Sb + c16 * 72 + 32 + 8 * g);
            v4i16_t fV = tr4(Vt, 80, 16 * it, lane); if (!mine) fV = zf;
            f32x4 a0 = __builtin_amdgcn_mfma_f32_16x16x32_bf16(*(const LAS bf16x8*)(At + c16 * 80 + 8 * g), sb0, (f32x4){0.f, 0.f, 0.f, 0.f}, 0, 0, 0);
            a0 = __builtin_amdgcn_mfma_f32_16x16x32_bf16(*(const LAS bf16x8*)(At + c16 * 80 + 32 + 8 * g), sb1, a0, 0, 0, 0);
            a0 = __builtin_amdgcn_mfma_f32_16x16x16bf16_1k(tr4(Nka, 16, 0, lane), fV, a0, 0, 0, 0);
            const f32x4 ut = __builtin_amdgcn_mfma_f32_16x16x16bf16_1k(tr4(Tm, 16, 0, lane), pack4(a0), (f32x4){0.f, 0.f, 0.f, 0.f}, 0, 0, 0);
            v4i16_t utp = pack4(ut); if (!mine) utp = zf;
            f32x4 z = __builtin_amdgcn_mfma_f32_16x16x32_bf16(sb0, *(const LAS bf16x8*)(Rt + c16 * 80 + 8 * g), (f32x4){0.f, 0.f, 0.f, 0.f}, 0, 0, 0);
            z = __builtin_amdgcn_mfma_f32_16x16x32_bf16(sb1, *(const LAS bf16x8*)(Rt + c16 * 80 + 32 + 8 * g), z, 0, 0, 0);
            z = __builtin_amdgcn_mfma_f32_16x16x16bf16_1k(utp, tr4(Nbr, 16, 0, lane), z, 0, 0, 0);
            z = __builtin_amdgcn_mfma_f32_16x16x16bf16_1k(fV, tr4(Nkr, 16, 0, lane), z, 0, 0, 0);
            { const int row = (seg < 0) ? row_base + 16 * c + c16 : row_base + (c16 & 3);
              if (seg < 0 || (c16 >> 2) == seg) *(v2u*)(YS + (size_t)row * 256 + h * 64 + 16 * it + 4 * g) = pk4(z); }
#pragma unroll
            for (int jt = 0; jt < 4; ++jt) { f32x4 acc = __builtin_amdgcn_mfma_f32_16x16x16bf16_1k(utp, tr4(Bt, 80, 16 * jt, lane), S[jt], 0, 0, 0);
                acc = __builtin_amdgcn_mfma_f32_16x16x16bf16_1k(fV, tr4(Kt, 80, 16 * jt, lane), acc, 0, 0, 0);
                S[jt] = acc * Gam[16 * jt + c16]; }
            LBAR();
        }
#pragma unroll
        for (int jt = 0; jt < 4; ++jt)
#pragma unroll
            for (int e = 0; e < 4; ++e) sout[(size_t)(16 * it + 4 * g + e) * 64 + 16 * jt + c16] = S[jt][e];
    }
}

constexpr int SD_PC = 144, SD_PX = 80;
__device__ __forceinline__ bf16x8 tr_frag(const LAS bf16* T, int pitch, int k0, int col0, int lane) {
    const int g = lane >> 4, q = (lane & 15) >> 2, p = lane & 3;
    const LAS bf16* a0 = T + (k0 + 8 * g + q) * pitch + col0 + 4 * p;
    union { bf16x8 v; v4i16_t h[2]; } f;
    f.h[0] = __builtin_amdgcn_ds_read_tr16_b64_v4i16((LAS v4i16_t*)a0); f.h[1] = __builtin_amdgcn_ds_read_tr16_b64_v4i16((LAS v4i16_t*)(a0 + 4 * pitch));
    return f.v;
}
PHASE_FN __device__ void ssd_unit(const KA a, int l, int unit, LAS unsigned char* lds, int tid) {
    int b, h, row_base, T; const float* h0; float* hout;
    if (unit < 48) { b = unit / 6; h = unit - b * 6; row_base = b * 2048; T = 2048; h0 = nullptr; hout = a.out() + O_PS + (size_t)((l * 8 + b) * 6 + h) * 8192; }
    else { const int u = unit - 48; b = u / 6; h = u - b * 6; row_base = TP + b * 4; T = 4; h0 = a.in(7) + (size_t)((l * 32 + b) * 6 + h) * 8192; hout = a.out() + O_SS + (size_t)((l * 32 + b) * 6 + h) * 8192; }
    const int g = h / 3, lane = tid & 63, wave = __builtin_amdgcn_readfirstlane(tid >> 6), fr = lane & 15, fq = lane >> 4;
    LAS bf16* Cs = (LAS bf16*)lds;
    LAS bf16* Bs = Cs + 64 * SD_PC;
    LAS bf16* hb = Bs + 64 * SD_PC;
    LAS bf16* xs = hb + 64 * SD_PC;
    LAS bf16* xw = xs + 64 * SD_PX;
    LAS bf16* Sc = xw + 64 * SD_PX;
    LAS float* dt_all = (LAS float*)(Sc + 64 * SD_PX);
    LAS float* ac_all = dt_all + 2048;
    LAS float* a_tmp = ac_all + 2048;
    const bf16* XC = (const bf16*)(a.ws() + WS_XC); const float* DT = (const float*)(a.ws() + WS_DT); bf16* YC = (bf16*)(a.ws() + WS_YC);
    const float A = -__expf(a.in(29)[l * 6 + h]), Dh = a.in(30)[l * 6 + h];
    const int nch = (T + 63) >> 6, TPAD = nch * 64;
    { f32x4 d = (f32x4){0.f, 0.f, 0.f, 0.f};
      if (4 * tid < TPAD) {
#pragma unroll
          for (int e = 0; e < 4; ++e) d[e] = (4 * tid + e < T) ? DT[(size_t)(row_base + 4 * tid + e) * 8 + h] : 0.f;
          *(LAS f32x4*)(dt_all + 4 * tid) = d; *(LAS f32x4*)(a_tmp + 4 * tid) = d * A; }
      __syncthreads();
      if (4 * tid < TPAD) { const int c0 = (4 * tid) & ~63; float s = 0.f;
          for (int k = c0; k < 4 * tid; k += 4) { const f32x4 v = *(const LAS f32x4*)(a_tmp + k); s += (v[0] + v[1]) + (v[2] + v[3]); }
          f32x4 o; o[0] = s + d[0] * A; o[1] = o[0] + d[1] * A; o[2] = o[1] + d[2] * A; o[3] = o[2] + d[3] * A;
          *(LAS f32x4*)(ac_all + 4 * tid) = o; } }
    const int pt = wave >> 1, nt0 = (wave & 1) * 4;
    f32x4 hs[4];
#pragma unroll
    for (int q = 0; q < 4; ++q)
#pragma unroll
        for (int e = 0; e < 4; ++e) hs[q][e] = h0 ? h0[(size_t)(16 * pt + 4 * fq + e) * 128 + 16 * (nt0 + q) + fr] : 0.f;
    v4u pC[2], pB[2], pX;
    const v4u z4 = (v4u){0u, 0u, 0u, 0u};
#pragma unroll
    for (int q = 0; q < 2; ++q) { const int idx = tid + NTHR * q, r = idx >> 4, pc = idx & 15;
        pC[q] = (r < T) ? *(const v4u*)(XC + (size_t)(row_base + r) * 896 + 640 + g * 128 + pc * 8) : z4; pB[q] = (r < T) ? *(const v4u*)(XC + (size_t)(row_base + r) * 896 + 384 + g * 128 + pc * 8) : z4; }
    pX = ((tid >> 3) < T) ? *(const v4u*)(XC + (size_t)(row_base + (tid >> 3)) * 896 + h * 64 + (tid & 7) * 8) : z4;
    LBAR();
    for (int c = 0; c < nch; ++c) {
        const int r0 = row_base + c * 64, nv = (T - c * 64) < 64 ? (T - c * 64) : 64;
        const LAS float* acum = ac_all + c * 64; const LAS float* dtv = dt_all + c * 64;
        const float alast = acum[63];
#pragma unroll
        for (int q = 0; q < 4; ++q)
#pragma unroll
            for (int e = 0; e < 4; ++e) hb[(16 * pt + 4 * fq + e) * SD_PC + 16 * (nt0 + q) + fr] = f2bf_s(hs[q][e]);
#pragma unroll
        for (int q = 0; q < 2; ++q) { const int idx = tid + NTHR * q, r = idx >> 4, pc = idx & 15;
            *(LAS v4u*)(Cs + r * SD_PC + pc * 8) = pC[q]; *(LAS v4u*)(Bs + r * SD_PC + pc * 8) = pB[q]; }
        { const int r = tid >> 3, pc = tid & 7; const float te = __expf(alast - acum[r]) * dtv[r];
          *(LAS v4u*)(xs + r * SD_PX + pc * 8) = pX;
          v4u w; w.x = pg8::cvt_pk_bf16(bflo(pX.x) * te, bfhi(pX.x) * te); w.y = pg8::cvt_pk_bf16(bflo(pX.y) * te, bfhi(pX.y) * te); w.z = pg8::cvt_pk_bf16(bflo(pX.z) * te, bfhi(pX.z) * te); w.w = pg8::cvt_pk_bf16(bflo(pX.w) * te, bfhi(pX.w) * te);
          *(LAS v4u*)(xw + r * SD_PX + pc * 8) = w; }
        if (c + 1 < nch) { const int rn = r0 + 64, nvn = (T - (c + 1) * 64) < 64 ? (T - (c + 1) * 64) : 64;
#pragma unroll
            for (int q = 0; q < 2; ++q) { const int idx = tid + NTHR * q, r = idx >> 4, pc = idx & 15;
                pC[q] = (r < nvn) ? *(const v4u*)(XC + (size_t)(rn + r) * 896 + 640 + g * 128 + pc * 8) : z4; pB[q] = (r < nvn) ? *(const v4u*)(XC + (size_t)(rn + r) * 896 + 384 + g * 128 + pc * 8) : z4; }
            pX = ((tid >> 3) < nvn) ? *(const v4u*)(XC + (size_t)(rn + (tid >> 3)) * 896 + h * 64 + (tid & 7) * 8) : z4; }
        LBAR();
        const int lt = wave >> 1;
#pragma unroll 1
        for (int q = 0; q < 2; ++q) { const int st = (wave & 1) * 2 + q;
            f32x4 gacc = tile_mma<128>((f32x4){0.f, 0.f, 0.f, 0.f}, Cs + lt * 16 * SD_PC, SD_PC, Bs + st * 16 * SD_PC, SD_PC, lane);
            const int s = 16 * st + fr; const float as = acum[s], ds = dtv[s];
#pragma unroll
            for (int e = 0; e < 4; ++e) { const int ll = 16 * lt + 4 * fq + e; const float v = (s <= ll) ? gacc[e] * __expf(acum[ll] - as) * ds : 0.f; Sc[ll * SD_PX + s] = f2bf_s(v); } }
        LBAR();
#pragma unroll 1
        for (int q = 0; q < 2; ++q) { const int ptl = (wave & 1) * 2 + q;
            f32x4 yi = (f32x4){0.f, 0.f, 0.f, 0.f};
#pragma unroll
            for (int ks = 0; ks < 2; ++ks) yi = __builtin_amdgcn_mfma_f32_16x16x32_bf16(*(const LAS bf16x8*)(Sc + (lt * 16 + fr) * SD_PX + 32 * ks + 8 * fq), tr_frag(xs, SD_PX, 32 * ks, 16 * ptl, lane), yi, 0, 0, 0);
            const f32x4 yo = tile_mma<128>((f32x4){0.f, 0.f, 0.f, 0.f}, Cs + lt * 16 * SD_PC, SD_PC, hb + ptl * 16 * SD_PC, SD_PC, lane);
            const int p = 16 * ptl + fr;
#pragma unroll
            for (int e = 0; e < 4; ++e) { const int ll = 16 * lt + 4 * fq + e;
                if (ll < nv) YC[(size_t)(r0 + ll) * 384 + h * 64 + p] = f2bf_s(yi[e] + __expf(acum[ll]) * yo[e] + Dh * bf2f(xs[ll * SD_PX + p])); } }
        { const float cd = __expf(alast);
#pragma unroll
          for (int q = 0; q < 4; ++q) hs[q] = hs[q] * cd;
#pragma unroll
          for (int ks = 0; ks < 2; ++ks) { const bf16x8 af = tr_frag(xw, SD_PX, 32 * ks, 16 * pt, lane);
#pragma unroll
              for (int q = 0; q < 4; ++q) hs[q] = __builtin_amdgcn_mfma_f32_16x16x32_bf16(af, tr_frag(Bs, SD_PC, 32 * ks, 16 * (nt0 + q), lane), hs[q], 0, 0, 0); } }
        LBAR();
    }
#pragma unroll
    for (int q = 0; q < 4; ++q)
#pragma unroll
        for (int e = 0; e < 4; ++e) hout[(size_t)(16 * pt + 4 * fq + e) * 128 + 16 * (nt0 + q) + fr] = hs[q][e];
}

constexpr int AT_PV = 264, AT_PK = 72;
__device__ __forceinline__ void attn_prompt_unit(const KA a, int l, int su, LAS unsigned char* lds, int tid) {
    const int quarter = su & 3, bhbr = su >> 2, br = bhbr % 3, bh = bhbr / 3, b = bh / 6, h = bh - b * 6;
    const int dil = (br == 0) ? 1 : (br == 1 ? 4 : 16), nblk = 16 / dil;
    const int lane = tid & 63, wave = __builtin_amdgcn_readfirstlane(tid >> 6), fr = lane & 15, fq = lane >> 4;
    const bf16* P = (const bf16*)(a.ws() + WS_P);
    LAS bf16* VT = (LAS bf16*)lds;
    LAS bf16* KL = VT + 64 * AT_PV;
    const size_t rowb = (size_t)b * 2048;
    const int kj_s = tid >> 1, hf = tid & 1, qi = 16 * wave + fr;
    const float slope = exp2f(-8.0f * (float)(h + 1) / 6.0f) * (float)dil;
    bf16* AP = (bf16*)(a.ws() + WS_AP) + (size_t)br * TOK * 384; float* AM = (float*)(a.ws() + WS_AM) + (size_t)br * TOK * 8; float* AL = (float*)(a.ws() + WS_AL) + (size_t)br * TOK * 8;
    v4u pv[4], pk[4]; bf16x8 q0, q1;
#define AT_LOAD(cn_) do { const int cls_ = (cn_) / nblk, n_ = (cn_) - cls_ * nblk; int ks_ = (n_ - 1) * 128 + kj_s; if (ks_ < 0) ks_ = 0; \
        const bf16* src_ = P + (rowb + (size_t)ks_ * dil + cls_) * NPP + h * 64 + hf * 32; \
        _Pragma("unroll") for (int q_ = 0; q_ < 4; ++q_) { pv[q_] = *(const v4u*)(src_ + C_V + q_ * 8); pk[q_] = *(const v4u*)(src_ + C_K + q_ * 8); } \
        const bf16* qp_ = P + (rowb + (size_t)(n_ * 128 + qi) * dil + cls_) * NPP + C_Q + h * 64 + 8 * fq; q0 = *(const bf16x8*)qp_; q1 = *(const bf16x8*)(qp_ + 32); } while (0)
    AT_LOAD(quarter * 4);
#pragma unroll 1
    for (int j = 0; j < 4; ++j) {
        const int cn = quarter * 4 + j, cls = cn / nblk, n = cn - cls * nblk;
#pragma unroll
        for (int q = 0; q < 4; ++q) { *(LAS v4u*)(KL + kj_s * AT_PK + hf * 32 + q * 8) = pk[q]; const unsigned wv[4] = {pv[q].x, pv[q].y, pv[q].z, pv[q].w};
#pragma unroll
            for (int e = 0; e < 4; ++e) { VT[(hf * 32 + q * 8 + 2 * e) * AT_PV + kj_s] = (bf16)(wv[e] & 0xffffu); VT[(hf * 32 + q * 8 + 2 * e + 1) * AT_PV + kj_s] = (bf16)(wv[e] >> 16); } }
        const bf16x8 cq0 = q0, cq1 = q1;
        if (j < 3) AT_LOAD(cn + 1);
        LBAR();
        const int ktlo = (n == 0 && wave < 8) ? (8 > wave ? 8 : wave) : wave, kthi = wave + 8;
        const float sl4[4] = {0.f, slope, 2.f * slope, 3.f * slope};
#define AT_SCORE(acc_, kt_) do { const LAS bf16* kp_ = KL + (16 * (kt_) + fr) * AT_PK + 8 * fq; \
            acc_ = __builtin_amdgcn_mfma_f32_16x16x32_bf16(*(const LAS bf16x8*)kp_, cq0, (f32x4){0.f, 0.f, 0.f, 0.f}, 0, 0, 0); \
            acc_ = __builtin_amdgcn_mfma_f32_16x16x32_bf16(*(const LAS bf16x8*)(kp_ + 32), cq1, acc_, 0, 0, 0); \
            const int d0_ = 128 + qi - 16 * (kt_) - 4 * fq; const float b0_ = -slope * (float)d0_; \
            _Pragma("unroll") for (int e_ = 0; e_ < 4; ++e_) acc_[e_] = acc_[e_] * 0.125f + (b0_ + sl4[e_]); \
            if ((kt_) == wave || (kt_) == wave + 8) { _Pragma("unroll") for (int e_ = 0; e_ < 4; ++e_) { const int dl_ = d0_ - e_; if (dl_ < 0 || dl_ > 128) acc_[e_] = NEG_INF; } } } while (0)
        float m = NEG_INF;
#pragma unroll
        for (int rel = 0; rel < 9; ++rel) { const int kt = wave + rel;
            if (kt >= ktlo) { f32x4 acc; AT_SCORE(acc, kt); m = fmaxf(fmaxf(m, fmaxf(acc[0], acc[1])), fmaxf(acc[2], acc[3])); }
            if (rel & 1) asm volatile("" ::: "memory"); }
        m = pg8::xmax16(m); m = pg8::xmax32(m);
        float lsum = 0.f;
        f32x4 o[4];
#pragma unroll
        for (int dt = 0; dt < 4; ++dt) o[dt] = (f32x4){0.f, 0.f, 0.f, 0.f};
#pragma unroll
        for (int rel = 0; rel < 9; ++rel) { const int kt = wave + rel;
            if (kt >= ktlo) { f32x4 sc; AT_SCORE(sc, kt);
#pragma unroll
                for (int e = 0; e < 4; ++e) { sc[e] = __expf(sc[e] - m); lsum += sc[e]; }
                const v4i16_t pa = pack4(sc);
#pragma unroll
                for (int dt = 0; dt < 4; ++dt) { const v4i16_t vb = *(const LAS v4i16_t*)(VT + (16 * dt + fr) * AT_PV + 16 * kt + 4 * fq);
                    o[dt] = __builtin_amdgcn_mfma_f32_16x16x16bf16_1k(pa, vb, o[dt], 0, 0, 0); } }
            if (rel & 1) asm volatile("" ::: "memory"); }
#undef AT_SCORE
        lsum = pg8::xsum16(lsum); lsum = pg8::xsum32(lsum);
#pragma unroll
        for (int e = 0; e < 4; ++e) { const int qq = 16 * wave + 4 * fq + e; const size_t row = rowb + (size_t)(n * 128 + qq) * dil + cls;
#pragma unroll
            for (int dt = 0; dt < 4; ++dt) AP[row * 384 + h * 64 + 16 * dt + fr] = f2bf_s(o[dt][e]); }
        if (fq == 0) { const size_t row = rowb + (size_t)(n * 128 + qi) * dil + cls; AM[row * 8 + h] = m; AL[row * 8 + h] = lsum; }
        LBAR();
    }
#undef AT_LOAD
}

PHASE_FN __device__ void attn_sample_task(const KA a, int l, int task0, LAS unsigned char* lds, int tid) {
    const int lane = tid & 63, wave = __builtin_amdgcn_readfirstlane(tid >> 6), task = task0 + wave;
    const int t = task & 3, bh = task >> 2, b = bh / 6, h = bh - b * 6;
    const bf16* P = (const bf16*)(a.ws() + WS_P);
    const float* ck = a.in(2) + ((size_t)(l * 32 + b) * 2048) * 384 + h * 64; const float* cv = a.in(3) + ((size_t)(l * 32 + b) * 2048) * 384 + h * 64;
    const int row = TP + b * 4 + t;
    LAS float* pl = (LAS float*)lds + wave * 512;
    LAS float* q = pl + 448;
    q[lane] = bf2f(P[(size_t)row * NPP + C_Q + h * 64 + lane]) * 0.125f;
    asm volatile("s_waitcnt lgkmcnt(0)" ::: "memory");
    const float slope = exp2f(-8.0f * (float)(h + 1) / 6.0f);
    float m = NEG_INF;
#pragma unroll 1
    for (int ps = 0; ps < 7; ++ps) {
        const int e = ps * 64 + lane; float v = NEG_INF;
        if (e < 387) { const int br = e / 129, st = e - br * 129, dil = (br == 0) ? 1 : (br == 1 ? 4 : 16), idx = 2048 + t - dil * st;
            float dot = 0.f;
            if (idx >= 2048) { const bf16* kp = P + (size_t)(TP + b * 4 + (idx - 2048)) * NPP + C_K + h * 64;
#pragma unroll
                for (int i = 0; i < 8; ++i) { const v4u w = *(const v4u*)(kp + i * 8); const f32x4 qa = *(const LAS f32x4*)(q + 8 * i), qb = *(const LAS f32x4*)(q + 8 * i + 4); dot += qa[0] * bflo(w.x) + qa[1] * bfhi(w.x) + qa[2] * bflo(w.y) + qa[3] * bfhi(w.y) + qb[0] * bflo(w.z) + qb[1] * bfhi(w.z) + qb[2] * bflo(w.w) + qb[3] * bfhi(w.w); } }
            else { const float* kp = ck + (size_t)idx * 384;
#pragma unroll
                for (int i = 0; i < 8; ++i) { const f32x4 w = *(const f32x4*)(kp + 4 * i); const f32x4 qa = *(const LAS f32x4*)(q + 4 * i); dot += qa[0] * w[0] + qa[1] * w[1] + qa[2] * w[2] + qa[3] * w[3]; }
#pragma unroll
                for (int i = 8; i < 16; ++i) { const f32x4 w = *(const f32x4*)(kp + 4 * i); const f32x4 qa = *(const LAS f32x4*)(q + 4 * i); dot += qa[0] * w[0] + qa[1] * w[1] + qa[2] * w[2] + qa[3] * w[3]; } }
            v = dot - slope * (float)(dil * st); }
        pl[e] = v; m = fmaxf(m, v);
    }
    m = wave_max(m);
    float ls = 0.f;
#pragma unroll
    for (int ps = 0; ps < 7; ++ps) { const float p = __expf(pl[ps * 64 + lane] - m); ls += p; pl[ps * 64 + lane] = p; }
    ls = wave_sum(ls);
    asm volatile("s_waitcnt lgkmcnt(0)" ::: "memory");
    float acc = 0.f;
    const bf16* pvn = P + (size_t)(TP + b * 4) * NPP + C_V + h * 64 + lane;
#pragma unroll 1
    for (int br = 0; br < 3; ++br) { const int dil = (br == 0) ? 1 : (br == 1 ? 4 : 16); const LAS float* pb = pl + br * 129;
#pragma unroll 1
        for (int s0 = 0; s0 < 128; s0 += 32) { float vv[32];
#pragma unroll
            for (int j = 0; j < 32; ++j) { const int idx = 2048 + t - dil * (s0 + j);
                vv[j] = (idx >= 2048) ? bf2f(pvn[(size_t)(idx - 2048) * NPP]) : cv[(size_t)idx * 384 + lane]; }
#pragma unroll
            for (int j = 0; j < 32; ++j) acc += pb[s0 + j] * vv[j]; }
        { const int idx = 2048 + t - dil * 128; acc += pb[128] * cv[(size_t)idx * 384 + lane]; } }
    bf16* AP = (bf16*)(a.ws() + WS_AP); float* AM = (float*)(a.ws() + WS_AM); float* AL = (float*)(a.ws() + WS_AL);
    AP[(size_t)row * 384 + h * 64 + lane] = f2bf_s(acc); AP[((size_t)TOK + row) * 384 + h * 64 + lane] = 0; AP[((size_t)2 * TOK + row) * 384 + h * 64 + lane] = 0;
    if (lane == 0) { AM[(size_t)row * 8 + h] = m; AL[(size_t)row * 8 + h] = ls; AM[((size_t)TOK + row) * 8 + h] = NEG_INF; AL[((size_t)TOK + row) * 8 + h] = 0.f; AM[((size_t)2 * TOK + row) * 8 + h] = NEG_INF; AL[((size_t)2 * TOK + row) * 8 + h] = 0.f; }
}

PHASE_FN __device__ void post_rwkv(const KA a, int l, int tid) {
    const int lane = tid & 63, gw = blockIdx.x * NWAVES + __builtin_amdgcn_readfirstlane(tid >> 6); int NGW = gridDim.x * NWAVES; asm volatile("" : "+s"(NGW));
    const bf16* YS = (const bf16*)(a.ws() + WS_YS); const unsigned char* REC = a.ws() + WS_REC; const float* SC = (const float*)(a.ws() + WS_SC); const bf16* G = (const bf16*)(a.ws() + WS_G);
    bf16* YM = (bf16*)(a.ws() + WS_YM);
    float lw[4], lb[4];
#pragma unroll
    for (int hh = 0; hh < 4; ++hh) { lw[hh] = a.in(23)[l * 256 + hh * 64 + lane]; lb[hh] = a.in(24)[l * 256 + hh * 64 + lane]; }
    for (int row0 = gw * 2; row0 < TOK; row0 += 2 * NGW) {
        float v[2][4], ys[2][4], g[2][4], kr[2][4], bon[2][4];
#pragma unroll
        for (int r = 0; r < 2; ++r)
#pragma unroll
            for (int hh = 0; hh < 4; ++hh) { const int row = row0 + r, c = hh * 64 + lane;
                v[r][hh] = bf2f(*(const bf16*)(REC + (size_t)((row >> 4) * 4 + hh) * REC_BYTES + 8192 + ((row & 15) * 64 + lane) * 2)); ys[r][hh] = bf2f(YS[(size_t)row * 256 + c]); g[r][hh] = bf2f(G[(size_t)row * 256 + c]);
                kr[r][hh] = SC[(size_t)(row * 4 + hh) * 2]; bon[r][hh] = SC[(size_t)(row * 4 + hh) * 2 + 1]; }
#pragma unroll
        for (int r = 0; r < 2; ++r)
#pragma unroll
            for (int hh = 0; hh < 4; ++hh) { const float y = ys[r][hh] + v[r][hh] * kr[r][hh];
                const float mu = wave_sum(y) * (1.f / 64.f), d = y - mu, var = wave_sum(d * d) * (1.f / 64.f);
                const float yn = d * rsqrtf(var + GN_EPS) * lw[hh] + lb[hh];
                YM[(size_t)(row0 + r) * D + hh * 64 + lane] = f2bf_s((yn + bon[r][hh] * v[r][hh]) * g[r][hh]); }
    }
}
PHASE_FN __device__ void post_att(const KA a, int l, int tid) {
    const int lane = tid & 63, gw = blockIdx.x * NWAVES + __builtin_amdgcn_readfirstlane(tid >> 6); int NGW = gridDim.x * NWAVES; asm volatile("" : "+s"(NGW));
    const bf16* AP = (const bf16*)(a.ws() + WS_AP); const float* AM = (const float*)(a.ws() + WS_AM); const float* AL = (const float*)(a.ws() + WS_AL); bf16* YM = (bf16*)(a.ws() + WS_YM);
    float nw[6];
#pragma unroll
    for (int hd = 0; hd < 6; ++hd) nw[hd] = a.in(25)[l * 384 + hd * 64 + lane];
    for (int row0 = gw * 2; row0 < TOK; row0 += 2 * NGW) {
        float ap[2][3][6], am[2][3], al[2][3];
#pragma unroll
        for (int r = 0; r < 2; ++r)
#pragma unroll
            for (int br = 0; br < 3; ++br) { const size_t rb = (size_t)br * TOK + row0 + r;
                am[r][br] = AM[rb * 8 + (lane & 7)]; al[r][br] = AL[rb * 8 + (lane & 7)];
#pragma unroll
                for (int hd = 0; hd < 6; ++hd) ap[r][br][hd] = bf2f(AP[rb * 384 + hd * 64 + lane]); }
#pragma unroll
        for (int r = 0; r < 2; ++r) {
            const float M = fmaxf(am[r][0], fmaxf(am[r][1], am[r][2]));
            const float e0 = __expf(am[r][0] - M), e1 = __expf(am[r][1] - M), e2 = __expf(am[r][2] - M);
            const float inv = 1.0f / (e0 * al[r][0] + e1 * al[r][1] + e2 * al[r][2]);
            float ob[6], ss = 0.f;
#pragma unroll
            for (int hd = 0; hd < 6; ++hd) { const float w0 = __uint_as_float(__builtin_amdgcn_readlane(__float_as_uint(e0 * inv), hd));
                const float w1 = __uint_as_float(__builtin_amdgcn_readlane(__float_as_uint(e1 * inv), hd)), w2 = __uint_as_float(__builtin_amdgcn_readlane(__float_as_uint(e2 * inv), hd));
                ob[hd] = w0 * ap[r][0][hd] + w1 * ap[r][1][hd] + w2 * ap[r][2][hd]; ss += ob[hd] * ob[hd]; }
            ss = wave_sum(ss); const float rs = rsqrtf(ss * (1.f / 384.f) + NORM_EPS);
#pragma unroll
            for (int hd = 0; hd < 6; ++hd) YM[(size_t)(row0 + r) * D + 256 + hd * 64 + lane] = f2bf_s(ob[hd] * rs * nw[hd]);
        }
    }
}
PHASE_FN __device__ void post_ssd(const KA a, int l, int tid) {
    const int lane = tid & 63, gw = blockIdx.x * NWAVES + __builtin_amdgcn_readfirstlane(tid >> 6); int NGW = gridDim.x * NWAVES; asm volatile("" : "+s"(NGW));
    const bf16* YC = (const bf16*)(a.ws() + WS_YC); const bf16* P = (const bf16*)(a.ws() + WS_P); bf16* YM = (bf16*)(a.ws() + WS_YM);
    float nw[6];
#pragma unroll
    for (int hd = 0; hd < 6; ++hd) nw[hd] = a.in(31)[l * 384 + hd * 64 + lane];
    for (int row0 = gw * 2; row0 < TOK; row0 += 2 * NGW) {
        float yc[2][6], z[2][6];
#pragma unroll
        for (int r = 0; r < 2; ++r)
#pragma unroll
            for (int hd = 0; hd < 6; ++hd) { yc[r][hd] = bf2f(YC[(size_t)(row0 + r) * 384 + hd * 64 + lane]); z[r][hd] = bf2f(P[(size_t)(row0 + r) * NPP + C_Z + hd * 64 + lane]); }
#pragma unroll
        for (int r = 0; r < 2; ++r) { float ob[6], ss = 0.f;
#pragma unroll
            for (int hd = 0; hd < 6; ++hd) { ob[hd] = yc[r][hd] * (z[r][hd] * sigmoidf_(z[r][hd])); ss += ob[hd] * ob[hd]; }
            ss = wave_sum(ss); const float rs = rsqrtf(ss * (1.f / 384.f) + NORM_EPS);
#pragma unroll
            for (int hd = 0; hd < 6; ++hd) YM[(size_t)(row0 + r) * D + 640 + hd * 64 + lane] = f2bf_s(ob[hd] * rs * nw[hd]); }
    }
}
PHASE_FN __device__ void final_rows(const KA a, int tid) {
    const int lane = tid & 63, gw = blockIdx.x * NWAVES + __builtin_amdgcn_readfirstlane(tid >> 6); int NGW = gridDim.x * NWAVES; asm volatile("" : "+s"(NGW));
    const float* X = (const float*)(a.ws() + WS_X); const float* SSQ = (const float*)(a.ws() + WS_SSQ);
    for (int row = gw; row < TOK; row += NGW) {
        const float rs = pg8::row_rstd(SSQ, row);
        float* dst = (row < TP) ? a.out() + O_YP + (size_t)row * D : a.out() + O_YS + (size_t)(row - TP) * D;
#pragma unroll
        for (int j = 0; j < 4; ++j) { const f32x4 v = ((const f32x4*)(X + (size_t)row * D))[lane + 64 * j], w = ((const f32x4*)a.in(37))[lane + 64 * j]; ((f32x4*)dst)[lane + 64 * j] = v * rs * w; }
    }
}

constexpr int Q_SCAN = 32, Q_SSD = Q_SCAN + 48, Q_ATS = Q_SSD + 96, Q_ATT = Q_ATS + 576, Q_SCS = Q_ATT + 128, NU_MIX = Q_SCS + 192;
#ifndef REP_MIX
#define REP_MIX 1
#endif
#ifndef REP_PP
#define REP_PP 1
#endif
#ifndef REP_G
#define REP_G 1
#endif
#ifndef DUP_MASK
#define DUP_MASK 0
#endif
#ifndef REP_PRO
#define REP_PRO 1
#endif
#ifndef REP_R
#define REP_R 1
#endif

template <int KSTEPS> PHASE_FN __device__ void skinny_res(const KA a, size_t a_off, size_t b_off, float scale, int write_f32, LAS unsigned char* lds, int tid) {
    constexpr int K = KSTEPS * 32 * 4;
    const int lane = tid & 63, wave = __builtin_amdgcn_readfirstlane(tid >> 6), fr = lane & 15, fq = lane >> 4, ct = wave & 1, kq = wave >> 1;
    const bf16* A = (const bf16*)(a.ws() + a_off); const bf16* Bt = (const bf16*)(a.ws() + b_off);
    float* X = (float*)(a.ws() + WS_X); bf16* XB = (bf16*)(a.ws() + WS_XB); float* SSQ = (float*)(a.ws() + WS_SSQ);
    LAS f32x4* red = (LAS f32x4*)lds;
    for (int piece = blockIdx.x; piece < 256; piece += gridDim.x) {
        const int rt = piece >> 5, cg = piece & 31;
        const bf16* ap = A + (size_t)(TP + rt * 16 + fr) * K + kq * (K / 4) + 8 * fq; const bf16* wp = Bt + (size_t)(cg * 32 + ct * 16 + fr) * K + kq * (K / 4) + 8 * fq;
        f32x4 acc = (f32x4){0.f, 0.f, 0.f, 0.f};
#pragma unroll
        for (int ks = 0; ks < KSTEPS; ++ks) acc = __builtin_amdgcn_mfma_f32_16x16x32_bf16(*(const bf16x8*)(wp + 32 * ks), *(const bf16x8*)(ap + 32 * ks), acc, 0, 0, 0);
        red[wave * 64 + lane] = acc;
        __syncthreads();
        if (kq == 0) {
            acc = (red[ct * 64 + lane] + red[(ct + 2) * 64 + lane]) + (red[(ct + 4) * 64 + lane] + red[(ct + 6) * 64 + lane]);
            const int rl = rt * 16 + fr, row = TP + rl, c0 = cg * 32 + ct * 16 + 4 * fq;
            const f32x4 x = up4(*(const v2u*)(XB + (size_t)row * D + c0)) + acc * scale; if (write_f32) *(f32x4*)(X + (size_t)row * D + c0) = x;
            v2u w; w.x = pg8::cvt_pk_bf16(x[0], x[1]); w.y = pg8::cvt_pk_bf16(x[2], x[3]); *(v2u*)(XB + (size_t)row * D + c0) = w;
            float ss = (x[0] * x[0] + x[1] * x[1]) + (x[2] * x[2] + x[3] * x[3]); ss = pg8::xsum16(ss); ss = pg8::xsum32(ss);
            if (fq == 0) SSQ[pg8::SSQS_OFF + (size_t)rl * 64 + cg * 2 + ct] = ss;
        }
        __syncthreads();
    }
}
#define WT_REM0 ((gridDim.x == 256) ? WT_ITEMS : 0)
#define MIX_PHASE(QREP) \
        for (;;) { \
            { WSL(w); if (fresh_tid() == 0) MISC[0] = __hip_atomic_fetch_add((unsigned*)((gu32*)(w + WS_CTL) + CW_Q + 64 * (l + 4 * (QREP))), 1u, __ATOMIC_RELAXED, __HIP_MEMORY_SCOPE_AGENT); } \
            __syncthreads(); \
            const int u = (int)MISC[0]; \
            __syncthreads(); \
            if (u >= NU_MIX + ((l < DEPTH - 1) ? (I_LAYER - WT_REM0) / 8 : 0)) break; \
            if (u < Q_SCAN) { rwkv_scan_unit(make_ka(), l, u, lds, fresh_tid()); if (DUP_MASK & 1) { __syncthreads(); rwkv_scan_unit(make_ka(), l, u, lds, fresh_tid()); } } \
            else if (u < Q_SSD) { ssd_unit(make_ka(), l, u - Q_SCAN, lds, fresh_tid()); if (DUP_MASK & 2) { __syncthreads(); ssd_unit(make_ka(), l, u - Q_SCAN, lds, fresh_tid()); } } \
            else if (u < Q_ATS) { attn_sample_task(make_ka(), l, (u - Q_SSD) * 8, lds, fresh_tid()); if (DUP_MASK & 4) { __syncthreads(); attn_sample_task(make_ka(), l, (u - Q_SSD) * 8, lds, fresh_tid()); } } \
            else if (u < Q_ATT) { attn_prompt_unit(make_ka(), l, u - Q_ATS, lds, fresh_tid()); if (DUP_MASK & 8) { __syncthreads(); attn_prompt_unit(make_ka(), l, u - Q_ATS, lds, fresh_tid()); } } \
            else if (u < Q_SCS) { rwkv_scan_unit(make_ka(), l, 32 + (u - Q_ATT), lds, fresh_tid()); if (DUP_MASK & 16) { __syncthreads(); rwkv_scan_unit(make_ka(), l, 32 + (u - Q_ATT), lds, fresh_tid()); } } \
            else if (u < NU_MIX) { ssd_unit(make_ka(), l, 48 + (u - Q_SCS), lds, fresh_tid()); if (DUP_MASK & 32) { __syncthreads(); ssd_unit(make_ka(), l, 48 + (u - Q_SCS), lds, fresh_tid()); } } \
            else wconv_unit(make_ka(), l + 1, u - NU_MIX + WT_REM0 / 8, lds, fresh_tid()); \
        } \
        GRID_BAR();
__global__ void __launch_bounds__(NTHR, 2) hymba_fwd(KArgs args) {
    extern __shared__ __attribute__((aligned(16))) unsigned char lds_raw[];
    LAS unsigned char* lds = (LAS unsigned char*)lds_raw;
    volatile LAS unsigned* MISC = (volatile LAS unsigned*)(lds + MISC_OFF);
    { const int tid = threadIdx.x; for (int u = tid; u < (LDS_BYTES - LDSCTL_OFF) / 4; u += NTHR) ((LAS unsigned*)(lds + LDSCTL_OFF))[u] = 0u; }
    __syncthreads();
    XcdBarrier bar = xcd_barrier_post((unsigned*)((gu32*)(args.ws + WS_CTL) + CW_BAR), MISC + 8);
#define GRID_BAR() do { XcdBarrier b_ = bar; asm volatile("" : "+s"(b_.bar), "+s"(b_.x)); xcd_barrier(b_); } while (0)
#define WSL(name) unsigned char* name = make_ka().ws()
#define GL(name) int name = gridDim.x; asm volatile("" : "+s"(name)); int bx_ = blockIdx.x; asm volatile("" : "+s"(bx_))

#ifndef NO_PRO
    p0_prologue(make_ka(), lds, fresh_tid()); p0_xinit(make_ka(), fresh_tid());
#endif
    GRID_BAR();
#if REP_PRO > 1
    p0_prologue(make_ka(), lds, fresh_tid()); p0_xinit(make_ka(), fresh_tid());
    GRID_BAR();
#endif
    for (int l = 0; l < DEPTH; ++l) {
        { WSL(w); GL(G); pg8::Gemm g{(const bf16*)(w + WS_XB), (const bf16*)(w + WS_W + (size_t)l * WL_SIZE + WL_GU1), MP, 2 * FF, D}; pg8::StaticOrder S; S.init(MP, 2 * FF, G, bx_, WGM_GU); pg8::EpiGU E{(bf16*)(w + WS_H), (const float*)(w + WS_SSQ)};
          pg8::gemm_phase<pg8::EpiGU, pg8::StaticOrder, true, true>(lds, g, S, E); }
        if (l < DEPTH - 1) wconv_tail(make_ka(), l + 1, 0, lds, fresh_tid());
        GRID_BAR();
#if REP_G > 1
        { WSL(w); GL(G); pg8::Gemm g{(const bf16*)(w + WS_XB), (const bf16*)(w + WS_W + (size_t)l * WL_SIZE + WL_GU1), MP, 2 * FF, D}; pg8::StaticOrder S; S.init(MP, 2 * FF, G, bx_, WGM_GU); pg8::EpiGU E{(bf16*)(w + WS_H), (const float*)(w + WS_SSQ)};
          pg8::gemm_phase<pg8::EpiGU, pg8::StaticOrder, true, true>(lds, g, S, E); }
        GRID_BAR();
#endif
        skinny_res<22>(make_ka(), WS_H, WS_W + (size_t)l * WL_SIZE + WL_D1, 0.5f, 0, lds, fresh_tid());
        { WSL(w); GL(G); pg8::Gemm g{(const bf16*)(w + WS_H), (const bf16*)(w + WS_W + (size_t)l * WL_SIZE + WL_D1), TP, D, FF}; pg8::StaticOrder S; S.init(TP, D, G, bx_, WGM_R); pg8::EpiRes E{(float*)nullptr, (bf16*)(w + WS_XB), (float*)(w + WS_SSQ), 0.5f};
          pg8::gemm_phase<pg8::EpiRes, pg8::StaticOrder, true, true>(lds, g, S, E); }
        GRID_BAR();
#if REP_R > 1
        skinny_res<22>(make_ka(), WS_H, WS_W + (size_t)l * WL_SIZE + WL_D1, 0.0f, 0, lds, fresh_tid());
        { WSL(w); GL(G); pg8::Gemm g{(const bf16*)(w + WS_H), (const bf16*)(w + WS_W + (size_t)l * WL_SIZE + WL_D1), TP, D, FF}; pg8::StaticOrder S; S.init(TP, D, G, bx_, WGM_R); pg8::EpiRes E{(float*)nullptr, (bf16*)(w + WS_XB), (float*)(w + WS_SSQ), 0.0f};
          pg8::gemm_phase<pg8::EpiRes, pg8::StaticOrder, true, true>(lds, g, S, E); }
        GRID_BAR();
#endif
        { WSL(w); GL(G); pg8::Gemm g{(const bf16*)(w + WS_XB), (const bf16*)(w + WS_W + (size_t)l * WL_SIZE + WL_IN), MP, NPP, D}; pg8::StaticOrder S; S.init(MP, NPP, G, bx_, WGM_IN); pg8::EpiIn E{(bf16*)(w + WS_P), (const float*)(w + WS_SSQ), make_ka().out(), l};
          pg8::gemm_phase<pg8::EpiIn, pg8::StaticOrder, true, true>(lds, g, S, E); }
        if (l < DEPTH - 1) wconv_tail(make_ka(), l + 1, 1, lds, fresh_tid());
        GRID_BAR();
#if REP_G > 1
        { WSL(w); GL(G); pg8::Gemm g{(const bf16*)(w + WS_XB), (const bf16*)(w + WS_W + (size_t)l * WL_SIZE + WL_IN), MP, NPP, D}; pg8::StaticOrder S; S.init(MP, NPP, G, bx_, WGM_IN); pg8::EpiIn E{(bf16*)(w + WS_P), (const float*)(w + WS_SSQ), make_ka().out(), l};
          pg8::gemm_phase<pg8::EpiIn, pg8::StaticOrder, true, true>(lds, g, S, E); }
        GRID_BAR();
#endif
#ifndef NO_PREP
        rwkv_prep(make_ka(), l, lds, fresh_tid());
#endif
#ifndef NO_PREPE
        prep_elementwise(make_ka(), l, fresh_tid());
#endif
        GRID_BAR();
#if REP_PP > 1
        rwkv_prep(make_ka(), l, lds, fresh_tid());
        prep_elementwise(make_ka(), l, fresh_tid());
        GRID_BAR();
#endif
        MIX_PHASE(0)
#if REP_MIX > 1
        MIX_PHASE(1)
#endif
#ifndef NO_POST
        post_rwkv(make_ka(), l, fresh_tid()); post_att(make_ka(), l, fresh_tid()); post_ssd(make_ka(), l, fresh_tid());
#endif
        GRID_BAR();
#if REP_PP > 1
        post_rwkv(make_ka(), l, fresh_tid()); post_att(make_ka(), l, fresh_tid()); post_ssd(make_ka(), l, fresh_tid());
        GRID_BAR();
#endif
        skinny_res<8>(make_ka(), WS_YM, WS_W + (size_t)l * WL_SIZE + WL_OUT, 1.0f, 0, lds, fresh_tid());
        { WSL(w); GL(G); pg8::Gemm g{(const bf16*)(w + WS_YM), (const bf16*)(w + WS_W + (size_t)l * WL_SIZE + WL_OUT), TP, D, D}; pg8::StaticOrder S; S.init(TP, D, G, bx_, WGM_R); pg8::EpiRes E{(float*)nullptr, (bf16*)(w + WS_XB), (float*)(w + WS_SSQ), 1.0f};
          pg8::gemm_phase<pg8::EpiRes, pg8::StaticOrder, true, true>(lds, g, S, E); }
        GRID_BAR();
#if REP_R > 1
        skinny_res<8>(make_ka(), WS_YM, WS_W + (size_t)l * WL_SIZE + WL_OUT, 0.0f, 0, lds, fresh_tid());
        { WSL(w); GL(G); pg8::Gemm g{(const bf16*)(w + WS_YM), (const bf16*)(w + WS_W + (size_t)l * WL_SIZE + WL_OUT), TP, D, D}; pg8::StaticOrder S; S.init(TP, D, G, bx_, WGM_R); pg8::EpiRes E{(float*)nullptr, (bf16*)(w + WS_XB), (float*)(w + WS_SSQ), 0.0f};
          pg8::gemm_phase<pg8::EpiRes, pg8::StaticOrder, true, true>(lds, g, S, E); }
        GRID_BAR();
#endif
        { WSL(w); GL(G); pg8::Gemm g{(const bf16*)(w + WS_XB), (const bf16*)(w + WS_W + (size_t)l * WL_SIZE + WL_GU2), MP, 2 * FF, D}; pg8::StaticOrder S; S.init(MP, 2 * FF, G, bx_, WGM_GU); pg8::EpiGU E{(bf16*)(w + WS_H), (const float*)(w + WS_SSQ)};
          pg8::gemm_phase<pg8::EpiGU, pg8::StaticOrder, true, true>(lds, g, S, E); }
        if (l < DEPTH - 1) wconv_tail(make_ka(), l + 1, 2, lds, fresh_tid());
        GRID_BAR();
#if REP_G > 1
        { WSL(w); GL(G); pg8::Gemm g{(const bf16*)(w + WS_XB), (const bf16*)(w + WS_W + (size_t)l * WL_SIZE + WL_GU2), MP, 2 * FF, D}; pg8::StaticOrder S; S.init(MP, 2 * FF, G, bx_, WGM_GU); pg8::EpiGU E{(bf16*)(w + WS_H), (const float*)(w + WS_SSQ)};
          pg8::gemm_phase<pg8::EpiGU, pg8::StaticOrder, true, true>(lds, g, S, E); }
        GRID_BAR();
#endif
        skinny_res<22>(make_ka(), WS_H, WS_W + (size_t)l * WL_SIZE + WL_D2, 0.5f, (l == DEPTH - 1) ? 1 : 0, lds, fresh_tid());
        { WSL(w); GL(G); pg8::Gemm g{(const bf16*)(w + WS_H), (const bf16*)(w + WS_W + (size_t)l * WL_SIZE + WL_D2), TP, D, FF}; pg8::StaticOrder S; S.init(TP, D, G, bx_, WGM_R); pg8::EpiRes E{((l == DEPTH - 1) ? (float*)(w + WS_X) : (float*)nullptr), (bf16*)(w + WS_XB), (float*)(w + WS_SSQ), 0.5f};
          pg8::gemm_phase<pg8::EpiRes, pg8::StaticOrder, true, true>(lds, g, S, E); }
        GRID_BAR();
#if REP_R > 1
        skinny_res<22>(make_ka(), WS_H, WS_W + (size_t)l * WL_SIZE + WL_D2, 0.0f, (l == DEPTH - 1) ? 1 : 0, lds, fresh_tid());
        { WSL(w); GL(G); pg8::Gemm g{(const bf16*)(w + WS_H), (const bf16*)(w + WS_W + (size_t)l * WL_SIZE + WL_D2), TP, D, FF}; pg8::StaticOrder S; S.init(TP, D, G, bx_, WGM_R); pg8::EpiRes E{((l == DEPTH - 1) ? (float*)(w + WS_X) : (float*)nullptr), (bf16*)(w + WS_XB), (float*)(w + WS_SSQ), 0.0f};
          pg8::gemm_phase<pg8::EpiRes, pg8::StaticOrder, true, true>(lds, g, S, E); }
        GRID_BAR();
#endif
    }
    final_rows(make_ka(), fresh_tid());
}

extern "C" void kernel_launch(void* const* d_in, const int* in_sizes, int n_in, void* d_out, int out_size, void* d_ws, size_t ws_size, hipStream_t stream) {
    static int grid = 0;
    if (grid == 0) {
        if (n_in != 38 || (size_t)out_size != O_END || ws_size < WS_END) { fprintf(stderr, "kernel_launch: unexpected shapes: n_in %d out %d ws %zu\n", n_in, out_size, ws_size); grid = -1; return; }
        int dev = 0, cus = 0, per_cu = 0;
        if (hipGetDevice(&dev) != hipSuccess || hipDeviceGetAttribute(&cus, hipDeviceAttributeMultiprocessorCount, dev) != hipSuccess) { grid = -1; return; }
        if (hipFuncSetAttribute((const void*)hymba_fwd, hipFuncAttributeMaxDynamicSharedMemorySize, LDS_BYTES) != hipSuccess) { fprintf(stderr, "kernel_launch: hipFuncSetAttribute failed\n"); grid = -1; return; }
        if (hipOccupancyMaxActiveBlocksPerMultiprocessor(&per_cu, (const void*)hymba_fwd, NTHR, LDS_BYTES) != hipSuccess || per_cu < 1) { fprintf(stderr, "kernel_launch: occupancy query says %d\n", per_cu); }
        (void)hipGetLastError();
        grid = cus;
    }
    if (grid < 0) return;
    if (hipMemsetAsync((char*)d_ws + WS_CTL, 0, CTL_ZERO_BYTES, stream) != hipSuccess) return;
    KArgs a{};
    for (int i = 0; i < 38; ++i) a.in[i] = (const float*)d_in[i];
    a.out = (float*)d_out; a.ws = (unsigned char*)d_ws;
    hipLaunchKernelGGL(hymba_fwd, dim3(grid), dim3(NTHR), LDS_BYTES, stream, a);
}
```

```cpp
#include <hip/hip_runtime.h>
#include <cstdio>
#include <cstdint>
namespace pg8 {
#define PG8_LAS __attribute__((address_space(3)))
typedef unsigned short bf16_t;
typedef short bf16x8 __attribute__((ext_vector_type(8)));
typedef float f32x4 __attribute__((ext_vector_type(4)));
typedef unsigned u32x4 __attribute__((ext_vector_type(4)));
constexpr int BM = 256, BK = 64, HALF = 128, HTB = HALF * BK * 2  , STAGE_BYTES = 8 * HTB, NXCD = 8, WGM = 4;

__host__ __device__ __forceinline__ int lds_byte(int r, int c) { const int st = (r >> 4) * 2 + (c >> 5), rr = r & 15, cc = c & 31, ob = rr * 64 + cc * 2; return st * 1024 + (ob ^ (((ob >> 9) & 1) << 5)); }
__host__ __device__ __forceinline__ void stage_rc(int b, int& R, int& C) { const int st = b / 1024, sb = b % 1024, swz = sb ^ (((sb >> 9) & 1) << 5); R = (st >> 1) * 16 + swz / 64; C = (st & 1) * 32 + (swz % 64) / 2; }
__host__ __device__ __forceinline__ int perm32(int rho) { const int n = rho >> 4, i = rho & 15; return 8 * (i >> 2) + 4 * n + (i & 3); }

struct Unit { int pm, pn; };
struct Gemm { const bf16_t* A; const bf16_t* Bt; int M, N, K; };

struct StaticOrder {
    int nM, nN, nwg, G, c, wgm;
    __host__ __device__ void init(int M, int N, int G_, int c_, int wgm_ = WGM) { nM = M / BM; nN = N / BM; nwg = nM * nN; G = G_; c = c_; wgm = wgm_; }
    __host__ __device__ bool next(int i, Unit& u) const {
        const long L = (long)i * G + c; if (L >= nwg) return false;
        int wgid = (int)L; { const int q = nwg / NXCD, r = nwg % NXCD, xcd = wgid % NXCD, off = wgid / NXCD; wgid = (xcd < r ? xcd * (q + 1) : r * (q + 1) + (xcd - r) * q) + off; }
        const int nig = wgm * nN, gid = wgid / nig, fm = gid * wgm, gsz = (nM - fm) < wgm ? (nM - fm) : wgm;
        u.pm = fm + ((wgid % nig) % gsz); u.pn = (wgid % nig) / gsz; return true;
    }
    __device__ __forceinline__ void a_ready(const Unit&) const {}
    __device__ __forceinline__ void done(const Unit&) const {}
};

typedef __bf16 bf2c_t __attribute__((ext_vector_type(2))); typedef float f2c_t __attribute__((ext_vector_type(2)));
__device__ __forceinline__ unsigned cvt_pk_bf16(float lo, float hi) { const f2c_t v = {lo, hi}; return __builtin_bit_cast(unsigned, __builtin_convertvector(v, bf2c_t)); }
typedef float f32x2 __attribute__((ext_vector_type(2)));

typedef unsigned u32x2 __attribute__((ext_vector_type(2)));
__device__ __forceinline__ float xsum16(float v) { const auto r = __builtin_amdgcn_permlane16_swap(__float_as_uint(v), __float_as_uint(v), false, false); return __uint_as_float(r[0]) + __uint_as_float(r[1]); }
__device__ __forceinline__ float xsum32(float v) { const auto r = __builtin_amdgcn_permlane32_swap(__float_as_uint(v), __float_as_uint(v), false, false); return __uint_as_float(r[0]) + __uint_as_float(r[1]); }
__device__ __forceinline__ float xmax16(float v) { const auto r = __builtin_amdgcn_permlane16_swap(__float_as_uint(v), __float_as_uint(v), false, false); return fmaxf(__uint_as_float(r[0]), __uint_as_float(r[1])); }
__device__ __forceinline__ float xmax32(float v) { const auto r = __builtin_amdgcn_permlane32_swap(__float_as_uint(v), __float_as_uint(v), false, false); return fmaxf(__uint_as_float(r[0]), __uint_as_float(r[1])); }
constexpr int E_FF = 2816, E_NPP = 3584, E_D = 1024;
constexpr int SSQS_OFF = 524288;
__device__ __forceinline__ float row_rstd(const float* ssq, int row) {
    float t;
    if (row < 16384) { const f32x4* sp = (const f32x4*)(ssq + (size_t)row * 16); const f32x4 s = (sp[0] + sp[1]) + (sp[2] + sp[3]); t = (s[0] + s[1]) + (s[2] + s[3]); }
    else { const f32x4* sp = (const f32x4*)(ssq + SSQS_OFF + (size_t)(row - 16384) * 64); f32x4 s = sp[0];
#pragma unroll
        for (int i = 1; i < 16; ++i) s += sp[i];
        t = (s[0] + s[1]) + (s[2] + s[3]); }
    return __builtin_amdgcn_rsqf(t * (1.0f / 1024.0f) + 1e-6f);
}
__device__ __forceinline__ float silu_f(float g) { return g * __builtin_amdgcn_rcpf(1.0f + __builtin_amdgcn_exp2f(-1.4426950408889634f * g)); }
__device__ __forceinline__ float row_rstd_coop(const float* ssq, int row, int fq) {
    float t;
    if (row < 16384) { const f32x4 s = ((const f32x4*)(ssq + (size_t)row * 16))[fq]; t = (s[0] + s[1]) + (s[2] + s[3]); }
    else { const f32x4* sp = (const f32x4*)(ssq + SSQS_OFF + (size_t)(row - 16384) * 64) + 4 * fq; const f32x4 s = (sp[0] + sp[1]) + (sp[2] + sp[3]); t = (s[0] + s[1]) + (s[2] + s[3]); }
    t = xsum16(t); t = xsum32(t);
    return __builtin_amdgcn_rsqf(t * (1.0f / 1024.0f) + 1e-6f);
}
struct EpiGU {
    static constexpr bool PERM = true, AFTER_DRAIN = false;
    bf16_t* H; const float* ssq; PG8_LAS float* rt;
    __device__ __forceinline__ void operator()(const f32x4 (&acc)[2][2][4][2], const Unit& u, int wr, int wc, int fr, int fq) const {
        const int row0 = u.pm * BM + wr * 64 + fr, hc0 = u.pn * 128 + wc * 16 + 4 * fq;
        if (wr == 0) { const int t_ = wc * 64 + fq * 16 + fr; rt[t_] = row_rstd(ssq, u.pm * BM + t_); }
        asm volatile("s_waitcnt lgkmcnt(0)\n\ts_barrier" ::: "memory");
#ifdef EPI_REP_GU
        int nrep_ = EPI_REP_GU; asm volatile("" : "+s"(nrep_));
#pragma unroll 1
        for (int rep_ = 0; rep_ < nrep_; ++rep_)
#endif
#pragma unroll
        for (int ai = 0; ai < 2; ++ai)
#pragma unroll
            for (int m = 0; m < 4; ++m) { const int row = row0 + ai * HALF + m * 16; const float rs = rt[wr * 64 + fr + ai * HALF + m * 16];
#pragma unroll
                for (int bj = 0; bj < 2; ++bj) { const f32x4 g = acc[ai][bj][m][0] * rs, up = acc[ai][bj][m][1] * rs;
                    u32x2 w; w.x = cvt_pk_bf16(silu_f(g[0]) * up[0], silu_f(g[1]) * up[1]); w.y = cvt_pk_bf16(silu_f(g[2]) * up[2], silu_f(g[3]) * up[3]);
                    *(u32x2*)(H + (size_t)row * E_FF + hc0 + bj * 64) = w; } asm volatile("" ::: "memory"); }
    }
};
struct EpiIn {
    static constexpr bool PERM = true, AFTER_DRAIN = false;
    bf16_t* P; const float* ssq; float* out; int l; PG8_LAS float* rt;
    __device__ __forceinline__ void operator()(const f32x4 (&acc)[2][2][4][2], const Unit& u, int wr, int wc, int fr, int fq) const {
        const int row0 = u.pm * BM + wr * 64 + fr, col0 = u.pn * BM + wc * 64 + 8 * fq;
        if (wr == 0) { const int t_ = wc * 64 + fq * 16 + fr; rt[t_] = row_rstd(ssq, u.pm * BM + t_); }
        asm volatile("s_waitcnt lgkmcnt(0)\n\ts_barrier" ::: "memory");
#ifdef EPI_REP_IN
        int nrep_ = EPI_REP_IN; asm volatile("" : "+s"(nrep_));
#pragma unroll 1
        for (int rep_ = 0; rep_ < nrep_; ++rep_)
#endif
#pragma unroll
        for (int ai = 0; ai < 2; ++ai)
#pragma unroll
            for (int m = 0; m < 4; ++m) { const int row = row0 + ai * HALF + m * 16; const float rs = rt[wr * 64 + fr + ai * HALF + m * 16];
#pragma unroll
                for (int bj = 0; bj < 2; ++bj) { const f32x4 v0 = acc[ai][bj][m][0] * rs, v1 = acc[ai][bj][m][1] * rs;
                    u32x4 w; w.x = cvt_pk_bf16(v0[0], v0[1]); w.y = cvt_pk_bf16(v0[2], v0[3]); w.z = cvt_pk_bf16(v1[0], v1[1]); w.w = cvt_pk_bf16(v1[2], v1[3]);
                    *(u32x4*)(P + (size_t)row * E_NPP + col0 + bj * 32) = w;
                    const int cb = u.pn * BM + wc * 64 + bj * 32;
                    if (cb >= 1408 && cb < 2176 && row < 16512) { const bool isv = cb >= 1792; const int cc = col0 + bj * 32 - (isv ? 1792 : 1408);
                        const size_t off = (row < 16384) ? (isv ? (size_t)42074112 : (size_t)16908288) + ((size_t)l * 16384 + row) * 384 : (isv ? (size_t)69652480 : (size_t)69455872) + ((size_t)l * 128 + (row - 16384)) * 384;
                        float* dst = out + off + cc;
                        *(f32x4*)dst = v0; *(f32x4*)(dst + 4) = v1; } } asm volatile("" ::: "memory"); }
    }
};
struct EpiRes {
    static constexpr bool PERM = true, AFTER_DRAIN = false;
    float* Xf; bf16_t* XB; float* ssq; float scale;
    __device__ __forceinline__ void operator()(const f32x4 (&acc)[2][2][4][2], const Unit& u, int wr, int wc, int fr, int fq) const {
        const int row0 = u.pm * BM + wr * 64 + fr, col0 = u.pn * BM + wc * 32 + 8 * fq;
#ifdef EPI_REP_RES
        int nrep_ = EPI_REP_RES; asm volatile("" : "+s"(nrep_));
#pragma unroll 1
        for (int rep_ = 0; rep_ < nrep_; ++rep_) { const float scale = rep_ ? 0.f : this->scale;
#else
        {
#endif
        u32x4 xo[2][4][2];
#pragma unroll
        for (int ai = 0; ai < 2; ++ai)
#pragma unroll
            for (int m = 0; m < 4; ++m)
#pragma unroll
                for (int bj = 0; bj < 2; ++bj) xo[ai][m][bj] = *(const u32x4*)(XB + (size_t)(row0 + ai * HALF + m * 16) * E_D + col0 + bj * HALF);
        asm volatile("" ::: "memory");
#pragma unroll
        for (int ai = 0; ai < 2; ++ai)
#pragma unroll
            for (int m = 0; m < 4; ++m) { const int row = row0 + ai * HALF + m * 16; float ss = 0.f;
#pragma unroll
                for (int bj = 0; bj < 2; ++bj) { bf16_t* xp = XB + (size_t)row * E_D + col0 + bj * HALF; const u32x4 o = xo[ai][m][bj];
                    f32x4 x0, x1;
                    x0[0] = __uint_as_float(o.x << 16); x0[1] = __uint_as_float(o.x & 0xffff0000u); x0[2] = __uint_as_float(o.y << 16); x0[3] = __uint_as_float(o.y & 0xffff0000u);
                    x1[0] = __uint_as_float(o.z << 16); x1[1] = __uint_as_float(o.z & 0xffff0000u); x1[2] = __uint_as_float(o.w << 16); x1[3] = __uint_as_float(o.w & 0xffff0000u);
                    x0 += acc[ai][bj][m][0] * scale; x1 += acc[ai][bj][m][1] * scale;
                    if (Xf) { float* fp = Xf + (size_t)row * E_D + col0 + bj * HALF; *(f32x4*)fp = x0; *(f32x4*)(fp + 4) = x1; }
                    ss += (x0[0] * x0[0] + x0[1] * x0[1]) + (x0[2] * x0[2] + x0[3] * x0[3]) + (x1[0] * x1[0] + x1[1] * x1[1]) + (x1[2] * x1[2] + x1[3] * x1[3]);
                    u32x4 w; w.x = cvt_pk_bf16(x0[0], x0[1]); w.y = cvt_pk_bf16(x0[2], x0[3]); w.z = cvt_pk_bf16(x1[0], x1[1]); w.w = cvt_pk_bf16(x1[2], x1[3]);
                    *(u32x4*)xp = w; }
                ss = xsum16(ss); ss = xsum32(ss);
                if (fq == 0) ssq[(size_t)row * 16 + u.pn * 4 + wc] = ss; if (m & 1) asm volatile("" ::: "memory"); }
        }
    }
};
template <class Epi, class Sched, bool ALIGN_EPI = false, bool SP2 = false>
__device__ __forceinline__ void gemm_phase(PG8_LAS unsigned char* lds, const Gemm g, const Sched& S, const Epi& E) {
    int tid = threadIdx.x; asm volatile("" : "+v"(tid)); const int wid = __builtin_amdgcn_readfirstlane(tid >> 6), lane = tid & 63, wr = wid >> 2, wc = wid & 3, fr = lane & 15, fq = lane >> 4;
    const int K = g.K, nt = K / BK;
    unsigned voffA[2], voffB[2];
#pragma unroll
    for (int i = 0; i < 2; ++i) { int R, C; stage_rc(tid * 16 + i * 8192, R, C); const int Rb = Epi::PERM ? ((R & ~31) + perm32(R & 31)) : R;
        voffA[i] = (unsigned)(R * K + C) * 2u; voffB[i] = (unsigned)(Rb * K + C) * 2u; }
    const size_t kstep = (size_t)(BK * 2);
    const size_t hstep = (size_t)HALF * K * 2;
    const size_t tstep = 2 * hstep;
    const unsigned ldsw = (unsigned)wid * 1024u;
    const int aoff = lds_byte(wr * 64 + fr, fq * 8), boff = lds_byte(wc * 32 + fr, fq * 8);
#define PG8_SA(b, h) (((b) * 2 + (h)) * HTB)
#define PG8_SB(b, h) ((4 + (b) * 2 + (h)) * HTB)
#define PG8_STAGE(bufoff, gbase, voff) do { _Pragma("unroll") for (int _i = 0; _i < 2; ++_i) \
        __builtin_amdgcn_global_load_lds((const unsigned*)((const char*)(gbase) + (voff)[_i]), (PG8_LAS unsigned*)(lds + (bufoff) + ldsw + _i * 8192), 16, 0, 0); } while (0)
#define PG8_LDA(dst, b, h) do { _Pragma("unroll") for (int m = 0; m < 4; ++m) _Pragma("unroll") for (int k = 0; k < 2; ++k) dst[m][k] = *(const PG8_LAS bf16x8*)(lds + PG8_SA(b, h) + aoff + m * 2048 + k * 1024); } while (0)
#define PG8_LDB(dst, b, h) do { _Pragma("unroll") for (int n = 0; n < 2; ++n) _Pragma("unroll") for (int k = 0; k < 2; ++k) dst[n][k] = *(const PG8_LAS bf16x8*)(lds + PG8_SB(b, h) + boff + n * 2048 + k * 1024); } while (0)
#define PG8_MMA(ai, bj, At, Bt) do { __builtin_amdgcn_s_setprio(1); _Pragma("unroll") for (int m = 0; m < 4; ++m) _Pragma("unroll") for (int n = 0; n < 2; ++n) _Pragma("unroll") for (int k = 0; k < 2; ++k) \
        acc[ai][bj][m][n] = __builtin_amdgcn_mfma_f32_16x16x32_bf16(Bt[n][k], At[m][k], acc[ai][bj][m][n], 0, 0, 0); __builtin_amdgcn_s_setprio(0); } while (0)
#define PG8_WAIT_V(n) asm volatile("s_waitcnt vmcnt(" #n ")" ::: "memory")
#define PG8_WAIT_L(n) asm volatile("s_waitcnt lgkmcnt(" #n ")" ::: "memory")
#define PG8_BAR __builtin_amdgcn_s_barrier()
#define PG8_SCHED __builtin_amdgcn_sched_barrier(0)
    Unit cur, nxt; int ui = 0;
    if (!S.next(0, cur)) return;
    f32x4 acc[2][2][4][2];
#pragma unroll
    for (int a = 0; a < 2; ++a)
#pragma unroll
        for (int b = 0; b < 2; ++b)
#pragma unroll
            for (int m = 0; m < 4; ++m)
#pragma unroll
                for (int n = 0; n < 2; ++n) acc[a][b][m][n] = (f32x4){0.f, 0.f, 0.f, 0.f};
    bf16x8 At[4][2], B0[2][2], B1[2][2];
    const char* cA = (const char*)g.A + (size_t)cur.pm * tstep; const char* cB = (const char*)g.Bt + (size_t)cur.pn * tstep;
    S.a_ready(cur);
    if constexpr (SP2) {
        PG8_STAGE(PG8_SB(0, 0), cB, voffB); PG8_STAGE(PG8_SB(0, 1), cB + hstep, voffB); PG8_STAGE(PG8_SA(0, 0), cA, voffA); PG8_STAGE(PG8_SA(0, 1), cA + hstep, voffA);
        if (wr == 1) PG8_BAR;
        PG8_WAIT_V(2); PG8_BAR;
        PG8_STAGE(PG8_SB(1, 0), cB + kstep, voffB); PG8_STAGE(PG8_SA(1, 0), cA + kstep, voffA); PG8_STAGE(PG8_SB(1, 1), cB + hstep + kstep, voffB);
        PG8_WAIT_V(6); PG8_BAR;
    } else {
        PG8_STAGE(PG8_SB(0, 0), cB, voffB); PG8_STAGE(PG8_SA(0, 0), cA, voffA); PG8_STAGE(PG8_SB(0, 1), cB + hstep, voffB); PG8_STAGE(PG8_SA(0, 1), cA + hstep, voffA);
        if (wr == 1) PG8_BAR;
        PG8_WAIT_V(4); PG8_BAR;
        PG8_STAGE(PG8_SB(1, 0), cB + kstep, voffB); PG8_STAGE(PG8_SA(1, 0), cA + kstep, voffA); PG8_STAGE(PG8_SB(1, 1), cB + hstep + kstep, voffB);
        PG8_WAIT_V(6); PG8_BAR;
    }
    for (;;) {
        const bool has_next = S.next(ui + 1, nxt);
        const char* nA = has_next ? (const char*)g.A + (size_t)nxt.pm * tstep : cA; const char* nB = has_next ? (const char*)g.Bt + (size_t)nxt.pn * tstep : cB;
        for (int t = 0; t < nt; t += 2) {
            const bool last = (t == nt - 2);
            const char* a1 = cA + (size_t)(t + 1) * kstep;
            const char* a2 = last ? nA : cA + (size_t)(t + 2) * kstep; const char* b2 = last ? nB : cB + (size_t)(t + 2) * kstep;
            const char* a3 = a2 + kstep; const char* b3 = b2 + kstep;
            if (last && has_next) S.a_ready(nxt);
            if constexpr (SP2) {
            PG8_LDB(B0, 0, 0); PG8_LDB(B1, 0, 1); PG8_SCHED; PG8_LDA(At, 0, 0); PG8_STAGE(PG8_SA(1, 1), a1 + hstep, voffA);
            PG8_WAIT_V(8); PG8_WAIT_L(0); PG8_BAR; PG8_MMA(0, 0, At, B0); PG8_MMA(0, 1, At, B1); PG8_BAR; PG8_SCHED;
            PG8_LDA(At, 0, 1); PG8_STAGE(PG8_SB(0, 0), b2, voffB); PG8_STAGE(PG8_SB(0, 1), b2 + hstep, voffB); PG8_STAGE(PG8_SA(0, 0), a2, voffA);
            PG8_WAIT_V(8); PG8_WAIT_L(0); PG8_BAR; PG8_MMA(1, 0, At, B0); PG8_MMA(1, 1, At, B1); PG8_BAR; PG8_SCHED;
            PG8_LDB(B0, 1, 0); PG8_LDB(B1, 1, 1); PG8_SCHED; PG8_LDA(At, 1, 0); PG8_STAGE(PG8_SA(0, 1), a2 + hstep, voffA);
            PG8_WAIT_V(8); PG8_WAIT_L(0); PG8_BAR; PG8_MMA(0, 0, At, B0); PG8_MMA(0, 1, At, B1); PG8_BAR; PG8_SCHED;
            PG8_LDA(At, 1, 1); PG8_STAGE(PG8_SB(1, 0), b3, voffB); PG8_STAGE(PG8_SB(1, 1), b3 + hstep, voffB); PG8_STAGE(PG8_SA(1, 0), a3, voffA);
            PG8_WAIT_V(8); PG8_WAIT_L(0); PG8_BAR; PG8_MMA(1, 0, At, B0); PG8_MMA(1, 1, At, B1); PG8_BAR; PG8_SCHED;
            } else {
            PG8_LDB(B0, 0, 0); PG8_SCHED; PG8_LDA(At, 0, 0); PG8_STAGE(PG8_SA(1, 1), a1 + hstep, voffA);
            PG8_WAIT_L(8); PG8_BAR; PG8_WAIT_L(0); PG8_MMA(0, 0, At, B0); PG8_BAR; PG8_SCHED;
            PG8_LDB(B1, 0, 1); PG8_STAGE(PG8_SB(0, 0), b2, voffB);
            PG8_BAR; PG8_WAIT_L(0); PG8_MMA(0, 1, At, B1); PG8_BAR;
            PG8_LDA(At, 0, 1); PG8_STAGE(PG8_SA(0, 0), a2, voffA);
            PG8_BAR; PG8_WAIT_L(0); PG8_MMA(1, 0, At, B0); PG8_BAR; PG8_SCHED;
            PG8_STAGE(PG8_SB(0, 1), b2 + hstep, voffB);
            PG8_WAIT_V(6); PG8_BAR; PG8_MMA(1, 1, At, B1); PG8_BAR;
            PG8_LDB(B0, 1, 0); PG8_SCHED; PG8_LDA(At, 1, 0); PG8_STAGE(PG8_SA(0, 1), a2 + hstep, voffA);
            PG8_WAIT_L(8); PG8_BAR; PG8_WAIT_L(0); PG8_MMA(0, 0, At, B0); PG8_BAR; PG8_SCHED;
            PG8_LDB(B1, 1, 1); PG8_STAGE(PG8_SB(1, 0), b3, voffB);
            PG8_BAR; PG8_WAIT_L(0); PG8_MMA(0, 1, At, B1); PG8_BAR;
            PG8_LDA(At, 1, 1); PG8_STAGE(PG8_SA(1, 0), a3, voffA);
            PG8_BAR; PG8_WAIT_L(0); PG8_MMA(1, 0, At, B0); PG8_BAR; PG8_SCHED;
            PG8_STAGE(PG8_SB(1, 1), b3 + hstep, voffB);
            PG8_WAIT_V(6); PG8_BAR; PG8_MMA(1, 1, At, B1); PG8_BAR;
            }
        }
        if constexpr (ALIGN_EPI) { if (wr == 0) PG8_BAR; }
        if constexpr (!Epi::AFTER_DRAIN) { E(acc, cur, wr, wc, fr, fq); S.done(cur); }
        if (!has_next) break;
#pragma unroll
        for (int a = 0; a < 2; ++a)
#pragma unroll
            for (int b = 0; b < 2; ++b)
#pragma unroll
                for (int m = 0; m < 4; ++m)
#pragma unroll
                    for (int n = 0; n < 2; ++n) acc[a][b][m][n] = (f32x4){0.f, 0.f, 0.f, 0.f};
        cur = nxt; cA = nA; cB = nB; ++ui;
        if constexpr (ALIGN_EPI) { if (wr == 1) PG8_BAR; }
    }
    PG8_WAIT_V(0);
    if constexpr (!ALIGN_EPI) { if (wr == 0) PG8_BAR; }
    PG8_BAR;
    if constexpr (Epi::AFTER_DRAIN) { E.fused(acc, cur, wr, wc, fr, fq, lds, wid, lane); S.done(cur); }
#undef PG8_SA
#undef PG8_SB
#undef PG8_STAGE
#undef PG8_LDA
#undef PG8_LDB
#undef PG8_MMA
#undef PG8_WAIT_V
#undef PG8_WAIT_L
#undef PG8_BAR
#undef PG8_SCHED
}
}
#define GAS __attribute__((address_space(1)))
#define LAS __attribute__((address_space(3)))
typedef unsigned short bf16;
typedef unsigned v4u __attribute__((ext_vector_type(4)));
typedef float f32x4 __attribute__((ext_vector_type(4)));
typedef short bf16x8 __attribute__((ext_vector_type(8)));
typedef GAS unsigned gu32;
typedef GAS unsigned long long gu64;
#define RLX_AGENT __ATOMIC_RELAXED, __HIP_MEMORY_SCOPE_AGENT
#define LDS_WAIT() asm volatile("s_waitcnt lgkmcnt(0)" ::: "memory")
#define VM_WAIT() asm volatile("s_waitcnt vmcnt(0)" ::: "memory")
__device__ __forceinline__ unsigned long long rt() { return __builtin_amdgcn_s_memrealtime(); }
__device__ __forceinline__ unsigned f2bf(float f) { unsigned u = __builtin_bit_cast(unsigned, f); return (u + 0x7fffu + ((u >> 16) & 1u)) >> 16; }
__device__ __forceinline__ unsigned pk2(float lo, float hi) { return f2bf(lo) | (f2bf(hi) << 16); }

#define XB_TMO      128
#define XB_XCNT(j)  (256  + 64 * (j))
#define XB_XSUB(j)  (1280 + 64 * (j))
#define XB_XGEN(j)  (2304 + 64 * (j))
#define XB_TOP      3328
#define XB_TOPGEN   3392
#define XCD_BAR_WORDS 3456
#define XB_SPIN_CAP (1u << 18)

__device__ __forceinline__ unsigned xb_ld(unsigned* p)              { return __hip_atomic_load(p, __ATOMIC_RELAXED, __HIP_MEMORY_SCOPE_AGENT); }
__device__ __forceinline__ unsigned xb_add(unsigned* p, unsigned v) { return __hip_atomic_fetch_add(p, v, __ATOMIC_RELAXED, __HIP_MEMORY_SCOPE_AGENT); }
__device__ __forceinline__ unsigned xb_xcc_id() { return (unsigned)__builtin_amdgcn_s_getreg((3 << 11) | 20) & 0xFu; }
#define XB_SPIN(cond, bar) do { unsigned _sp = 0; while (cond) { __builtin_amdgcn_s_sleep(1); \
    if ((++_sp & 255u) == 0u) { if (xb_ld(&(bar)[XB_TMO])) break; if (_sp > XB_SPIN_CAP) { atomicAdd(&(bar)[XB_TMO], 1u); break; } } } } while (0)

struct XcdBarrier {
    unsigned* bar; unsigned x;
    volatile LAS unsigned* st;
};

__device__ __forceinline__ XcdBarrier xcd_barrier_post(unsigned* bar, volatile LAS unsigned* st) {
    XcdBarrier b; b.bar = bar; b.x = xb_xcc_id(); b.st = st;
    if (threadIdx.x == 0) (void)xb_add(&bar[XB_XCNT(b.x)], 1u);
    return b;
}
__device__ __forceinline__ void xcd_barrier_complete(unsigned* bar, unsigned x, unsigned& nloc, unsigned& nx) {
    const unsigned G = gridDim.x * gridDim.y * gridDim.z;
    unsigned sum, cnt, mine, sp = 0u;
    for (;;) {
        sum = 0u; cnt = 0u; mine = 0u;
#pragma unroll
        for (unsigned j = 0; j < 16; ++j) { const unsigned c = xb_ld(&bar[XB_XCNT(j)]); sum += c; cnt += (c > 0u) ? 1u : 0u; mine = (j == x) ? c : mine; }
        if (sum == G) break;
        __builtin_amdgcn_s_sleep(1);
        if ((++sp & 255u) == 0u) { if (xb_ld(&bar[XB_TMO])) break; if (sp > XB_SPIN_CAP) { atomicAdd(&bar[XB_TMO], 1u); break; } }
    }
    nloc = mine > 0u ? mine : 1u; nx = cnt > 0u ? cnt : 1u;
}

__device__ __forceinline__ void xcd_barrier(const XcdBarrier& b) {
    asm volatile("s_waitcnt vmcnt(0)" ::: "memory");
    __syncthreads();
    int tid0_ = threadIdx.x; asm volatile("" : "+v"(tid0_));
    if (tid0_ == 0) {
        unsigned* bar = b.bar;
        __builtin_amdgcn_s_waitcnt(0);
        unsigned nloc = b.st[0], nx = b.st[1];
        if (nloc == 0u) { xcd_barrier_complete(bar, b.x, nloc, nx); b.st[0] = nloc; b.st[1] = nx; }
        const unsigned old = xb_add(&bar[XB_XSUB(b.x)], 1u);
        const unsigned gen = old / nloc;
        if (old + 1u == (gen + 1u) * nloc) {
            __builtin_amdgcn_fence(__ATOMIC_RELEASE, "agent");
            asm volatile("s_waitcnt vmcnt(0)" ::: "memory");
            const unsigned og = xb_add(&bar[XB_TOP], 1u);
            const unsigned tg = og / nx;
            if (og + 1u == (tg + 1u) * nx) xb_add(&bar[XB_TOPGEN], 1u);
            else XB_SPIN(xb_ld(&bar[XB_TOPGEN]) == tg, bar);
            __builtin_amdgcn_fence(__ATOMIC_ACQUIRE, "agent");
            xb_add(&bar[XB_XGEN(b.x)], 1u);
            asm volatile("s_waitcnt vmcnt(0)" ::: "memory");
        } else {
            XB_SPIN(xb_ld(&bar[XB_XGEN(b.x)]) == gen, bar);
            __builtin_amdgcn_fence(__ATOMIC_ACQUIRE, "agent");
            asm volatile("s_waitcnt vmcnt(0)" ::: "memory");
        }
    }
    __syncthreads();
}

constexpr int NWAVES = 8, NTHR = 512;
#ifndef WGM_GU
#define WGM_GU 4
#endif
#ifndef WGM_IN
#define WGM_IN 4
#endif
#ifndef WGM_R
#define WGM_R 8
#endif
constexpr int D = 1024, FF = 2816, NPJ = 3462, NPP = 3584;
constexpr int TP = 16384, TS = 128, TOK = TP + TS, MP = 16640;
constexpr int DEPTH = 4;
constexpr int C_Q = 1024, C_K = 1408, C_V = 1792, C_Z = 2176, C_XBC = 2560, C_DT = 3456;
constexpr float NORM_EPS = 1e-6f, GN_EPS = 64e-5f, NEG_INF = -1e30f;
constexpr size_t O_YP = 0, O_YS = 16777216, O_PK = 16908288, O_PV = 42074112, O_PSH = 67239936, O_PR = 67272704, O_PC = 67796992, O_PS = 67883008,
                 O_SK = 69455872, O_SV = 69652480, O_SSH = 69849088, O_SR = 69980160, O_SC = 72077312, O_SS = 72421376, O_END = 78712832;
static_assert(O_PK == 16908288 && O_PV == 42074112 && O_SK == 69455872 && O_SV == 69652480 && TP == 16384 && TS == 128, "the input-projection epilogue (EpiIn) hard-codes these output offsets");
constexpr size_t MiB = 1u << 20;
constexpr size_t WS_CTL = 0, CTL_ZERO_BYTES = 1 * MiB;
constexpr size_t SZ_WGU = (size_t)2 * FF * D * 2, SZ_WD = (size_t)D * FF * 2, SZ_WIN = (size_t)NPP * D * 2, SZ_WOUT = (size_t)D * D * 2;
constexpr size_t WL_GU1 = 0, WL_D1 = WL_GU1 + SZ_WGU, WL_IN = WL_D1 + SZ_WD, WL_OUT = WL_IN + SZ_WIN, WL_GU2 = WL_OUT + SZ_WOUT, WL_D2 = WL_GU2 + SZ_WGU, WL_SIZE = WL_D2 + SZ_WD;
static_assert(WL_SIZE == 44040192, "per-layer bf16 weight bytes");
constexpr size_t WS_REC = 488 * MiB; constexpr int REC_BYTES = 13312, REC_N = 10240, REC_T = 11776, REC_G = 12288;
constexpr size_t WS_LW = 1 * MiB, LW_SIZE = 131072;
constexpr size_t WS_W = 2 * MiB;
constexpr size_t WS_X = 176 * MiB, WS_XB = 242 * MiB, WS_SSQ = 276 * MiB, WS_H = 280 * MiB, WS_P = 372 * MiB, WS_OPS = 488 * MiB, WS_G = 586 * MiB, WS_SC = 603 * MiB,
                 WS_YS = 604 * MiB, WS_XC = 622 * MiB, WS_DT = 651 * MiB, WS_YC = 652 * MiB, WS_AP = 678 * MiB, WS_AM = 752 * MiB, WS_AL = 754 * MiB, WS_YM = 756 * MiB, WS_END = 790 * MiB;
static_assert(WS_W + 4 * WL_SIZE <= WS_X && WS_X + (size_t)MP * D * 4 <= WS_XB && WS_XB + (size_t)MP * D * 2 <= WS_SSQ && WS_SSQ + (size_t)MP * 64 <= WS_H && WS_H + (size_t)MP * FF * 2 <= WS_P &&
              WS_P + (size_t)MP * NPP * 2 <= WS_OPS && WS_OPS + (size_t)TOK * 4 * 384 * 4 <= WS_G && WS_G + (size_t)TOK * 256 * 4 <= WS_SC && WS_SC + (size_t)TOK * 32 <= WS_YS &&
              WS_YS + (size_t)TOK * 256 * 4 <= WS_XC && WS_XC + (size_t)TOK * 896 * 2 <= WS_DT && WS_DT + (size_t)TOK * 32 <= WS_YC && WS_YC + (size_t)TOK * 384 * 4 <= WS_AP &&
              WS_AP + (size_t)3 * TOK * 384 * 4 <= WS_AM && WS_AM + (size_t)3 * TOK * 32 <= WS_AL && WS_AL + (size_t)3 * TOK * 32 <= WS_YM && WS_YM + (size_t)MP * D * 2 <= WS_END, "d_ws map");
constexpr int CW_BAR = 4096;
constexpr int CW_Q = 16384;
constexpr int RING_BYTES = 131072, LDSCTL_OFF = RING_BYTES, MISC_OFF = LDSCTL_OFF + 320, LDS_BYTES = 147456;

typedef unsigned v2u __attribute__((ext_vector_type(2)));

#ifndef PHASE_FN
#define PHASE_FN __attribute__((noinline)) static
#endif
struct KArgs { const float* in[38]; float* out; unsigned char* ws; };
#define CAS __attribute__((address_space(4)))
struct KA {
    const CAS unsigned char* kp;
    __device__ __forceinline__ const float* in(int k) const { return *(const float* const CAS*)(kp + 8 * k); }
    __device__ __forceinline__ float* out() const { return *(float* const CAS*)(kp + 304); }
    __device__ __forceinline__ unsigned char* ws() const { return *(unsigned char* const CAS*)(kp + 312); }
};
__device__ __forceinline__ KA make_ka() { KA k; k.kp = (const CAS unsigned char*)__builtin_amdgcn_kernarg_segment_ptr(); asm volatile("" : "+s"(k.kp)); return k; }
__device__ __forceinline__ int fresh_tid() { int t = threadIdx.x; asm volatile("" : "+v"(t)); return t; }

__device__ __forceinline__ float bf2f(bf16 u) { return __uint_as_float((unsigned)u << 16); }
__device__ __forceinline__ float bflo(unsigned u) { return __uint_as_float(u << 16); }
__device__ __forceinline__ float bfhi(unsigned u) { return __uint_as_float(u & 0xffff0000u); }
__device__ __forceinline__ bf16 f2bf_s(float f) { unsigned u = __float_as_uint(f); return (bf16)((u + 0x7fffu + ((u >> 16) & 1u)) >> 16); }
template <int CTRL> __device__ __forceinline__ float dppf(float v) { return __builtin_bit_cast(float, __builtin_amdgcn_update_dpp(0, __builtin_bit_cast(int, v), CTRL, 0xF, 0xF, true)); }
template <int N> __device__ __forceinline__ float dpp_shr(float v, float fill) { return __builtin_bit_cast(float, __builtin_amdgcn_update_dpp(__builtin_bit_cast(int, fill), __builtin_bit_cast(int, v), 0x110 + N, 0xF, 0xF, false)); }
__device__ __forceinline__ float red8(float v) { v += dppf<0xB1>(v); v += dppf<0x4E>(v); v += dppf<0x141>(v); return v; }
__device__ __forceinline__ float wave_sum(float v) { v += dppf<0xB1>(v); v += dppf<0x4E>(v); v += dppf<0x141>(v); v += dppf<0x140>(v); v = pg8::xsum16(v); return pg8::xsum32(v); }
__device__ __forceinline__ float wave_max(float v) { v = fmaxf(v, dppf<0xB1>(v)); v = fmaxf(v, dppf<0x4E>(v)); v = fmaxf(v, dppf<0x141>(v)); v = fmaxf(v, dppf<0x140>(v)); v = pg8::xmax16(v); return pg8::xmax32(v); }
__device__ __forceinline__ float sigmoidf_(float x) { return __builtin_amdgcn_rcpf(1.0f + __builtin_amdgcn_exp2f(-1.4426950408889634f * x)); }
__device__ __forceinline__ float tanhf_(float x) { return 2.0f * sigmoidf_(2.0f * x) - 1.0f; }
__device__ __forceinline__ float softplusf_(float x) { return fmaxf(x, 0.f) + 0.6931471805599453f * __builtin_amdgcn_logf(1.0f + __builtin_amdgcn_exp2f(-1.4426950408889634f * fabsf(x))); }
template <int K> __device__ __forceinline__ f32x4 tile_mma(f32x4 acc, const LAS bf16* A, int lda, const LAS bf16* B, int ldb, int lane) {
    const LAS bf16* ap = A + (lane & 15) * lda + 8 * (lane >> 4); const LAS bf16* bp = B + (lane & 15) * ldb + 8 * (lane >> 4);
#pragma unroll
    for (int k = 0; k < K; k += 32) acc = __builtin_amdgcn_mfma_f32_16x16x32_bf16(*(const LAS bf16x8*)(ap + k), *(const LAS bf16x8*)(bp + k), acc, 0, 0, 0);
    return acc;
}

template <int MODE, int VW, int CP = 0> __device__ __forceinline__ void tr_item(const float* W, int K, int N, const float* gain, bf16* WT, LAS float* scr, int kb, int nb, int lane) {
    const int k0 = 64 * kb, n0 = 32 * nb;
    constexpr int LPR = 32 / VW, RPI = 64 / LPR, NI = 64 / RPI;
    const int rr = lane / LPR, cc = (lane % LPR) * VW;
    float v[NI][VW];
#pragma unroll
    for (int i = 0; i < NI; ++i) { const int kk = RPI * i + rr; const float* p = W + (size_t)(k0 + kk) * N + n0 + cc;
        if (n0 + 32 <= N) { if (VW == 4) { const f32x4 t = *(const f32x4*)p; v[i][0] = t[0]; v[i][1] = t[1]; v[i][VW - 2] = t[2]; v[i][VW - 1] = t[3]; } else { const pg8::f32x2 t = *(const pg8::f32x2*)p; v[i][0] = t[0]; v[i][1] = t[1]; } }
        else {
#pragma unroll
            for (int e = 0; e < VW; ++e) v[i][e] = (n0 + cc + e < N) ? p[e] : 0.f; } }
#pragma unroll
    for (int i = 0; i < NI; ++i) { const int kk = RPI * i + rr; const float g = gain ? gain[k0 + kk] : 1.0f;
#pragma unroll
        for (int e = 0; e < VW; ++e) scr[kk * 33 + cc + e] = v[i][e] * g; }
    asm volatile("s_waitcnt lgkmcnt(0)" ::: "memory");
    const int c = lane & 7;
#pragma unroll
    for (int j = 0; j < 4; ++j) { const int nl = (lane >> 3) + 8 * j, n = n0 + nl; const LAS float* sp = scr + (8 * c) * 33 + nl;
        v4u o; o.x = pg8::cvt_pk_bf16(sp[0 * 33], sp[1 * 33]); o.y = pg8::cvt_pk_bf16(sp[2 * 33], sp[3 * 33]); o.z = pg8::cvt_pk_bf16(sp[4 * 33], sp[5 * 33]); o.w = pg8::cvt_pk_bf16(sp[6 * 33], sp[7 * 33]);
        const int np = CP ? ((n & ~255) | (((n >> 5) & 1) << 7) | (((n >> 6) & 3) << 5) | (n & 31)) : n;
        const int drow = (MODE == 0) ? np : 8 * (n >> 2) + 4 * (MODE - 1) + (n & 3);
        *(v4u*)(WT + (size_t)drow * K + k0 + 8 * c) = o; }
    asm volatile("s_waitcnt lgkmcnt(0)" ::: "memory");
}
constexpr int I_G = 16 * 88, I_D = 44 * 32, I_IN = 16 * 112, I_OUT = 16 * 32, I_LAYER = 6 * 1408 + I_IN + I_OUT;
static_assert(I_G == 1408 && I_D == 1408 && I_LAYER % 8 == 0, "items");
__device__ __forceinline__ void wconv_item(const KA a, int l, int r, LAS float* scr, int lane) {
    bf16* wl = (bf16*)(a.ws() + WS_W + (size_t)l * WL_SIZE);
    if (r < I_G) { tr_item<1, 4>(a.in(9) + (size_t)l * D * FF, D, FF, a.in(8) + l * D, (bf16*)((unsigned char*)wl + WL_GU1), scr, r / 88, r % 88, lane); return; } r -= I_G;
    if (r < I_G) { tr_item<2, 4>(a.in(10) + (size_t)l * D * FF, D, FF, a.in(8) + l * D, (bf16*)((unsigned char*)wl + WL_GU1), scr, r / 88, r % 88, lane); return; } r -= I_G;
    if (r < I_D) { tr_item<0, 4>(a.in(11) + (size_t)l * D * FF, FF, D, nullptr, (bf16*)((unsigned char*)wl + WL_D1), scr, r / 32, r % 32, lane); return; } r -= I_D;
    if (r < I_IN) { tr_item<0, 2, 1>(a.in(13) + (size_t)l * D * NPJ, D, NPJ, a.in(12) + l * D, (bf16*)((unsigned char*)wl + WL_IN), scr, r / 112, r % 112, lane); return; } r -= I_IN;
    if (r < I_OUT) { tr_item<0, 4>(a.in(32) + (size_t)l * D * D, D, D, nullptr, (bf16*)((unsigned char*)wl + WL_OUT), scr, r / 32, r % 32, lane); return; } r -= I_OUT;
    if (r < I_G) { tr_item<1, 4>(a.in(34) + (size_t)l * D * FF, D, FF, a.in(33) + l * D, (bf16*)((unsigned char*)wl + WL_GU2), scr, r / 88, r % 88, lane); return; } r -= I_G;
    if (r < I_G) { tr_item<2, 4>(a.in(35) + (size_t)l * D * FF, D, FF, a.in(33) + l * D, (bf16*)((unsigned char*)wl + WL_GU2), scr, r / 88, r % 88, lane); return; } r -= I_G;
    tr_item<0, 4>(a.in(36) + (size_t)l * D * FF, FF, D, nullptr, (bf16*)((unsigned char*)wl + WL_D2), scr, r / 32, r % 32, lane);
}
__device__ __forceinline__ void p0_prologue(const KA a, LAS unsigned char* lds, int tid) {
    const int lane = tid & 63, wave = __builtin_amdgcn_readfirstlane(tid >> 6), gw = blockIdx.x * NWAVES + wave; int NGW = gridDim.x * NWAVES; asm volatile("" : "+s"(NGW));
    LAS float* scr = (LAS float*)(lds + wave * 16384);
    for (int it = gw; it < DEPTH * 32; it += NGW) {
        const int l = it >> 5, r = it & 31; bf16* lw = (bf16*)(a.ws() + WS_LW + (size_t)l * LW_SIZE);
        if (r < 8) tr_item<0, 4>(a.in(16) + (size_t)l * 64 * 256, 64, 256, nullptr, lw, scr, 0, r, lane);
        else if (r < 16) tr_item<0, 4>(a.in(18) + (size_t)l * 64 * 256, 64, 256, nullptr, lw + 256 * 64, scr, 0, r - 8, lane);
        else tr_item<0, 4>(a.in(19) + (size_t)l * 128 * 256, 128, 256, nullptr, lw + 2 * 256 * 64, scr, (r - 16) >> 3, (r - 16) & 7, lane);
    }
    for (int it = gw; it < I_LAYER; it += NGW) wconv_item(a, 0, it, scr, lane);
}
__device__ __forceinline__ void wconv_unit(const KA a, int l, int u, LAS unsigned char* lds, int tid) {
    const int lane = tid & 63, wave = __builtin_amdgcn_readfirstlane(tid >> 6);
    wconv_item(a, l, u * 8 + wave, (LAS float*)(lds + wave * 16384), lane);
}
constexpr int WTAIL_K = 3, WT_C0 = 150, WT_C1 = 142, WT_N0 = (256 - WT_C0) * 8 * WTAIL_K, WT_N1 = (256 - WT_C1) * 8 * WTAIL_K, WT_ITEMS = 2 * WT_N0 + WT_N1;
static_assert(WT_ITEMS % 8 == 0 && WT_ITEMS <= I_LAYER, "tail items");
__device__ __forceinline__ void wconv_tail(const KA a, int l, int slot, LAS unsigned char* lds, int tid) {
    if (gridDim.x != 256) return;
    const int c0 = (slot == 1) ? WT_C1 : WT_C0, base = (slot == 0) ? 0 : (slot == 1 ? WT_N0 : WT_N0 + WT_N1), nw = (256 - c0) * 8;
    if ((int)blockIdx.x < c0) return;
    const int lane = tid & 63, wave = __builtin_amdgcn_readfirstlane(tid >> 6), widx = ((int)blockIdx.x - c0) * 8 + wave;
    __syncthreads();
#pragma unroll 1
    for (int k = 0; k < WTAIL_K; ++k) wconv_item(a, l, base + k * nw + widx, (LAS float*)(lds + wave * 16384), lane);
}
PHASE_FN __device__ void p0_xinit(const KA a, int tid) {
    const int lane = tid & 63, wave = __builtin_amdgcn_readfirstlane(tid >> 6), gw = blockIdx.x * NWAVES + wave; int NGW = gridDim.x * NWAVES; asm volatile("" : "+s"(NGW));
    float* X = (float*)(a.ws() + WS_X); bf16* XB = (bf16*)(a.ws() + WS_XB); float* SSQ = (float*)(a.ws() + WS_SSQ); bf16* YM = (bf16*)(a.ws() + WS_YM);
    for (int m = gw; m < MP; m += NGW) {
        const float* src = (m < TP) ? a.in(0) + (size_t)m * D : a.in(1) + (size_t)(m - TP) * D;
        f32x4 v[4]; float s = 0.f;
#pragma unroll
        for (int j = 0; j < 4; ++j) { v[j] = (m < TOK) ? ((const f32x4*)src)[lane + 64 * j] : (f32x4){0.f, 0.f, 0.f, 0.f}; s += (v[j][0] * v[j][0] + v[j][1] * v[j][1]) + (v[j][2] * v[j][2] + v[j][3] * v[j][3]); }
        s = wave_sum(s);
#pragma unroll
        for (int j = 0; j < 4; ++j) {
            v2u w; w.x = pg8::cvt_pk_bf16(v[j][0], v[j][1]); w.y = pg8::cvt_pk_bf16(v[j][2], v[j][3]); ((v2u*)(XB + (size_t)m * D))[lane + 64 * j] = w;
            if (m >= TOK) ((v2u*)(YM + (size_t)m * D))[lane + 64 * j] = (v2u){0u, 0u}; }
        if (m < TP) { if (lane < 16) SSQ[(size_t)m * 16 + lane] = (lane == 0) ? s : 0.f; }
        else SSQ[pg8::SSQS_OFF + (size_t)(m - TP) * 64 + lane] = (lane == 0) ? s : 0.f;
    }
}

__device__ __forceinline__ v2u pk4(f32x4 v) { v2u w; w.x = pg8::cvt_pk_bf16(v[0], v[1]); w.y = pg8::cvt_pk_bf16(v[2], v[3]); return w; }
__device__ __forceinline__ f32x4 up4(v2u w) { return (f32x4){bflo(w.x), bfhi(w.x), bflo(w.y), bfhi(w.y)}; }
__device__ __forceinline__ void ld8(float (&d)[8], const bf16* p) { const v4u w = *(const v4u*)p; d[0] = bflo(w.x); d[1] = bfhi(w.x); d[2] = bflo(w.y); d[3] = bfhi(w.y); d[4] = bflo(w.z); d[5] = bfhi(w.z); d[6] = bflo(w.w); d[7] = bfhi(w.w); }
__device__ __forceinline__ void ld4(float (&d)[4], const bf16* p) { const v2u w = *(const v2u*)p; d[0] = bflo(w.x); d[1] = bfhi(w.x); d[2] = bflo(w.y); d[3] = bfhi(w.y); }
__device__ __forceinline__ void rwkv_prep(const KA a, int l, LAS unsigned char* lds, int tid) {
    const int lane = tid & 63, wave = __builtin_amdgcn_readfirstlane(tid >> 6);
    int ngrp = gridDim.x >> 2; asm volatile("" : "+s"(ngrp));
    const int h = blockIdx.x & 3, wv = (blockIdx.x >> 2) * NWAVES + wave, NW = ngrp * NWAVES;
    if ((int)(blockIdx.x >> 2) >= ngrp) return;
    const int fr = lane & 15, fq = lane >> 4;
    const bf16* P = (const bf16*)(a.ws() + WS_P);
    const bf16* w2t = (const bf16*)(a.ws() + WS_LW + (size_t)l * LW_SIZE); const bf16* a2t = w2t + 256 * 64; const bf16* g2t = a2t + 256 * 64;
    LAS bf16* W2 = (LAS bf16*)lds; LAS bf16* A2 = W2 + 64 * 72; LAS bf16* G2 = A2 + 64 * 72;
    { const int r = tid >> 3, c = tid & 7;
      *(LAS v4u*)(W2 + r * 72 + c * 8) = *(const v4u*)(w2t + (size_t)(64 * h + r) * 64 + c * 8); *(LAS v4u*)(A2 + r * 72 + c * 8) = *(const v4u*)(a2t + (size_t)(64 * h + r) * 64 + c * 8);
#pragma unroll
      for (int q = 0; q < 2; ++q) { const int idx = tid + NTHR * q, rr = idx >> 4, cc = idx & 15; *(LAS v4u*)(G2 + rr * 136 + cc * 8) = *(const v4u*)(g2t + (size_t)(64 * h + rr) * 128 + cc * 8); } }
    __syncthreads();
    const float* mu = a.in(14) + l * 1024;
    bf16* G = (bf16*)(a.ws() + WS_G); float* SC = (float*)(a.ws() + WS_SC);
    for (int tile = wv; tile < TOK / 16; tile += NW) {
        const int row = tile * 16 + fr;
        bool first; const float* sh = nullptr;
        if (row < TP) first = (row & 2047) == 0; else { const int r = row - TP; first = (r & 3) == 0; sh = a.in(4) + (size_t)(l * 32 + (r >> 2)) * 1024; }
        const bf16* pc = P + (size_t)row * NPP; const bf16* pq = first ? pc : pc - NPP;
        bf16x8 fw[2], fa[2], fg[4];
#pragma unroll
        for (int ks = 0; ks < 8; ++ks) { const int col = 768 + 32 * ks + 8 * fq;
            float c[8], p[8]; ld8(c, pc + col); ld8(p, pq + col);
            const f32x4 m0 = *(const f32x4*)(mu + col), m1 = *(const f32x4*)(mu + col + 4);
            if (first) { if (sh) { const f32x4 s0 = *(const f32x4*)(sh + col), s1 = *(const f32x4*)(sh + col + 4);
#pragma unroll
                    for (int e = 0; e < 4; ++e) { p[e] = s0[e]; p[4 + e] = s1[e]; } } else {
#pragma unroll
                    for (int e = 0; e < 8; ++e) p[e] = 0.f; } }
            float x[8];
#pragma unroll
            for (int e = 0; e < 8; ++e) { const float m = (e < 4) ? m0[e & 3] : m1[e & 3]; const float ps = c[e] + m * (p[e] - c[e]); x[e] = (ks < 2) ? tanhf_(ps) : (ks < 4 ? ps : sigmoidf_(ps)); }
            union { bf16x8 v; unsigned u[4]; } f; f.u[0] = pg8::cvt_pk_bf16(x[0], x[1]); f.u[1] = pg8::cvt_pk_bf16(x[2], x[3]); f.u[2] = pg8::cvt_pk_bf16(x[4], x[5]); f.u[3] = pg8::cvt_pk_bf16(x[6], x[7]);
            if (ks < 2) fw[ks] = f.v; else if (ks < 4) fa[ks - 2] = f.v; else fg[ks - 4] = f.v;
            if (ks & 1) { } }
        {
            f32x4 aw[4], aa[4], ag[4];
#pragma unroll
            for (int t = 0; t < 4; ++t) { const int n = 16 * t + fr;
                const LAS bf16* wp = W2 + n * 72 + 8 * fq; const LAS bf16* ap = A2 + n * 72 + 8 * fq; const LAS bf16* gp = G2 + n * 136 + 8 * fq;
                f32x4 z = (f32x4){0.f, 0.f, 0.f, 0.f};
                aw[t] = __builtin_amdgcn_mfma_f32_16x16x32_bf16(*(const LAS bf16x8*)wp, fw[0], z, 0, 0, 0); aw[t] = __builtin_amdgcn_mfma_f32_16x16x32_bf16(*(const LAS bf16x8*)(wp + 32), fw[1], aw[t], 0, 0, 0);
                aa[t] = __builtin_amdgcn_mfma_f32_16x16x32_bf16(*(const LAS bf16x8*)ap, fa[0], z, 0, 0, 0); aa[t] = __builtin_amdgcn_mfma_f32_16x16x32_bf16(*(const LAS bf16x8*)(ap + 32), fa[1], aa[t], 0, 0, 0);
                ag[t] = __builtin_amdgcn_mfma_f32_16x16x32_bf16(*(const LAS bf16x8*)gp, fg[0], z, 0, 0, 0); ag[t] = __builtin_amdgcn_mfma_f32_16x16x32_bf16(*(const LAS bf16x8*)(gp + 32), fg[1], ag[t], 0, 0, 0);
                ag[t] = __builtin_amdgcn_mfma_f32_16x16x32_bf16(*(const LAS bf16x8*)(gp + 64), fg[2], ag[t], 0, 0, 0); ag[t] = __builtin_amdgcn_mfma_f32_16x16x32_bf16(*(const LAS bf16x8*)(gp + 96), fg[3], ag[t], 0, 0, 0);
                *(v2u*)(G + (size_t)row * 256 + 64 * h + 16 * t + 4 * fq) = pk4(ag[t]); }
            float r[4][4], k[4][4];
#pragma unroll
            for (int t = 0; t < 4; ++t) { const int c = 64 * h + 16 * t + 4 * fq;
#pragma unroll
                for (int part = 0; part < 2; ++part) { const int col = 256 * part + c; float cc[4], pp[4]; ld4(cc, pc + col); ld4(pp, pq + col);
                    const f32x4 m = *(const f32x4*)(mu + col);
                    if (first) { if (sh) { const f32x4 s0 = *(const f32x4*)(sh + col);
#pragma unroll
                            for (int e = 0; e < 4; ++e) pp[e] = s0[e]; } else {
#pragma unroll
                            for (int e = 0; e < 4; ++e) pp[e] = 0.f; } }
#pragma unroll
                    for (int e = 0; e < 4; ++e) { const float ps = cc[e] + m[e] * (pp[e] - cc[e]); if (part == 0) r[t][e] = ps; else k[t][e] = ps; } } }
            float n2 = 0.f;
#pragma unroll
            for (int t = 0; t < 4; ++t) { const int c = l * 256 + 64 * h + 16 * t + 4 * fq;
                const f32x4 w0 = *(const f32x4*)(a.in(15) + c), a0 = *(const f32x4*)(a.in(17) + c), kkw = *(const f32x4*)(a.in(20) + c);
#pragma unroll
                for (int e = 0; e < 4; ++e) { const float wlog = -softplusf_(-(w0[e] + aw[t][e])) - 0.5f; aw[t][e] = __expf(-__expf(wlog)); aa[t][e] = sigmoidf_(a0[e] + aa[t][e]); const float kk = k[t][e] * kkw[e]; n2 += kk * kk; } }
            n2 = pg8::xsum16(n2); n2 = pg8::xsum32(n2);
            const float inv = 1.0f / fmaxf(sqrtf(n2), 1e-12f);
            float br = 0.f, kr = 0.f, bon = 0.f;
#pragma unroll
            for (int t = 0; t < 4; ++t) { const int c = l * 256 + 64 * h + 16 * t + 4 * fq;
                const f32x4 kkw = *(const f32x4*)(a.in(20) + c), kaw = *(const f32x4*)(a.in(21) + c), rkw = *(const f32x4*)(a.in(22) + c);
#pragma unroll
                for (int e = 0; e < 4; ++e) { const float kk = k[t][e] * kkw[e] * inv, av = aa[t][e], kt = k[t][e] * (1.f + (av - 1.f) * kaw[e]);
                    br += kk * av * r[t][e]; kr += kt * r[t][e]; bon += r[t][e] * kt * rkw[e]; } }
            br = pg8::xsum16(br); br = pg8::xsum32(br); kr = pg8::xsum16(kr); kr = pg8::xsum32(kr); bon = pg8::xsum16(bon); bon = pg8::xsum32(bon);
            unsigned char* rec = a.ws() + WS_REC + (size_t)(tile * 4 + h) * REC_BYTES;
            const bool samp = tile >= TP / 16;
            const bool c1 = !samp || (fr & 3) >= 1, c2 = !samp || (fr & 3) >= 2;
            f32x4 At4[4], Rt4[4], Bt4[4], Kt4[4];
#pragma unroll
            for (int t = 0; t < 4; ++t) { const int c = l * 256 + 64 * h + 16 * t + 4 * fq;
                const f32x4 kkw = *(const f32x4*)(a.in(20) + c), kaw = *(const f32x4*)(a.in(21) + c);
                f32x4 vv;
                { const int col = 512 + 64 * h + 16 * t + 4 * fq; float cc[4], pp[4]; ld4(cc, pc + col); ld4(pp, pq + col); const f32x4 m = *(const f32x4*)(mu + col);
                  if (first) { if (sh) { const f32x4 q0 = *(const f32x4*)(sh + col);
#pragma unroll
                          for (int e = 0; e < 4; ++e) pp[e] = q0[e]; } else {
#pragma unroll
                          for (int e = 0; e < 4; ++e) pp[e] = 0.f; } }
#pragma unroll
                  for (int e = 0; e < 4; ++e) vv[e] = cc[e] + m[e] * (pp[e] - cc[e]); }
                f32x4 gend;
#pragma unroll
                for (int e = 0; e < 4; ++e) { const float kk = k[t][e] * kkw[e] * inv, av = aa[t][e], w = aw[t][e], kt = k[t][e] * (1.f + (av - 1.f) * kaw[e]);
                    float g = w, x;
                    x = dpp_shr<1>(g, 1.0f); g *= c1 ? x : 1.0f;
                    x = dpp_shr<2>(g, 1.0f); g *= c2 ? x : 1.0f;
                    x = dpp_shr<4>(g, 1.0f); g *= samp ? 1.0f : x;
                    x = dpp_shr<8>(g, 1.0f); g *= samp ? 1.0f : x;
                    x = dpp_shr<1>(g, 1.0f); const float gm = c1 ? x : 1.0f;
                    const float ig = __builtin_amdgcn_rcpf(g);
                    At4[t][e] = -gm * kk; Rt4[t][e] = gm * (w * r[t][e] - kk * br); Bt4[t][e] = kk * av * ig; Kt4[t][e] = kt * ig; gend[e] = g; }
                const size_t eo = ((size_t)fr * 64 + 16 * t + 4 * fq) * 2;
                *(v2u*)(rec + eo) = pk4(At4[t]); *(v2u*)(rec + 2048 + eo) = pk4(Rt4[t]); *(v2u*)(rec + 4096 + eo) = pk4(Bt4[t]); *(v2u*)(rec + 6144 + eo) = pk4(Kt4[t]); *(v2u*)(rec + 8192 + eo) = pk4(vv);
                if (samp ? ((fr & 3) == 3) : (fr == 15)) *(f32x4*)(rec + REC_G + ((samp ? (fr >> 2) : 0) * 64 + 16 * t + 4 * fq) * 4) = gend; }
            { union FR { bf16x8 v; unsigned u[4]; } fA[2], fR[2], fB[2], fK[2];
#pragma unroll
              for (int ks = 0; ks < 2; ++ks) { const v2u a0 = pk4(At4[2 * ks]), a1 = pk4(At4[2 * ks + 1]), r0 = pk4(Rt4[2 * ks]), r1 = pk4(Rt4[2 * ks + 1]), b0 = pk4(Bt4[2 * ks]), b1 = pk4(Bt4[2 * ks + 1]), k0 = pk4(Kt4[2 * ks]), k1 = pk4(Kt4[2 * ks + 1]);
                  fA[ks].u[0] = a0.x; fA[ks].u[1] = a0.y; fA[ks].u[2] = a1.x; fA[ks].u[3] = a1.y; fR[ks].u[0] = r0.x; fR[ks].u[1] = r0.y; fR[ks].u[2] = r1.x; fR[ks].u[3] = r1.y;
                  fB[ks].u[0] = b0.x; fB[ks].u[1] = b0.y; fB[ks].u[2] = b1.x; fB[ks].u[3] = b1.y; fK[ks].u[0] = k0.x; fK[ks].u[1] = k0.y; fK[ks].u[2] = k1.x; fK[ks].u[3] = k1.y; }
              const f32x4 z4 = (f32x4){0.f, 0.f, 0.f, 0.f};
              f32x4 nba = __builtin_amdgcn_mfma_f32_16x16x32_bf16(fB[0].v, fA[0].v, z4, 0, 0, 0); nba = __builtin_amdgcn_mfma_f32_16x16x32_bf16(fB[1].v, fA[1].v, nba, 0, 0, 0);
              f32x4 nka = __builtin_amdgcn_mfma_f32_16x16x32_bf16(fK[0].v, fA[0].v, z4, 0, 0, 0); nka = __builtin_amdgcn_mfma_f32_16x16x32_bf16(fK[1].v, fA[1].v, nka, 0, 0, 0);
              f32x4 nbr = __builtin_amdgcn_mfma_f32_16x16x32_bf16(fB[0].v, fR[0].v, z4, 0, 0, 0); nbr = __builtin_amdgcn_mfma_f32_16x16x32_bf16(fB[1].v, fR[1].v, nbr, 0, 0, 0);
              f32x4 nkr = __builtin_amdgcn_mfma_f32_16x16x32_bf16(fK[0].v, fR[0].v, z4, 0, 0, 0); nkr = __builtin_amdgcn_mfma_f32_16x16x32_bf16(fK[1].v, fR[1].v, nkr, 0, 0, 0);
              LAS float* Nb = (LAS float*)(lds + 36864) + wave * 288;
#pragma unroll
              for (int e = 0; e < 4; ++e) { const int sN = 4 * fq + e, tN = fr; const bool keep = (sN < tN) && (!samp || (sN >> 2) == (tN >> 2));
                  nba[e] = keep ? nba[e] : 0.f; nka[e] = keep ? nka[e] : 0.f; nbr[e] = keep ? nbr[e] : 0.f; nkr[e] = keep ? nkr[e] : 0.f;
                  Nb[sN * 17 + tN] = nba[e];
                  bf16* np = (bf16*)(rec + REC_N) + sN * 16 + tN; np[0] = f2bf_s(nka[e]); np[256] = f2bf_s(nbr[e]); np[512] = f2bf_s(nkr[e]); }
              asm volatile("s_waitcnt lgkmcnt(0)" ::: "memory");
              float Tr[16];
#pragma unroll
              for (int t = 0; t < 16; ++t) { float acc = (fr == t) ? 1.f : 0.f;
#pragma unroll
                  for (int sN = 0; sN < t; ++sN) acc += Tr[sN] * Nb[sN * 17 + t];
                  Tr[t] = acc; }
              if (fq == 0) { v4u o0, o1; o0.x = pg8::cvt_pk_bf16(Tr[0], Tr[1]); o0.y = pg8::cvt_pk_bf16(Tr[2], Tr[3]); o0.z = pg8::cvt_pk_bf16(Tr[4], Tr[5]); o0.w = pg8::cvt_pk_bf16(Tr[6], Tr[7]);
                  o1.x = pg8::cvt_pk_bf16(Tr[8], Tr[9]); o1.y = pg8::cvt_pk_bf16(Tr[10], Tr[11]); o1.z = pg8::cvt_pk_bf16(Tr[12], Tr[13]); o1.w = pg8::cvt_pk_bf16(Tr[14], Tr[15]);
                  *(v4u*)(rec + REC_T + fr * 32) = o0; *(v4u*)(rec + REC_T + fr * 32 + 16) = o1; }
              asm volatile("s_waitcnt lgkmcnt(0)" ::: "memory"); }
            if (fq == 0) { SC[(size_t)(row * 4 + h) * 2] = kr; SC[(size_t)(row * 4 + h) * 2 + 1] = bon; }
        }
    }
}

PHASE_FN __device__ void prep_elementwise(const KA a, int l, int tid) {
    int skipb = (gridDim.x > 8) ? 4 : 0; asm volatile("" : "+s"(skipb));
    if ((int)blockIdx.x < skipb) return;
    const int gtid = ((int)blockIdx.x - skipb) * NTHR + tid; int GT = ((int)gridDim.x - skipb) * NTHR; asm volatile("" : "+s"(GT));
    const bf16* P = (const bf16*)(a.ws() + WS_P); bf16* XC = (bf16*)(a.ws() + WS_XC); float* DT = (float*)(a.ws() + WS_DT); float* out = a.out();
    const float* cw = a.in(26) + (size_t)l * 4 * 896; const float* cb = a.in(27) + l * 896;
    for (int idx = gtid; idx < (TOK / 4) * 112; idx += GT) {
        const int grp = idx / 112, c8 = idx - grp * 112, col = c8 * 8, row0 = grp * 4;
        int t0, b = 0; if (row0 < TP) t0 = row0 & 2047; else { b = (row0 - TP) >> 2; t0 = 0; }
        float x[7][8];
#pragma unroll
        for (int i = 0; i < 7; ++i) { const int tt = t0 - 3 + i;
            if (tt >= 0) ld8(x[i], P + (size_t)(row0 - 3 + i) * NPP + C_XBC + col);
            else if (row0 < TP) {
#pragma unroll
                for (int e = 0; e < 8; ++e) x[i][e] = 0.f; }
            else { const float* s = a.in(6) + ((size_t)(l * 32 + b) * 3 + i) * 896 + col; const f32x4 s0 = *(const f32x4*)s, s1 = *(const f32x4*)(s + 4);
#pragma unroll
                for (int e = 0; e < 4; ++e) { x[i][e] = s0[e]; x[i][4 + e] = s1[e]; } } }
        float wv[4][8], bv[8];
#pragma unroll
        for (int i = 0; i < 4; ++i) { const f32x4 w0 = *(const f32x4*)(cw + i * 896 + col), w1 = *(const f32x4*)(cw + i * 896 + col + 4);
#pragma unroll
            for (int e = 0; e < 4; ++e) { wv[i][e] = w0[e]; wv[i][4 + e] = w1[e]; } }
        { const f32x4 b0 = *(const f32x4*)(cb + col), b1 = *(const f32x4*)(cb + col + 4);
#pragma unroll
          for (int e = 0; e < 4; ++e) { bv[e] = b0[e]; bv[4 + e] = b1[e]; } }
#pragma unroll
        for (int j = 0; j < 4; ++j) { float y[8];
#pragma unroll
            for (int e = 0; e < 8; ++e) { float acc = bv[e];
#pragma unroll
                for (int i = 0; i < 4; ++i) acc += wv[i][e] * x[j + i][e];
                y[e] = acc * sigmoidf_(acc); }
            v4u o; o.x = pg8::cvt_pk_bf16(y[0], y[1]); o.y = pg8::cvt_pk_bf16(y[2], y[3]); o.z = pg8::cvt_pk_bf16(y[4], y[5]); o.w = pg8::cvt_pk_bf16(y[6], y[7]);
            *(v4u*)(XC + (size_t)(row0 + j) * 896 + col) = o; }
    }
    for (int idx = gtid; idx < TOK * 6; idx += GT) { const int row = idx / 6, h = idx - row * 6;
        DT[(size_t)row * 8 + h] = softplusf_(bf2f(P[(size_t)row * NPP + C_DT + h]) + a.in(28)[l * 6 + h]); }
    for (int idx = gtid; idx < 40 * 1024; idx += GT) { const int s = idx >> 10, col = idx & 1023;
        const int row = (s < 8) ? s * 2048 + 2047 : TP + (s - 8) * 4 + 3;
        float* dst = (s < 8) ? out + O_PSH + (size_t)(l * 8 + s) * 1024 + col : out + O_SSH + (size_t)(l * 32 + s - 8) * 1024 + col;
        *dst = bf2f(P[(size_t)row * NPP + col]); }
    for (int idx = gtid; idx < 40 * 2688; idx += GT) { const int s = idx / 2688, rem = idx - s * 2688, i = rem / 896, col = rem - i * 896;
        const int row = (s < 8) ? s * 2048 + 2045 + i : TP + (s - 8) * 4 + 1 + i;
        float* dst = (s < 8) ? out + O_PC + ((size_t)(l * 8 + s) * 3 + i) * 896 + col : out + O_SC + ((size_t)(l * 32 + s - 8) * 3 + i) * 896 + col;
        *dst = bf2f(P[(size_t)row * NPP + C_XBC + col]); }
}

#define LBAR() asm volatile("s_waitcnt lgkmcnt(0)\n\ts_barrier" ::: "memory")
typedef short v4i16_t __attribute__((ext_vector_type(4)));
constexpr int CB_BYTES = 15872;
__device__ __forceinline__ v4i16_t tr4(const LAS bf16* T, int pitch, int col0, int lane) {
    return __builtin_amdgcn_ds_read_tr16_b64_v4i16((LAS v4i16_t*)(T + (4 * (lane >> 4) + ((lane & 15) >> 2)) * pitch + col0 + 4 * (lane & 3)));
}
typedef __bf16 bf2_t __attribute__((ext_vector_type(2))); typedef float f2v_t __attribute__((ext_vector_type(2)));
__device__ __forceinline__ unsigned cvt_pk_c(float lo, float hi) { const f2v_t v = {lo, hi}; return __builtin_bit_cast(unsigned, __builtin_convertvector(v, bf2_t)); }
__device__ __forceinline__ v4i16_t pack4(f32x4 x) { union { v4i16_t v; unsigned u[2]; } p; p.u[0] = cvt_pk_c(x[0], x[1]); p.u[1] = cvt_pk_c(x[2], x[3]); return p.v; }
PHASE_FN __device__ void rwkv_scan_unit(const KA a, int l, int unit, LAS unsigned char* lds, int tid) {
    int b, h, tile0, nch, seg, row_base; const float* s0; float* sout;
    if (unit < 32) { b = unit >> 2; h = unit & 3; tile0 = b * 128; nch = 128; seg = -1; row_base = b * 2048; s0 = nullptr; sout = a.out() + O_PR + (size_t)((l * 8 + b) * 4 + h) * 4096; }
    else { const int u = unit - 32; b = u >> 2; h = u & 3; tile0 = TP / 16 + (b >> 2); nch = 1; seg = b & 3; row_base = TP + b * 4; s0 = a.in(5) + (size_t)((l * 32 + b) * 4 + h) * 4096; sout = a.out() + O_SR + (size_t)((l * 32 + b) * 4 + h) * 4096; }
    const int lane = tid & 63, wave = __builtin_amdgcn_readfirstlane(tid >> 6), c16 = lane & 15, g = lane >> 4;
    const unsigned char* REC = a.ws() + WS_REC; bf16* YS = (bf16*)(a.ws() + WS_YS);
    LAS unsigned char* cbuf = lds;
    LAS bf16* SbAll = (LAS bf16*)(lds + 2 * CB_BYTES);
    if (wave >= 4) {
        const int ht = tid - 256;
        v4u ra[4], rb[4];
#define SC_FETCH(R, cc) do { const unsigned char* src_ = REC + (size_t)((tile0 + (cc)) * 4 + h) * REC_BYTES; \
            _Pragma("unroll") for (int q = 0; q < 4; ++q) { const int ci = ht + 256 * q; R[q] = *(const v4u*)(src_ + (ci < 832 ? ci : 831) * 16); } } while (0)
#define SC_PUT(R, cc) do { LAS unsigned char* dst_ = cbuf + ((cc) & 1) * CB_BYTES; \
            _Pragma("unroll") for (int q = 0; q < 4; ++q) { const int ci = ht + 256 * q; \
                if (ci < 640) { const int m_ = ci >> 7, r_ = (ci & 127) >> 3, k_ = ci & 7; *(LAS v4u*)(dst_ + m_ * 2560 + r_ * 160 + k_ * 16) = R[q]; } \
                else if (ci < 832) *(LAS v4u*)(dst_ + 12800 + (ci - 640) * 16) = R[q]; } } while (0)
#define SC_HELP(c, RL, RW) do { if ((c) + 2 < nch) SC_FETCH(RL, (c) + 2); if ((c) + 1 < nch) SC_PUT(RW, (c) + 1); LBAR(); } while (0)
        SC_FETCH(ra, 0); SC_PUT(ra, 0);
        if (1 < nch) SC_FETCH(rb, 1);
        LBAR();
        for (int c = 0; c < nch; c += 2) {
            SC_HELP(c, ra, rb);
            if (c + 1 < nch) SC_HELP(c + 1, rb, ra);
        }
#undef SC_HELP
#undef SC_PUT
#undef SC_FETCH
    } else {
        const int it = wave;
        LAS bf16* Sb = SbAll + it * (16 * 72);
        f32x4 S[4];
#pragma unroll
        for (int jt = 0; jt < 4; ++jt)
#pragma unroll
            for (int e = 0; e < 4; ++e) S[jt][e] = s0 ? s0[(size_t)(16 * it + 4 * g + e) * 64 + 16 * jt + c16] : 0.f;
        const bool mine = (seg < 0) || (g == seg);
        const v4i16_t zf = (v4i16_t){0, 0, 0, 0};
        LBAR();
        for (int c = 0; c < nch; ++c) {
            const LAS unsigned char* cb = cbuf + (c & 1) * CB_BYTES;
            const LAS bf16* At = (const LAS bf16*)cb; const LAS bf16* Rt = At + 1280; const LAS bf16* Bt = At + 2560; const LAS bf16* Kt = At + 3840; const LAS bf16* Vt = At + 5120;
            const LAS bf16* Nka = (const LAS bf16*)(cb + 12800); const LAS bf16* Nbr = Nka + 256; const LAS bf16* Nkr = Nka + 512; const LAS bf16* Tm = Nka + 768;
            const LAS float* Gam = (const LAS float*)(cb + 14848) + (seg < 0 ? 0 : seg) * 64;
#pragma unroll
            for (int jt = 0; jt < 4; ++jt)
#pragma unroll
                for (int e = 0; e < 4; ++e) Sb[(4 * g + e) * 72 + 16 * jt + c16] = f2bf_s(S[jt][e]);
            asm volatile("s_waitcnt lgkmcnt(0)" ::: "memory");
            const bf16x8 sb0 = *(const LAS bf16x8*)(Sb + c16 * 72 + 8 * g), sb1 = *(const LAS bf16x8*)(Sb + c16 * 72 + 32 + 8 * g);
            v4i16_t fV = tr4(Vt, 80, 16 * it, lane); if (!mine) fV = zf;
            f32x4 a0 = __builtin_amdgcn_mfma_f32_16x16x32_bf16(*(const LAS bf16x8*)(At + c16 * 80 + 8 * g), sb0, (f32x4){0.f, 0.f, 0.f, 0.f}, 0, 0, 0);
            a0 = __builtin_amdgcn_mfma_f32_16x16x32_bf16(*(const LAS bf16x8*)(At + c16 * 80 + 32 + 8 * g), sb1, a0, 0, 0, 0);
            a0 = __builtin_amdgcn_mfma_f32_16x16x16bf16_1k(tr4(Nka, 16, 0, lane), fV, a0, 0, 0, 0);
            const f32x4 ut = __builtin_amdgcn_mfma_f32_16x16x16bf16_1k(tr4(Tm, 16, 0, lane), pack4(a0), (f32x4){0.f, 0.f, 0.f, 0.f}, 0, 0, 0);
            v4i16_t utp = pack4(ut); if (!mine) utp = zf;
            f32x4 z = __builtin_amdgcn_mfma_f32_16x16x32_bf16(sb0, *(const LAS bf16x8*)(Rt + c16 * 80 + 8 * g), (f32x4){0.f, 0.f, 0.f, 0.f}, 0, 0, 0);
            z = __builtin_amdgcn_mfma_f32_16x16x32_bf16(sb1, *(const LAS bf16x8*)(Rt + c16 * 80 + 32 + 8 * g), z, 0, 0, 0);
            z = __builtin_amdgcn_mfma_f32_16x16x16bf16_1k(utp, tr4(Nbr, 16, 0, lane), z, 0, 0, 0);
            z = __builtin_amdgcn_mfma_f32_16x16x16bf16_1k(fV, tr4(Nkr, 16, 0, lane), z, 0, 0, 0);
            { const int row = (seg < 0) ? row_base + 16 * c + c16 : row_base + (c16 & 3);
              if (seg < 0 || (c16 >> 2) == seg) *(v2u*)(YS + (size_t)row * 256 + h * 64 + 16 * it + 4 * g) = pk4(z); }
#pragma unroll
            for (int jt = 0; jt < 4; ++jt) { f32x4 acc = __builtin_amdgcn_mfma_f32_16x16x16bf16_1k(utp, tr4(Bt, 80, 16 * jt, lane), S[jt], 0, 0, 0);
                acc = __builtin_amdgcn_mfma_f32_16x16x16bf16_1k(fV, tr4(Kt, 80, 16 * jt, lane), acc, 0, 0, 0);
                S[jt] = acc * Gam[16 * jt + c16]; }
            LBAR();
        }
#pragma unroll
        for (int jt = 0; jt < 4; ++jt)
#pragma unroll
            for (int e = 0; e < 4; ++e) sout[(size_t)(16 * it + 4 * g + e) * 64 + 16 * jt + c16] = S[jt][e];
    }
}

constexpr int SD_PC = 144, SD_PX = 80;
__device__ __forceinline__ bf16x8 tr_frag(const LAS bf16* T, int pitch, int k0, int col0, int lane) {
    const int g = lane >> 4, q = (lane & 15) >> 2, p = lane & 3;
    const LAS bf16* a0 = T + (k0 + 8 * g + q) * pitch + col0 + 4 * p;
    union { bf16x8 v; v4i16_t h[2]; } f;
    f.h[0] = __builtin_amdgcn_ds_read_tr16_b64_v4i16((LAS v4i16_t*)a0); f.h[1] = __builtin_amdgcn_ds_read_tr16_b64_v4i16((LAS v4i16_t*)(a0 + 4 * pitch));
    return f.v;
}
PHASE_FN __device__ void ssd_unit(const KA a, int l, int unit, LAS unsigned char* lds, int tid) {
    int b, h, row_base, T; const float* h0; float* hout;
    if (unit < 48) { b = unit / 6; h = unit - b * 6; row_base = b * 2048; T = 2048; h0 = nullptr; hout = a.out() + O_PS + (size_t)((l * 8 + b) * 6 + h) * 8192; }
    else { const int u = unit - 48; b = u / 6; h = u - b * 6; row_base = TP + b * 4; T = 4; h0 = a.in(7) + (size_t)((l * 32 + b) * 6 + h) * 8192; hout = a.out() + O_SS + (size_t)((l * 32 + b) * 6 + h) * 8192; }
    const int g = h / 3, lane = tid & 63, wave = __builtin_amdgcn_readfirstlane(tid >> 6), fr = lane & 15, fq = lane >> 4;
    LAS bf16* Cs = (LAS bf16*)lds;
    LAS bf16* Bs = Cs + 64 * SD_PC;
    LAS bf16* hb = Bs + 64 * SD_PC;
    LAS bf16* xs = hb + 64 * SD_PC;
    LAS bf16* xw = xs + 64 * SD_PX;
    LAS bf16* Sc = xw + 64 * SD_PX;
    LAS float* dt_all = (LAS float*)(Sc + 64 * SD_PX);
    LAS float* ac_all = dt_all + 2048;
    LAS float* a_tmp = ac_all + 2048;
    const bf16* XC = (const bf16*)(a.ws() + WS_XC); const float* DT = (const float*)(a.ws() + WS_DT); bf16* YC = (bf16*)(a.ws() + WS_YC);
    const float A = -__expf(a.in(29)[l * 6 + h]), Dh = a.in(30)[l * 6 + h];
    const int nch = (T + 63) >> 6, TPAD = nch * 64;
    { f32x4 d = (f32x4){0.f, 0.f, 0.f, 0.f};
      if (4 * tid < TPAD) {
#pragma unroll
          for (int e = 0; e < 4; ++e) d[e] = (4 * tid + e < T) ? DT[(size_t)(row_base + 4 * tid + e) * 8 + h] : 0.f;
          *(LAS f32x4*)(dt_all + 4 * tid) = d; *(LAS f32x4*)(a_tmp + 4 * tid) = d * A; }
      __syncthreads();
      if (4 * tid < TPAD) { const int c0 = (4 * tid) & ~63; float s = 0.f;
          for (int k = c0; k < 4 * tid; k += 4) { const f32x4 v = *(const LAS f32x4*)(a_tmp + k); s += (v[0] + v[1]) + (v[2] + v[3]); }
          f32x4 o; o[0] = s + d[0] * A; o[1] = o[0] + d[1] * A; o[2] = o[1] + d[2] * A; o[3] = o[2] + d[3] * A;
          *(LAS f32x4*)(ac_all + 4 * tid) = o; } }
    const int pt = wave >> 1, nt0 = (wave & 1) * 4;
    f32x4 hs[4];
#pragma unroll
    for (int q = 0; q < 4; ++q)
#pragma unroll
        for (int e = 0; e < 4; ++e) hs[q][e] = h0 ? h0[(size_t)(16 * pt + 4 * fq + e) * 128 + 16 * (nt0 + q) + fr] : 0.f;
    v4u pC[2], pB[2], pX;
    const v4u z4 = (v4u){0u, 0u, 0u, 0u};
#pragma unroll
    for (int q = 0; q < 2; ++q) { const int idx = tid + NTHR * q, r = idx >> 4, pc = idx & 15;
        pC[q] = (r < T) ? *(const v4u*)(XC + (size_t)(row_base + r) * 896 + 640 + g * 128 + pc * 8) : z4; pB[q] = (r < T) ? *(const v4u*)(XC + (size_t)(row_base + r) * 896 + 384 + g * 128 + pc * 8) : z4; }
    pX = ((tid >> 3) < T) ? *(const v4u*)(XC + (size_t)(row_base + (tid >> 3)) * 896 + h * 64 + (tid & 7) * 8) : z4;
    LBAR();
    for (int c = 0; c < nch; ++c) {
        const int r0 = row_base + c * 64, nv = (T - c * 64) < 64 ? (T - c * 64) : 64;
        const LAS float* acum = ac_all + c * 64; const LAS float* dtv = dt_all + c * 64;
        const float alast = acum[63];
#pragma unroll
        for (int q = 0; q < 4; ++q)
#pragma unroll
            for (int e = 0; e < 4; ++e) hb[(16 * pt + 4 * fq + e) * SD_PC + 16 * (nt0 + q) + fr] = f2bf_s(hs[q][e]);
#pragma unroll
        for (int q = 0; q < 2; ++q) { const int idx = tid + NTHR * q, r = idx >> 4, pc = idx & 15;
            *(LAS v4u*)(Cs + r * SD_PC + pc * 8) = pC[q]; *(LAS v4u*)(Bs + r * SD_PC + pc * 8) = pB[q]; }
        { const int r = tid >> 3, pc = tid & 7; const float te = __expf(alast - acum[r]) * dtv[r];
          *(LAS v4u*)(xs + r * SD_PX + pc * 8) = pX;
          v4u w; w.x = pg8::cvt_pk_bf16(bflo(pX.x) * te, bfhi(pX.x) * te); w.y = pg8::cvt_pk_bf16(bflo(pX.y) * te, bfhi(pX.y) * te); w.z = pg8::cvt_pk_bf16(bflo(pX.z) * te, bfhi(pX.z) * te); w.w = pg8::cvt_pk_bf16(bflo(pX.w) * te, bfhi(pX.w) * te);
          *(LAS v4u*)(xw + r * SD_PX + pc * 8) = w; }
        if (c + 1 < nch) { const int rn = r0 + 64, nvn = (T - (c + 1) * 64) < 64 ? (T - (c + 1) * 64) : 64;
#pragma unroll
            for (int q = 0; q < 2; ++q) { const int idx = tid + NTHR * q, r = idx >> 4, pc = idx & 15;
                pC[q] = (r < nvn) ? *(const v4u*)(XC + (size_t)(rn + r) * 896 + 640 + g * 128 + pc * 8) : z4; pB[q] = (r < nvn) ? *(const v4u*)(XC + (size_t)(rn + r) * 896 + 384 + g * 128 + pc * 8) : z4; }
            pX = ((tid >> 3) < nvn) ? *(const v4u*)(XC + (size_t)(rn + (tid >> 3)) * 896 + h * 64 + (tid & 7) * 8) : z4; }
        LBAR();
        const int lt = wave >> 1;
#pragma unroll 1
        for (int q = 0; q < 2; ++q) { const int st = (wave & 1) * 2 + q;
            f32x4 gacc = tile_mma<128>((f32x4){0.f, 0.f, 0.f, 0.f}, Cs + lt * 16 * SD_PC, SD_PC, Bs + st * 16 * SD_PC, SD_PC, lane);
            const int s = 16 * st + fr; const float as = acum[s], ds = dtv[s];
#pragma unroll
            for (int e = 0; e < 4; ++e) { const int ll = 16 * lt + 4 * fq + e; const float v = (s <= ll) ? gacc[e] * __expf(acum[ll] - as) * ds : 0.f; Sc[ll * SD_PX + s] = f2bf_s(v); } }
        LBAR();
#pragma unroll 1
        for (int q = 0; q < 2; ++q) { const int ptl = (wave & 1) * 2 + q;
            f32x4 yi = (f32x4){0.f, 0.f, 0.f, 0.f};
#pragma unroll
            for (int ks = 0; ks < 2; ++ks) yi = __builtin_amdgcn_mfma_f32_16x16x32_bf16(*(const LAS bf16x8*)(Sc + (lt * 16 + fr) * SD_PX + 32 * ks + 8 * fq), tr_frag(xs, SD_PX, 32 * ks, 16 * ptl, lane), yi, 0, 0, 0);
            const f32x4 yo = tile_mma<128>((f32x4){0.f, 0.f, 0.f, 0.f}, Cs + lt * 16 * SD_PC, SD_PC, hb + ptl * 16 * SD_PC, SD_PC, lane);
            const int p = 16 * ptl + fr;
#pragma unroll
            for (int e = 0; e < 4; ++e) { const int ll = 16 * lt + 4 * fq + e;
                if (ll < nv) YC[(size_t)(r0 + ll) * 384 + h * 64 + p] = f2bf_s(yi[e] + __expf(acum[ll]) * yo[e] + Dh * bf2f(xs[ll * SD_PX + p])); } }
        { const float cd = __expf(alast);
#pragma unroll
          for (int q = 0; q < 4; ++q) hs[q] = hs[q] * cd;
#pragma unroll
          for (int ks = 0; ks < 2; ++ks) { const bf16x8 af = tr_frag(xw, SD_PX, 32 * ks, 16 * pt, lane);
#pragma unroll
              for (int q = 0; q < 4; ++q) hs[q] = __builtin_amdgcn_mfma_f32_16x16x32_bf16(af, tr_frag(Bs, SD_PC, 32 * ks, 16 * (nt0 + q), lane), hs[q], 0, 0, 0); } }
        LBAR();
    }
#pragma unroll
    for (int q = 0; q < 4; ++q)
#pragma unroll
        for (int e = 0; e < 4; ++e) hout[(size_t)(16 * pt + 4 * fq + e) * 128 + 16 * (nt0 + q) + fr] = hs[q][e];
}

constexpr int AT_PV = 264, AT_PK = 72;
__device__ __forceinline__ void attn_prompt_unit(const KA a, int l, int su, LAS unsigned char* lds, int tid) {
    const int quarter = su & 3, bhbr = su >> 2, br = bhbr % 3, bh = bhbr / 3, b = bh / 6, h = bh - b * 6;
    const int dil = (br == 0) ? 1 : (br == 1 ? 4 : 16), nblk = 16 / dil;
    const int lane = tid & 63, wave = __builtin_amdgcn_readfirstlane(tid >> 6), fr = lane & 15, fq = lane >> 4;
    const bf16* P = (const bf16*)(a.ws() + WS_P);
    LAS bf16* VT = (LAS bf16*)lds;
    LAS bf16* KL = VT + 64 * AT_PV;
    const size_t rowb = (size_t)b * 2048;
    const int kj_s = tid >> 1, hf = tid & 1, qi = 16 * wave + fr;
    const float slope = exp2f(-8.0f * (float)(h + 1) / 6.0f) * (float)dil;
    bf16* AP = (bf16*)(a.ws() + WS_AP) + (size_t)br * TOK * 384; float* AM = (float*)(a.ws() + WS_AM) + (size_t)br * TOK * 8; float* AL = (float*)(a.ws() + WS_AL) + (size_t)br * TOK * 8;
    v4u pv[4], pk[4]; bf16x8 q0, q1;
#define AT_LOAD(cn_) do { const int cls_ = (cn_) / nblk, n_ = (cn_) - cls_ * nblk; int ks_ = (n_ - 1) * 128 + kj_s; if (ks_ < 0) ks_ = 0; \
        const bf16* src_ = P + (rowb + (size_t)ks_ * dil + cls_) * NPP + h * 64 + hf * 32; \
        _Pragma("unroll") for (int q_ = 0; q_ < 4; ++q_) { pv[q_] = *(const v4u*)(src_ + C_V + q_ * 8); pk[q_] = *(const v4u*)(src_ + C_K + q_ * 8); } \
        const bf16* qp_ = P + (rowb + (size_t)(n_ * 128 + qi) * dil + cls_) * NPP + C_Q + h * 64 + 8 * fq; q0 = *(const bf16x8*)qp_; q1 = *(const bf16x8*)(qp_ + 32); } while (0)
    AT_LOAD(quarter * 4);
#pragma unroll 1
    for (int j = 0; j < 4; ++j) {
        const int cn = quarter * 4 + j, cls = cn / nblk, n = cn - cls * nblk;
#pragma unroll
        for (int q = 0; q < 4; ++q) { *(LAS v4u*)(KL + kj_s * AT_PK + hf * 32 + q * 8) = pk[q]; const unsigned wv[4] = {pv[q].x, pv[q].y, pv[q].z, pv[q].w};
#pragma unroll
            for (int e = 0; e < 4; ++e) { VT[(hf * 32 + q * 8 + 2 * e) * AT_PV + kj_s] = (bf16)(wv[e] & 0xffffu); VT[(hf * 32 + q * 8 + 2 * e + 1) * AT_PV + kj_s] = (bf16)(wv[e] >> 16); } }
        const bf16x8 cq0 = q0, cq1 = q1;
        if (j < 3) AT_LOAD(cn + 1);
        LBAR();
        const int ktlo = (n == 0 && wave < 8) ? (8 > wave ? 8 : wave) : wave, kthi = wave + 8;
        const float sl4[4] = {0.f, slope, 2.f * slope, 3.f * slope};
#define AT_SCORE(acc_, kt_) do { const LAS bf16* kp_ = KL + (16 * (kt_) + fr) * AT_PK + 8 * fq; \
            acc_ = __builtin_amdgcn_mfma_f32_16x16x32_bf16(*(const LAS bf16x8*)kp_, cq0, (f32x4){0.f, 0.f, 0.f, 0.f}, 0, 0, 0); \
            acc_ = __builtin_amdgcn_mfma_f32_16x16x32_bf16(*(const LAS bf16x8*)(kp_ + 32), cq1, acc_, 0, 0, 0); \
            const int d0_ = 128 + qi - 16 * (kt_) - 4 * fq; const float b0_ = -slope * (float)d0_; \
            _Pragma("unroll") for (int e_ = 0; e_ < 4; ++e_) acc_[e_] = acc_[e_] * 0.125f + (b0_ + sl4[e_]); \
            if ((kt_) == wave || (kt_) == wave + 8) { _Pragma("unroll") for (int e_ = 0; e_ < 4; ++e_) { const int dl_ = d0_ - e_; if (dl_ < 0 || dl_ > 128) acc_[e_] = NEG_INF; } } } while (0)
        float m = NEG_INF;
#pragma unroll
        for (int rel = 0; rel < 9; ++rel) { const int kt = wave + rel;
            if (kt >= ktlo) { f32x4 acc; AT_SCORE(acc, kt); m = fmaxf(fmaxf(m, fmaxf(acc[0], acc[1])), fmaxf(acc[2], acc[3])); }
            if (rel & 1) asm volatile("" ::: "memory"); }
        m = pg8::xmax16(m); m = pg8::xmax32(m);
        float lsum = 0.f;
        f32x4 o[4];
#pragma unroll
        for (int dt = 0; dt < 4; ++dt) o[dt] = (f32x4){0.f, 0.f, 0.f, 0.f};
#pragma unroll
        for (int rel = 0; rel < 9; ++rel) { const int kt = wave + rel;
            if (kt >= ktlo) { f32x4 sc; AT_SCORE(sc, kt);
#pragma unroll
                for (int e = 0; e < 4; ++e) { sc[e] = __expf(sc[e] - m); lsum += sc[e]; }
                const v4i16_t pa = pack4(sc);
#pragma unroll
                for (int dt = 0; dt < 4; ++dt) { const v4i16_t vb = *(const LAS v4i16_t*)(VT + (16 * dt + fr) * AT_PV + 16 * kt + 4 * fq);
                    o[dt] = __builtin_amdgcn_mfma_f32_16x16x16bf16_1k(pa, vb, o[dt], 0, 0, 0); } }
            if (rel & 1) asm volatile("" ::: "memory"); }
#undef AT_SCORE
        lsum = pg8::xsum16(lsum); lsum = pg8::xsum32(lsum);
#pragma unroll
        for (int e = 0; e < 4; ++e) { const int qq = 16 * wave + 4 * fq + e; const size_t row = rowb + (size_t)(n * 128 + qq) * dil + cls;
#pragma unroll
            for (int dt = 0; dt < 4; ++dt) AP[row * 384 + h * 64 + 16 * dt + fr] = f2bf_s(o[dt][e]); }
        if (fq == 0) { const size_t row = rowb + (size_t)(n * 128 + qi) * dil + cls; AM[row * 8 + h] = m; AL[row * 8 + h] = lsum; }
        LBAR();
    }
#undef AT_LOAD
}

PHASE_FN __device__ void attn_sample_task(const KA a, int l, int task0, LAS unsigned char* lds, int tid) {
    const int lane = tid & 63, wave = __builtin_amdgcn_readfirstlane(tid >> 6), task = task0 + wave;
    const int t = task & 3, bh = task >> 2, b = bh / 6, h = bh - b * 6;
    const bf16* P = (const bf16*)(a.ws() + WS_P);
    const float* ck = a.in(2) + ((size_t)(l * 32 + b) * 2048) * 384 + h * 64; const float* cv = a.in(3) + ((size_t)(l * 32 + b) * 2048) * 384 + h * 64;
    const int row = TP + b * 4 + t;
    LAS float* pl = (LAS float*)lds + wave * 512;
    LAS float* q = pl + 448;
    q[lane] = bf2f(P[(size_t)row * NPP + C_Q + h * 64 + lane]) * 0.125f;
    asm volatile("s_waitcnt lgkmcnt(0)" ::: "memory");
    const float slope = exp2f(-8.0f * (float)(h + 1) / 6.0f);
    float m = NEG_INF;
#pragma unroll 1
    for (int ps = 0; ps < 7; ++ps) {
        const int e = ps * 64 + lane; float v = NEG_INF;
        if (e < 387) { const int br = e / 129, st = e - br * 129, dil = (br == 0) ? 1 : (br == 1 ? 4 : 16), idx = 2048 + t - dil * st;
            float dot = 0.f;
            if (idx >= 2048) { const bf16* kp = P + (size_t)(TP + b * 4 + (idx - 2048)) * NPP + C_K + h * 64;
#pragma unroll
                for (int i = 0; i < 8; ++i) { const v4u w = *(const v4u*)(kp + i * 8); const f32x4 qa = *(const LAS f32x4*)(q + 8 * i), qb = *(const LAS f32x4*)(q + 8 * i + 4); dot += qa[0] * bflo(w.x) + qa[1] * bfhi(w.x) + qa[2] * bflo(w.y) + qa[3] * bfhi(w.y) + qb[0] * bflo(w.z) + qb[1] * bfhi(w.z) + qb[2] * bflo(w.w) + qb[3] * bfhi(w.w); } }
            else { const float* kp = ck + (size_t)idx * 384;
#pragma unroll
                for (int i = 0; i < 8; ++i) { const f32x4 w = *(const f32x4*)(kp + 4 * i); const f32x4 qa = *(const LAS f32x4*)(q + 4 * i); dot += qa[0] * w[0] + qa[1] * w[1] + qa[2] * w[2] + qa[3] * w[3]; }
#pragma unroll
                for (int i = 8; i < 16; ++i) { const f32x4 w = *(const f32x4*)(kp + 4 * i); const f32x4 qa = *(const LAS f32x4*)(q + 4 * i); dot += qa[0] * w[0] + qa[1] * w[1] + qa[2] * w[2] + qa[3] * w[3]; } }
            v = dot - slope * (float)(dil * st); }
        pl[e] = v; m = fmaxf(m, v);
    }
    m = wave_max(m);
    float ls = 0.f;
#pragma unroll
    for (int ps = 0; ps < 7; ++ps) { const float p = __expf(pl[ps * 64 + lane] - m); ls += p; pl[ps * 64 + lane] = p; }
    ls = wave_sum(ls);
    asm volatile("s_waitcnt lgkmcnt(0)" ::: "memory");
    float acc = 0.f;
    const bf16* pvn = P + (size_t)(TP + b * 4) * NPP + C_V + h * 64 + lane;
#pragma unroll 1
    for (int br = 0; br < 3; ++br) { const int dil = (br == 0) ? 1 : (br == 1 ? 4 : 16); const LAS float* pb = pl + br * 129;
#pragma unroll 1
        for (int s0 = 0; s0 < 128; s0 += 32) { float vv[32];
#pragma unroll
            for (int j = 0; j < 32; ++j) { const int idx = 2048 + t - dil * (s0 + j);
                vv[j] = (idx >= 2048) ? bf2f(pvn[(size_t)(idx - 2048) * NPP]) : cv[(size_t)idx * 384 + lane]; }
#pragma unroll
            for (int j = 0; j < 32; ++j) acc += pb[s0 + j] * vv[j]; }
        { const int idx = 2048 + t - dil * 128; acc += pb[128] * cv[(size_t)idx * 384 + lane]; } }
    bf16* AP = (bf16*)(a.ws() + WS_AP); float* AM = (float*)(a.ws() + WS_AM); float* AL = (float*)(a.ws() + WS_AL);
    AP[(size_t)row * 384 + h * 64 + lane] = f2bf_s(acc); AP[((size_t)TOK + row) * 384 + h * 64 + lane] = 0; AP[((size_t)2 * TOK + row) * 384 + h * 64 + lane] = 0;
    if (lane == 0) { AM[(size_t)row * 8 + h] = m; AL[(size_t)row * 8 + h] = ls; AM[((size_t)TOK + row) * 8 + h] = NEG_INF; AL[((size_t)TOK + row) * 8 + h] = 0.f; AM[((size_t)2 * TOK + row) * 8 + h] = NEG_INF; AL[((size_t)2 * TOK + row) * 8 + h] = 0.f; }
}

PHASE_FN __device__ void post_rwkv(const KA a, int l, int tid) {
    const int lane = tid & 63, gw = blockIdx.x * NWAVES + __builtin_amdgcn_readfirstlane(tid >> 6); int NGW = gridDim.x * NWAVES; asm volatile("" : "+s"(NGW));
    const bf16* YS = (const bf16*)(a.ws() + WS_YS); const unsigned char* REC = a.ws() + WS_REC; const float* SC = (const float*)(a.ws() + WS_SC); const bf16* G = (const bf16*)(a.ws() + WS_G);
    bf16* YM = (bf16*)(a.ws() + WS_YM);
    float lw[4], lb[4];
#pragma unroll
    for (int hh = 0; hh < 4; ++hh) { lw[hh] = a.in(23)[l * 256 + hh * 64 + lane]; lb[hh] = a.in(24)[l * 256 + hh * 64 + lane]; }
    for (int row0 = gw * 2; row0 < TOK; row0 += 2 * NGW) {
        float v[2][4], ys[2][4], g[2][4], kr[2][4], bon[2][4];
#pragma unroll
        for (int r = 0; r < 2; ++r)
#pragma unroll
            for (int hh = 0; hh < 4; ++hh) { const int row = row0 + r, c = hh * 64 + lane;
                v[r][hh] = bf2f(*(const bf16*)(REC + (size_t)((row >> 4) * 4 + hh) * REC_BYTES + 8192 + ((row & 15) * 64 + lane) * 2)); ys[r][hh] = bf2f(YS[(size_t)row * 256 + c]); g[r][hh] = bf2f(G[(size_t)row * 256 + c]);
                kr[r][hh] = SC[(size_t)(row * 4 + hh) * 2]; bon[r][hh] = SC[(size_t)(row * 4 + hh) * 2 + 1]; }
#pragma unroll
        for (int r = 0; r < 2; ++r)
#pragma unroll
            for (int hh = 0; hh < 4; ++hh) { const float y = ys[r][hh] + v[r][hh] * kr[r][hh];
                const float mu = wave_sum(y) * (1.f / 64.f), d = y - mu, var = wave_sum(d * d) * (1.f / 64.f);
                const float yn = d * rsqrtf(var + GN_EPS) * lw[hh] + lb[hh];
                YM[(size_t)(row0 + r) * D + hh * 64 + lane] = f2bf_s((yn + bon[r][hh] * v[r][hh]) * g[r][hh]); }
    }
}
PHASE_FN __device__ void post_att(const KA a, int l, int tid) {
    const int lane = tid & 63, gw = blockIdx.x * NWAVES + __builtin_amdgcn_readfirstlane(tid >> 6); int NGW = gridDim.x * NWAVES; asm volatile("" : "+s"(NGW));
    const bf16* AP = (const bf16*)(a.ws() + WS_AP); const float* AM = (const float*)(a.ws() + WS_AM); const float* AL = (const float*)(a.ws() + WS_AL); bf16* YM = (bf16*)(a.ws() + WS_YM);
    float nw[6];
#pragma unroll
    for (int hd = 0; hd < 6; ++hd) nw[hd] = a.in(25)[l * 384 + hd * 64 + lane];
    for (int row0 = gw * 2; row0 < TOK; row0 += 2 * NGW) {
        float ap[2][3][6], am[2][3], al[2][3];
#pragma unroll
        for (int r = 0; r < 2; ++r)
#pragma unroll
            for (int br = 0; br < 3; ++br) { const size_t rb = (size_t)br * TOK + row0 + r;
                am[r][br] = AM[rb * 8 + (lane & 7)]; al[r][br] = AL[rb * 8 + (lane & 7)];
#pragma unroll
                for (int hd = 0; hd < 6; ++hd) ap[r][br][hd] = bf2f(AP[rb * 384 + hd * 64 + lane]); }
#pragma unroll
        for (int r = 0; r < 2; ++r) {
            const float M = fmaxf(am[r][0], fmaxf(am[r][1], am[r][2]));
            const float e0 = __expf(am[r][0] - M), e1 = __expf(am[r][1] - M), e2 = __expf(am[r][2] - M);
            const float inv = 1.0f / (e0 * al[r][0] + e1 * al[r][1] + e2 * al[r][2]);
            float ob[6], ss = 0.f;
#pragma unroll
            for (int hd = 0; hd < 6; ++hd) { const float w0 = __uint_as_float(__builtin_amdgcn_readlane(__float_as_uint(e0 * inv), hd));
                const float w1 = __uint_as_float(__builtin_amdgcn_readlane(__float_as_uint(e1 * inv), hd)), w2 = __uint_as_float(__builtin_amdgcn_readlane(__float_as_uint(e2 * inv), hd));
                ob[hd] = w0 * ap[r][0][hd] + w1 * ap[r][1][hd] + w2 * ap[r][2][hd]; ss += ob[hd] * ob[hd]; }
            ss = wave_sum(ss); const float rs = rsqrtf(ss * (1.f / 384.f) + NORM_EPS);
#pragma unroll
            for (int hd = 0; hd < 6; ++hd) YM[(size_t)(row0 + r) * D + 256 + hd * 64 + lane] = f2bf_s(ob[hd] * rs * nw[hd]);
        }
    }
}
PHASE_FN __device__ void post_ssd(const KA a, int l, int tid) {
    const int lane = tid & 63, gw = blockIdx.x * NWAVES + __builtin_amdgcn_readfirstlane(tid >> 6); int NGW = gridDim.x * NWAVES; asm volatile("" : "+s"(NGW));
    const bf16* YC = (const bf16*)(a.ws() + WS_YC); const bf16* P = (const bf16*)(a.ws() + WS_P); bf16* YM = (bf16*)(a.ws() + WS_YM);
    float nw[6];
#pragma unroll
    for (int hd = 0; hd < 6; ++hd) nw[hd] = a.in(31)[l * 384 + hd * 64 + lane];
    for (int row0 = gw * 2; row0 < TOK; row0 += 2 * NGW) {
        float yc[2][6], z[2][6];
#pragma unroll
        for (int r = 0; r < 2; ++r)
#pragma unroll
            for (int hd = 0; hd < 6; ++hd) { yc[r][hd] = bf2f(YC[(size_t)(row0 + r) * 384 + hd * 64 + lane]); z[r][hd] = bf2f(P[(size_t)(row0 + r) * NPP + C_Z + hd * 64 + lane]); }
#pragma unroll
        for (int r = 0; r < 2; ++r) { float ob[6], ss = 0.f;
#pragma unroll
            for (int hd = 0; hd < 6; ++hd) { ob[hd] = yc[r][hd] * (z[r][hd] * sigmoidf_(z[r][hd])); ss += ob[hd] * ob[hd]; }
            ss = wave_sum(ss); const float rs = rsqrtf(ss * (1.f / 384.f) + NORM_EPS);
#pragma unroll
            for (int hd = 0; hd < 6; ++hd) YM[(size_t)(row0 + r) * D + 640 + hd * 64 + lane] = f2bf_s(ob[hd] * rs * nw[hd]); }
    }
}
PHASE_FN __device__ void final_rows(const KA a, int tid) {
    const int lane = tid & 63, gw = blockIdx.x * NWAVES + __builtin_amdgcn_readfirstlane(tid >> 6); int NGW = gridDim.x * NWAVES; asm volatile("" : "+s"(NGW));
    const float* X = (const float*)(a.ws() + WS_X); const float* SSQ = (const float*)(a.ws() + WS_SSQ);
    for (int row = gw; row < TOK; row += NGW) {
        const float rs = pg8::row_rstd(SSQ, row);
        float* dst = (row < TP) ? a.out() + O_YP + (size_t)row * D : a.out() + O_YS + (size_t)(row - TP) * D;
#pragma unroll
        for (int j = 0; j < 4; ++j) { const f32x4 v = ((const f32x4*)(X + (size_t)row * D))[lane + 64 * j], w = ((const f32x4*)a.in(37))[lane + 64 * j]; ((f32x4*)dst)[lane + 64 * j] = v * rs * w; }
    }
}

constexpr int Q_SCAN = 32, Q_SSD = Q_SCAN + 48, Q_ATS = Q_SSD + 96, Q_ATT = Q_ATS + 576, Q_SCS = Q_ATT + 128, NU_MIX = Q_SCS + 192;
#ifndef REP_MIX
#define REP_MIX 1
#endif
#ifndef REP_PP
#define REP_PP 1
#endif
#ifndef REP_G
#define REP_G 1
#endif
#ifndef DUP_MASK
#define DUP_MASK 0
#endif
#ifndef REP_PRO
#define REP_PRO 1
#endif
#ifndef REP_R
#define REP_R 1
#endif

template <int KSTEPS> PHASE_FN __device__ void skinny_res(const KA a, size_t a_off, size_t b_off, float scale, int write_f32, LAS unsigned char* lds, int tid) {
    constexpr int K = KSTEPS * 32 * 4;
    const int lane = tid & 63, wave = __builtin_amdgcn_readfirstlane(tid >> 6), fr = lane & 15, fq = lane >> 4, ct = wave & 1, kq = wave >> 1;
    const bf16* A = (const bf16*)(a.ws() + a_off); const bf16* Bt = (const bf16*)(a.ws() + b_off);
    float* X = (float*)(a.ws() + WS_X); bf16* XB = (bf16*)(a.ws() + WS_XB); float* SSQ = (float*)(a.ws() + WS_SSQ);
    LAS f32x4* red = (LAS f32x4*)lds;
    for (int piece = blockIdx.x; piece < 256; piece += gridDim.x) {
        const int rt = piece >> 5, cg = piece & 31;
        const bf16* ap = A + (size_t)(TP + rt * 16 + fr) * K + kq * (K / 4) + 8 * fq; const bf16* wp = Bt + (size_t)(cg * 32 + ct * 16 + fr) * K + kq * (K / 4) + 8 * fq;
        f32x4 acc = (f32x4){0.f, 0.f, 0.f, 0.f};
#pragma unroll
        for (int ks = 0; ks < KSTEPS; ++ks) acc = __builtin_amdgcn_mfma_f32_16x16x32_bf16(*(const bf16x8*)(wp + 32 * ks), *(const bf16x8*)(ap + 32 * ks), acc, 0, 0, 0);
        red[wave * 64 + lane] = acc;
        __syncthreads();
        if (kq == 0) {
            acc = (red[ct * 64 + lane] + red[(ct + 2) * 64 + lane]) + (red[(ct + 4) * 64 + lane] + red[(ct + 6) * 64 + lane]);
            const int rl = rt * 16 + fr, row = TP + rl, c0 = cg * 32 + ct * 16 + 4 * fq;
            const f32x4 x = up4(*(const v2u*)(XB + (size_t)row * D + c0)) + acc * scale; if (write_f32) *(f32x4*)(X + (size_t)row * D + c0) = x;
            v2u w; w.x = pg8::cvt_pk_bf16(x[0], x[1]); w.y = pg8::cvt_pk_bf16(x[2], x[3]); *(v2u*)(XB + (size_t)row * D + c0) = w;
            float ss = (x[0] * x[0] + x[1] * x[1]) + (x[2] * x[2] + x[3] * x[3]); ss = pg8::xsum16(ss); ss = pg8::xsum32(ss);
            if (fq == 0) SSQ[pg8::SSQS_OFF + (size_t)rl * 64 + cg * 2 + ct] = ss;
        }
        __syncthreads();
    }
}
#define WT_REM0 ((gridDim.x == 256) ? WT_ITEMS : 0)
#define MIX_PHASE(QREP) \
        for (;;) { \
            { WSL(w); if (fresh_tid() == 0) MISC[0] = __hip_atomic_fetch_add((unsigned*)((gu32*)(w + WS_CTL) + CW_Q + 64 * (l + 4 * (QREP))), 1u, __ATOMIC_RELAXED, __HIP_MEMORY_SCOPE_AGENT); } \
            __syncthreads(); \
            const int u = (int)MISC[0]; \
            __syncthreads(); \
            if (u >= NU_MIX + ((l < DEPTH - 1) ? (I_LAYER - WT_REM0) / 8 : 0)) break; \
            if (u < Q_SCAN) { rwkv_scan_unit(make_ka(), l, u, lds, fresh_tid()); if (DUP_MASK & 1) { __syncthreads(); rwkv_scan_unit(make_ka(), l, u, lds, fresh_tid()); } } \
            else if (u < Q_SSD) { ssd_unit(make_ka(), l, u - Q_SCAN, lds, fresh_tid()); if (DUP_MASK & 2) { __syncthreads(); ssd_unit(make_ka(), l, u - Q_SCAN, lds, fresh_tid()); } } \
            else if (u < Q_ATS) { attn_sample_task(make_ka(), l, (u - Q_SSD) * 8, lds, fresh_tid()); if (DUP_MASK & 4) { __syncthreads(); attn_sample_task(make_ka(), l, (u - Q_SSD) * 8, lds, fresh_tid()); } } \
            else if (u < Q_ATT) { attn_prompt_unit(make_ka(), l, u - Q_ATS, lds, fresh_tid()); if (DUP_MASK & 8) { __syncthreads(); attn_prompt_unit(make_ka(), l, u - Q_ATS, lds, fresh_tid()); } } \
            else if (u < Q_SCS) { rwkv_scan_unit(make_ka(), l, 32 + (u - Q_ATT), lds, fresh_tid()); if (DUP_MASK & 16) { __syncthreads(); rwkv_scan_unit(make_ka(), l, 32 + (u - Q_ATT), lds, fresh_tid()); } } \
            else if (u < NU_MIX) { ssd_unit(make_ka(), l, 48 + (u - Q_SCS), lds, fresh_tid()); if (DUP_MASK & 32) { __syncthreads(); ssd_unit(make_ka(), l, 48 + (u - Q_SCS), lds, fresh_tid()); } } \
            else wconv_unit(make_ka(), l + 1, u - NU_MIX + WT_REM0 / 8, lds, fresh_tid()); \
        } \
        GRID_BAR();
__global__ void __launch_bounds__(NTHR, 2) hymba_fwd(KArgs args) {
    extern __shared__ __attribute__((aligned(16))) unsigned char lds_raw[];
    LAS unsigned char* lds = (LAS unsigned char*)lds_raw;
    volatile LAS unsigned* MISC = (volatile LAS unsigned*)(lds + MISC_OFF);
    { const int tid = threadIdx.x; for (int u = tid; u < (LDS_BYTES - LDSCTL_OFF) / 4; u += NTHR) ((LAS unsigned*)(lds + LDSCTL_OFF))[u] = 0u; }
    __syncthreads();
    XcdBarrier bar = xcd_barrier_post((unsigned*)((gu32*)(args.ws + WS_CTL) + CW_BAR), MISC + 8);
#define GRID_BAR() do { XcdBarrier b_ = bar; asm volatile("" : "+s"(b_.bar), "+s"(b_.x)); xcd_barrier(b_); } while (0)
#define WSL(name) unsigned char* name = make_ka().ws()
#define GL(name) int name = gridDim.x; asm volatile("" : "+s"(name)); int bx_ = blockIdx.x; asm volatile("" : "+s"(bx_))

#ifndef NO_PRO
    p0_prologue(make_ka(), lds, fresh_tid()); p0_xinit(make_ka(), fresh_tid());
#endif
    GRID_BAR();
#if REP_PRO > 1
    p0_prologue(make_ka(), lds, fresh_tid()); p0_xinit(make_ka(), fresh_tid());
    GRID_BAR();
#endif
    for (int l = 0; l < DEPTH; ++l) {
        if (l < DEPTH - 1) { wconv_tail(make_ka(), l + 1, 0, lds, fresh_tid()); __syncthreads(); }
        { WSL(w); GL(G); pg8::Gemm g{(const bf16*)(w + WS_XB), (const bf16*)(w + WS_W + (size_t)l * WL_SIZE + WL_GU1), MP, 2 * FF, D}; pg8::StaticOrder S; S.init(MP, 2 * FF, G, bx_, WGM_GU); pg8::EpiGU E{(bf16*)(w + WS_H), (const float*)(w + WS_SSQ), (LAS float*)(lds + LDSCTL_OFF + 4096)};
          pg8::gemm_phase<pg8::EpiGU, pg8::StaticOrder, true, true>(lds, g, S, E); }
        GRID_BAR();
#if REP_G > 1
        { WSL(w); GL(G); pg8::Gemm g{(const bf16*)(w + WS_XB), (const bf16*)(w + WS_W + (size_t)l * WL_SIZE + WL_GU1), MP, 2 * FF, D}; pg8::StaticOrder S; S.init(MP, 2 * FF, G, bx_, WGM_GU); pg8::EpiGU E{(bf16*)(w + WS_H), (const float*)(w + WS_SSQ), (LAS float*)(lds + LDSCTL_OFF + 4096)};
          pg8::gemm_phase<pg8::EpiGU, pg8::StaticOrder, true, true>(lds, g, S, E); }
        GRID_BAR();
#endif
        skinny_res<22>(make_ka(), WS_H, WS_W + (size_t)l * WL_SIZE + WL_D1, 0.5f, 0, lds, fresh_tid());
        { WSL(w); GL(G); pg8::Gemm g{(const bf16*)(w + WS_H), (const bf16*)(w + WS_W + (size_t)l * WL_SIZE + WL_D1), TP, D, FF}; pg8::StaticOrder S; S.init(TP, D, G, bx_, WGM_R); pg8::EpiRes E{(float*)nullptr, (bf16*)(w + WS_XB), (float*)(w + WS_SSQ), 0.5f};
          pg8::gemm_phase<pg8::EpiRes, pg8::StaticOrder, true, true>(lds, g, S, E); }
        GRID_BAR();
#if REP_R > 1
        skinny_res<22>(make_ka(), WS_H, WS_W + (size_t)l * WL_SIZE + WL_D1, 0.0f, 0, lds, fresh_tid());
        { WSL(w); GL(G); pg8::Gemm g{(const bf16*)(w + WS_H), (const bf16*)(w + WS_W + (size_t)l * WL_SIZE + WL_D1), TP, D, FF}; pg8::StaticOrder S; S.init(TP, D, G, bx_, WGM_R); pg8::EpiRes E{(float*)nullptr, (bf16*)(w + WS_XB), (float*)(w + WS_SSQ), 0.0f};
          pg8::gemm_phase<pg8::EpiRes, pg8::StaticOrder, true, true>(lds, g, S, E); }
        GRID_BAR();
#endif
        if (l < DEPTH - 1) { wconv_tail(make_ka(), l + 1, 1, lds, fresh_tid()); __syncthreads(); }
        { WSL(w); GL(G); pg8::Gemm g{(const bf16*)(w + WS_XB), (const bf16*)(w + WS_W + (size_t)l * WL_SIZE + WL_IN), MP, NPP, D}; pg8::StaticOrder S; S.init(MP, NPP, G, bx_, WGM_IN); pg8::EpiIn E{(bf16*)(w + WS_P), (const float*)(w + WS_SSQ), make_ka().out(), l, (LAS float*)(lds + LDSCTL_OFF + 4096)};
          pg8::gemm_phase<pg8::EpiIn, pg8::StaticOrder, true, true>(lds, g, S, E); }
        GRID_BAR();
#if REP_G > 1
        { WSL(w); GL(G); pg8::Gemm g{(const bf16*)(w + WS_XB), (const bf16*)(w + WS_W + (size_t)l * WL_SIZE + WL_IN), MP, NPP, D}; pg8::StaticOrder S; S.init(MP, NPP, G, bx_, WGM_IN); pg8::EpiIn E{(bf16*)(w + WS_P), (const float*)(w + WS_SSQ), make_ka().out(), l, (LAS float*)(lds + LDSCTL_OFF + 4096)};
          pg8::gemm_phase<pg8::EpiIn, pg8::StaticOrder, true, true>(lds, g, S, E); }
        GRID_BAR();
#endif
#ifndef NO_PREP
        rwkv_prep(make_ka(), l, lds, fresh_tid());
#endif
#ifndef NO_PREPE
        prep_elementwise(make_ka(), l, fresh_tid());
#endif
        GRID_BAR();
#if REP_PP > 1
        rwkv_prep(make_ka(), l, lds, fresh_tid());
        prep_elementwise(make_ka(), l, fresh_tid());
        GRID_BAR();
#endif
        MIX_PHASE(0)
#if REP_MIX > 1
        MIX_PHASE(1)
#endif
#ifndef NO_POST
        post_rwkv(make_ka(), l, fresh_tid()); post_att(make_ka(), l, fresh_tid()); post_ssd(make_ka(), l, fresh_tid());
#endif
        GRID_BAR();
#if REP_PP > 1
        post_rwkv(make_ka(), l, fresh_tid()); post_att(make_ka(), l, fresh_tid()); post_ssd(make_ka(), l, fresh_tid());
        GRID_BAR();
#endif
        skinny_res<8>(make_ka(), WS_YM, WS_W + (size_t)l * WL_SIZE + WL_OUT, 1.0f, 0, lds, fresh_tid());
        { WSL(w); GL(G); pg8::Gemm g{(const bf16*)(w + WS_YM), (const bf16*)(w + WS_W + (size_t)l * WL_SIZE + WL_OUT), TP, D, D}; pg8::StaticOrder S; S.init(TP, D, G, bx_, WGM_R); pg8::EpiRes E{(float*)nullptr, (bf16*)(w + WS_XB), (float*)(w + WS_SSQ), 1.0f};
          pg8::gemm_phase<pg8::EpiRes, pg8::StaticOrder, true, true>(lds, g, S, E); }
        GRID_BAR();
#if REP_R > 1
        skinny_res<8>(make_ka(), WS_YM, WS_W + (size_t)l * WL_SIZE + WL_OUT, 0.0f, 0, lds, fresh_tid());
        { WSL(w); GL(G); pg8::Gemm g{(const bf16*)(w + WS_YM), (const bf16*)(w + WS_W + (size_t)l * WL_SIZE + WL_OUT), TP, D, D}; pg8::StaticOrder S; S.init(TP, D, G, bx_, WGM_R); pg8::EpiRes E{(float*)nullptr, (bf16*)(w + WS_XB), (float*)(w + WS_SSQ), 0.0f};
          pg8::gemm_phase<pg8::EpiRes, pg8::StaticOrder, true, true>(lds, g, S, E); }
        GRID_BAR();
#endif
        if (l < DEPTH - 1) { wconv_tail(make_ka(), l + 1, 2, lds, fresh_tid()); __syncthreads(); }
        { WSL(w); GL(G); pg8::Gemm g{(const bf16*)(w + WS_XB), (const bf16*)(w + WS_W + (size_t)l * WL_SIZE + WL_GU2), MP, 2 * FF, D}; pg8::StaticOrder S; S.init(MP, 2 * FF, G, bx_, WGM_GU); pg8::EpiGU E{(bf16*)(w + WS_H), (const float*)(w + WS_SSQ), (LAS float*)(lds + LDSCTL_OFF + 4096)};
          pg8::gemm_phase<pg8::EpiGU, pg8::StaticOrder, true, true>(lds, g, S, E); }
        GRID_BAR();
#if REP_G > 1
        { WSL(w); GL(G); pg8::Gemm g{(const bf16*)(w + WS_XB), (const bf16*)(w + WS_W + (size_t)l * WL_SIZE + WL_GU2), MP, 2 * FF, D}; pg8::StaticOrder S; S.init(MP, 2 * FF, G, bx_, WGM_GU); pg8::EpiGU E{(bf16*)(w + WS_H), (const float*)(w + WS_SSQ), (LAS float*)(lds + LDSCTL_OFF + 4096)};
          pg8::gemm_phase<pg8::EpiGU, pg8::StaticOrder, true, true>(lds, g, S, E); }
        GRID_BAR();
#endif
        skinny_res<22>(make_ka(), WS_H, WS_W + (size_t)l * WL_SIZE + WL_D2, 0.5f, (l == DEPTH - 1) ? 1 : 0, lds, fresh_tid());
        { WSL(w); GL(G); pg8::Gemm g{(const bf16*)(w + WS_H), (const bf16*)(w + WS_W + (size_t)l * WL_SIZE + WL_D2), TP, D, FF}; pg8::StaticOrder S; S.init(TP, D, G, bx_, WGM_R); pg8::EpiRes E{((l == DEPTH - 1) ? (float*)(w + WS_X) : (float*)nullptr), (bf16*)(w + WS_XB), (float*)(w + WS_SSQ), 0.5f};
          pg8::gemm_phase<pg8::EpiRes, pg8::StaticOrder, true, true>(lds, g, S, E); }
        GRID_BAR();
#if REP_R > 1
        skinny_res<22>(make_ka(), WS_H, WS_W + (size_t)l * WL_SIZE + WL_D2, 0.0f, (l == DEPTH - 1) ? 1 : 0, lds, fresh_tid());
        { WSL(w); GL(G); pg8::Gemm g{(const bf16*)(w + WS_H), (const bf16*)(w + WS_W + (size_t)l * WL_SIZE + WL_D2), TP, D, FF}; pg8::StaticOrder S; S.init(TP, D, G, bx_, WGM_R); pg8::EpiRes E{((l == DEPTH - 1) ? (float*)(w + WS_X) : (float*)nullptr), (bf16*)(w + WS_XB), (float*)(w + WS_SSQ), 0.0f};
          pg8::gemm_phase<pg8::EpiRes, pg8::StaticOrder, true, true>(lds, g, S, E); }
        GRID_BAR();
#endif
    }
    final_rows(make_ka(), fresh_tid());
}

extern "C" void kernel_launch(void* const* d_in, const int* in_sizes, int n_in, void* d_out, int out_size, void* d_ws, size_t ws_size, hipStream_t stream) {
    static int grid = 0;
    if (grid == 0) {
        if (n_in != 38 || (size_t)out_size != O_END || ws_size < WS_END) { fprintf(stderr, "kernel_launch: unexpected shapes: n_in %d out %d ws %zu\n", n_in, out_size, ws_size); grid = -1; return; }
        int dev = 0, cus = 0, per_cu = 0;
        if (hipGetDevice(&dev) != hipSuccess || hipDeviceGetAttribute(&cus, hipDeviceAttributeMultiprocessorCount, dev) != hipSuccess) { grid = -1; return; }
        if (hipFuncSetAttribute((const void*)hymba_fwd, hipFuncAttributeMaxDynamicSharedMemorySize, LDS_BYTES) != hipSuccess) { fprintf(stderr, "kernel_launch: hipFuncSetAttribute failed\n"); grid = -1; return; }
        if (hipOccupancyMaxActiveBlocksPerMultiprocessor(&per_cu, (const void*)hymba_fwd, NTHR, LDS_BYTES) != hipSuccess || per_cu < 1) { fprintf(stderr, "kernel_launch: occupancy query says %d\n", per_cu); }
        (void)hipGetLastError();
        grid = cus;
    }
    if (grid < 0) return;
    if (hipMemsetAsync((char*)d_ws + WS_CTL, 0, CTL_ZERO_BYTES, stream) != hipSuccess) return;
    KArgs a{};
    for (int i = 0; i < 38; ++i) a.in[i] = (const float*)d_in[i];
    a.out = (float*)d_out; a.ws = (unsigned char*)d_ws;
    hipLaunchKernelGGL(hymba_fwd, dim3(grid), dim3(NTHR), LDS_BYTES, stream, a);
}
```
